# Optimizing an MI355X kernel written in HIP

```python
import jax, jax.numpy as jnp
from jax import lax
import numpy as np

D_MODEL = 1024
BATCH = 16
SEQ = 2048
DEPTH = 2

GRID_W = 64
CTX_LEN = 256
N_MIXERS = 2
N_A_LAYERS = (DEPTH + N_MIXERS - 1) // N_MIXERS
N_B_LAYERS = DEPTH // N_MIXERS

D_RNN = D_MODEL
CONV_W = 4
LRU_BLOCKS = 8
LRU_BLOCK = D_RNN // LRU_BLOCKS
LRU_C = 8.0

MLA_HEADS = 16
QK_NOPE = 64
QK_ROPE = 32
QK_DIM = QK_NOPE + QK_ROPE
V_DIM = 64
Q_LORA = 384
KV_LORA = 256
ROPE_FREQS = QK_ROPE // 4
ROPE_BASE = 10000.0
Q_BLOCK = 128
ATTN_SCALE = QK_DIM ** -0.5

N_EXPERTS = 16
D_EXPERT = 1024
CAPACITY_FACTOR = 2

EPS = 1e-6

kernel_name = "hybrid_rglru_mla_ecmoe_dit"


def rmsnorm(x, g):
    xf = x.astype(jnp.float32)
    y = xf * lax.rsqrt(jnp.mean(xf * xf, axis=-1, keepdims=True) + EPS)
    return (y * g.astype(jnp.float32)).astype(x.dtype)


def adaln(cvec, w, b):
    m = jax.nn.silu(cvec) @ w + b
    return jnp.split(m[..., None, :], 6, axis=-1)


def modulate(h, shift, scale):
    return h * (1 + scale) + shift


def axial_rope(rows):
    row = jnp.broadcast_to(jnp.arange(rows)[:, None], (rows, GRID_W)).reshape(-1)
    col = jnp.broadcast_to(jnp.arange(GRID_W)[None, :], (rows, GRID_W)).reshape(-1)
    pos = jnp.stack([row, col], axis=-1).astype(jnp.float32)
    freq = ROPE_BASE ** (-jnp.arange(ROPE_FREQS, dtype=jnp.float32) / ROPE_FREQS)
    ang = pos[:, :, None] * freq
    return jnp.cos(ang), jnp.sin(ang)


def apply_rope(x, cos, sin):
    xr = x.reshape(x.shape[:-1] + (2, 2, ROPE_FREQS))
    x1 = xr[..., 0, :]
    x2 = xr[..., 1, :]
    out = jnp.stack([x1 * cos - x2 * sin, x1 * sin + x2 * cos], axis=-2)
    return out.reshape(x.shape).astype(x.dtype)


def dwconv_centred(x, w, b):
    T = x.shape[1]
    xp = jnp.pad(x, ((0, 0), (CONV_W // 2, CONV_W - 1 - CONV_W // 2), (0, 0)))
    y = xp[:, 0:T] * w[0]
    for k in range(1, CONV_W):
        y = y + xp[:, k:k + T] * w[k]
    return y + b


def rglru_direction(xc, w_g, b_g, lam, h0, reverse):
    B, T, _ = xc.shape
    xb = xc.reshape(B, T, LRU_BLOCKS, LRU_BLOCK)
    g = jnp.einsum('btnk,gnkj->gbtnj', xb, w_g).reshape(2, B, T, D_RNN) + b_g[:, None, None, :]
    r = jax.nn.sigmoid(g[0].astype(jnp.float32))
    ig = jax.nn.sigmoid(g[1].astype(jnp.float32))
    log_a = -LRU_C * r * jax.nn.softplus(-lam.astype(jnp.float32))
    a = jnp.exp(log_a)
    u = jnp.sqrt(-jnp.expm1(2.0 * log_a)) * (ig * xc.astype(jnp.float32))

    def step(h, au):
        at, ut = au
        h = at * h + ut
        return h, h

    h_last, hs = lax.scan(step, h0, (jnp.moveaxis(a, 1, 0), jnp.moveaxis(u, 1, 0)), reverse=reverse)
    return jnp.moveaxis(hs, 0, 1), h_last


def rglru_mixer(h_lat, h_ctx, w_in, conv_w, conv_b, gate_w, gate_b, lam, w_out, need_ctx):
    def branches(h):
        z = h @ w_in
        return jax.nn.gelu(z[..., :D_RNN]), dwconv_centred(z[..., D_RNN:], conv_w, conv_b)

    B = h_lat.shape[0]
    g_ctx, xc_ctx = branches(h_ctx)
    g_lat, xc_lat = branches(h_lat)
    y_lat = 0.0
    y_ctx = 0.0
    for d in range(2):
        h0 = jnp.zeros((B, D_RNN), jnp.float32)
        yc, hc = rglru_direction(xc_ctx, gate_w[d], gate_b[d], lam[d], h0, reverse=(d == 1))
        yl, _ = rglru_direction(xc_lat, gate_w[d], gate_b[d], lam[d], hc, reverse=(d == 1))
        y_lat = y_lat + yl
        y_ctx = y_ctx + yc
    out_lat = (y_lat.astype(h_lat.dtype) * g_lat) @ w_out
    out_ctx = (y_ctx.astype(h_ctx.dtype) * g_ctx) @ w_out if need_ctx else None
    return out_lat, out_ctx


def mla_qkv(h, w_in, q_norm, kv_norm, w_uq, w_ukv, cos, sin):
    B, L, _ = h.shape
    z = h @ w_in
    cq = z[..., :Q_LORA]
    ckv = z[..., Q_LORA:Q_LORA + KV_LORA]
    kr = z[..., Q_LORA + KV_LORA:]
    q = (rmsnorm(cq, q_norm) @ w_uq).reshape(B, L, MLA_HEADS, QK_DIM)
    kv = (rmsnorm(ckv, kv_norm) @ w_ukv).reshape(B, L, MLA_HEADS, QK_NOPE + V_DIM)
    q_nope, q_rope = q[..., :QK_NOPE], q[..., QK_NOPE:]
    k_nope, v = kv[..., :QK_NOPE], kv[..., QK_NOPE:]
    if cos is not None:
        q_rope = apply_rope(q_rope, cos[:, None], sin[:, None])
        kr = apply_rope(kr, cos, sin)
    k_rope = jnp.broadcast_to(kr[:, :, None, :], (B, L, MLA_HEADS, QK_ROPE))
    return (jnp.concatenate([q_nope, q_rope], axis=-1),
            jnp.concatenate([k_nope, k_rope], axis=-1), v)


def attend(q, k, v):
    s = jnp.einsum('bqhd,bkhd->bhqk', q, k).astype(jnp.float32) * ATTN_SCALE
    p = jax.nn.softmax(s, axis=-1).astype(v.dtype)
    return jnp.einsum('bhqk,bkhd->bqhd', p, v)


def mla_mixer(h_lat, h_ctx, w_in, q_norm, kv_norm, w_uq, w_ukv, w_o, cos, sin, need_ctx):
    B, T, _ = h_lat.shape
    q_lat, k_lat, v_lat = mla_qkv(h_lat, w_in, q_norm, kv_norm, w_uq, w_ukv, cos, sin)
    q_ctx, k_ctx, v_ctx = mla_qkv(h_ctx, w_in, q_norm, kv_norm, w_uq, w_ukv, None, None)
    k_all = jnp.concatenate([k_lat, k_ctx], axis=1)
    v_all = jnp.concatenate([v_lat, v_ctx], axis=1)
    nb = T // Q_BLOCK
    qb = q_lat.reshape(B, nb, Q_BLOCK, MLA_HEADS, QK_DIM).swapaxes(0, 1)
    o = lax.map(lambda qq: attend(qq, k_all, v_all), qb)
    out_lat = o.swapaxes(0, 1).reshape(B, T, MLA_HEADS * V_DIM) @ w_o
    out_ctx = None
    if need_ctx:
        Lc = h_ctx.shape[1]
        out_ctx = attend(q_ctx, k_ctx, v_ctx).reshape(B, Lc, MLA_HEADS * V_DIM) @ w_o
    return out_lat, out_ctx


def ec_moe(h, router, w_up, w_down):
    B, T, _ = h.shape
    cap = CAPACITY_FACTOR * T // N_EXPERTS
    aff = jax.nn.softmax((h @ router).astype(jnp.float32), axis=-1)
    gate, idx = lax.top_k(jnp.swapaxes(aff, 1, 2), cap)
    bidx = jnp.arange(B)[:, None, None]
    xg = h[bidx, idx]
    up = jnp.einsum('becd,edf->becf', xg, w_up)
    hid = jax.nn.silu(up[..., :D_EXPERT]) * up[..., D_EXPERT:]
    y = jnp.einsum('becf,efd->becd', hid, w_down) * gate[..., None].astype(h.dtype)
    return jnp.zeros_like(h).at[bidx, idx].add(y)


def setup_inputs(seed: int = 0) -> dict:
    key = jax.random.key(seed)
    ks = jax.random.split(key, 32)
    f32 = jnp.float32
    nrm = lambda k, shape, s: jax.random.normal(k, shape, f32) * s
    a0 = jax.random.uniform(ks[12], (N_A_LAYERS, 2, D_RNN), f32, 0.9, 0.999)
    return {
        "x": nrm(ks[0], (BATCH, SEQ, D_MODEL), 1.0),
        "c": nrm(ks[1], (BATCH, D_MODEL), 1.0),
        "ctx": nrm(ks[2], (BATCH, CTX_LEN, D_MODEL), 1.0),
        "c_ctx": nrm(ks[3], (D_MODEL,), 1.0),
        "ada_w": nrm(ks[4], (DEPTH, D_MODEL, 6 * D_MODEL), 0.5 * D_MODEL ** -0.5),
        "ada_b": nrm(ks[5], (DEPTH, 6 * D_MODEL), 0.01),
        "norm_mix": 1.0 + nrm(ks[6], (DEPTH, D_MODEL), 0.01),
        "norm_ffn": 1.0 + nrm(ks[7], (DEPTH, D_MODEL), 0.01),
        "norm_final": 1.0 + nrm(ks[8], (D_MODEL,), 0.01),
        "lru_w_in": nrm(ks[9], (N_A_LAYERS, D_MODEL, 2 * D_RNN), D_MODEL ** -0.5),
        "lru_conv_w": nrm(ks[10], (N_A_LAYERS, CONV_W, D_RNN), CONV_W ** -0.5),
        "lru_conv_b": nrm(ks[11], (N_A_LAYERS, D_RNN), 0.01),
        "lru_gate_w": nrm(ks[13], (N_A_LAYERS, 2, 2, LRU_BLOCKS, LRU_BLOCK, LRU_BLOCK), LRU_BLOCK ** -0.5),
        "lru_gate_b": nrm(ks[14], (N_A_LAYERS, 2, 2, D_RNN), 0.01),
        "lru_lambda": jnp.log(a0) - jnp.log1p(-a0),
        "lru_w_out": nrm(ks[15], (N_A_LAYERS, D_RNN, D_MODEL), D_RNN ** -0.5),
        "mla_w_in": nrm(ks[16], (N_B_LAYERS, D_MODEL, Q_LORA + KV_LORA + QK_ROPE), D_MODEL ** -0.5),
        "mla_q_norm": 1.0 + nrm(ks[17], (N_B_LAYERS, Q_LORA), 0.01),
        "mla_kv_norm": 1.0 + nrm(ks[18], (N_B_LAYERS, KV_LORA), 0.01),
        "mla_w_uq": nrm(ks[19], (N_B_LAYERS, Q_LORA, MLA_HEADS * QK_DIM), Q_LORA ** -0.5),
        "mla_w_ukv": nrm(ks[20], (N_B_LAYERS, KV_LORA, MLA_HEADS * (QK_NOPE + V_DIM)), KV_LORA ** -0.5),
        "mla_w_o": nrm(ks[21], (N_B_LAYERS, MLA_HEADS * V_DIM, D_MODEL), (MLA_HEADS * V_DIM) ** -0.5),
        "moe_router": nrm(ks[22], (DEPTH, D_MODEL, N_EXPERTS), D_MODEL ** -0.5),
        "moe_w_up": nrm(ks[23], (DEPTH, N_EXPERTS, D_MODEL, 2 * D_EXPERT), D_MODEL ** -0.5),
        "moe_w_down": nrm(ks[24], (DEPTH, N_EXPERTS, D_EXPERT, D_MODEL), D_EXPERT ** -0.5),
    }


def reference(x, c, ctx, c_ctx, ada_w, ada_b, norm_mix, norm_ffn, norm_final,
              lru_w_in, lru_conv_w, lru_conv_b, lru_gate_w, lru_gate_b, lru_lambda, lru_w_out,
              mla_w_in, mla_q_norm, mla_kv_norm, mla_w_uq, mla_w_ukv, mla_w_o,
              moe_router, moe_w_up, moe_w_down):
    T = x.shape[1]
    ROWS = T // GRID_W
    cos, sin = axial_rope(ROWS)
    for i in range(DEPTH):
        need_ctx = i < DEPTH - 1
        s1, sc1, g1, s2, sc2, g2 = adaln(c, ada_w[i], ada_b[i])
        s1c, sc1c, g1c, s2c, sc2c, g2c = adaln(c_ctx, ada_w[i], ada_b[i])
        h_lat = modulate(rmsnorm(x, norm_mix[i]), s1, sc1)
        h_ctx = modulate(rmsnorm(ctx, norm_mix[i]), s1c, sc1c)
        j = i // N_MIXERS
        if i % N_MIXERS == 0:
            o_lat, o_ctx = rglru_mixer(h_lat, h_ctx, lru_w_in[j], lru_conv_w[j], lru_conv_b[j],
                                       lru_gate_w[j], lru_gate_b[j], lru_lambda[j], lru_w_out[j], need_ctx)
        else:
            o_lat, o_ctx = mla_mixer(h_lat, h_ctx, mla_w_in[j], mla_q_norm[j], mla_kv_norm[j],
                                     mla_w_uq[j], mla_w_ukv[j], mla_w_o[j], cos, sin, need_ctx)
        x = x + g1 * o_lat
        x = x + g2 * ec_moe(modulate(rmsnorm(x, norm_ffn[i]), s2, sc2),
                            moe_router[i], moe_w_up[i], moe_w_down[i])
        if need_ctx:
            ctx = ctx + g1c * o_ctx
            ctx = ctx + g2c * ec_moe(modulate(rmsnorm(ctx, norm_ffn[i]), s2c, sc2c),
                                     moe_router[i], moe_w_up[i], moe_w_down[i])
    return rmsnorm(x, norm_final)
```

```cpp
#include <hip/hip_runtime.h>
#include <hip/hip_cooperative_groups.h>
#include <cstdio>
#include <cstdint>
namespace cg = cooperative_groups;

#ifndef DUP_MASK
#define DUP_MASK 0u
#endif
#ifndef MK_N_LAUNCHES
#define MK_N_LAUNCHES 1
#endif

#define LAS __attribute__((address_space(3)))
typedef unsigned short bf16_t;
typedef short bf16x8 __attribute__((ext_vector_type(8)));
typedef short s16x4 __attribute__((ext_vector_type(4)));
typedef float f32x2 __attribute__((ext_vector_type(2)));
typedef float f32x4 __attribute__((ext_vector_type(4)));
typedef float f32x16 __attribute__((ext_vector_type(16)));
typedef unsigned u32x2 __attribute__((ext_vector_type(2)));
typedef unsigned u32x4 __attribute__((ext_vector_type(4)));

constexpr int D = 1024, NB = 16, TL = 2048, TCX = 256, MLAT = NB * TL, MCTX = NB * TCX, MT = MLAT + MCTX;
constexpr int NE = 16, CAPL = 256, CAPC = 32, DEXP = 1024;
constexpr int MOE_LAT_ROWS = NB * NE * CAPL;
constexpr int MOE_ROWS0 = MOE_LAT_ROWS + NB * NE * CAPC;
constexpr int NH = 16, DQK = 96, DV = 64, QLORA = 384, KVLORA = 256, ZW = 768, SKV = TL + TCX;
constexpr float EPS = 1e-6f;
constexpr float QSCALE = 0.10206207261596575f * 1.4426950408889634f;

constexpr size_t MiB = 1u << 20;
constexpr size_t WS_MOD = 1 * MiB;
constexpr size_t WS_ROPE = 2 * MiB;
constexpr size_t WS_SSQ = 2 * MiB + 512 * 1024;
constexpr size_t WS_SSKV = WS_SSQ + 256 * 1024;
constexpr size_t WS_AFFL = 3 * MiB;
constexpr size_t WS_AFFC = 5 * MiB;
constexpr size_t WS_ROWIDX = 6 * MiB;
constexpr size_t WS_GATEV = 6 * MiB + 512 * 1024;
constexpr size_t WS_SEL = 7 * MiB;
constexpr size_t WS_WG = 10 * MiB;
constexpr size_t WS_WLIN = 16 * MiB;
constexpr size_t WS_WLOUT = 20 * MiB;
constexpr size_t WS_WMIN = 22 * MiB;
constexpr size_t WS_WUQ = 24 * MiB;
constexpr size_t WS_WUKV = 26 * MiB;
constexpr size_t WS_WO = 27 * MiB;
constexpr size_t WS_WUP = 32 * MiB;
constexpr size_t WS_WDN = 160 * MiB;
constexpr size_t WS_H = 224 * MiB;
constexpr size_t WS_G = 296 * MiB;
constexpr size_t WS_ZX = 368 * MiB;
constexpr size_t WS_YG = 440 * MiB;
constexpr size_t WS_Z = 296 * MiB;
constexpr size_t WS_Q = 352 * MiB;
constexpr size_t WS_X = 512 * MiB;
constexpr size_t WS_HID = 656 * MiB;
constexpr size_t WS_K = 656 * MiB;
constexpr size_t WS_Y = 800 * MiB;
constexpr size_t WS_V = 800 * MiB;
constexpr size_t WS_O = 872 * MiB;
constexpr size_t WS_END = 944 * MiB;

constexpr int LDS_BYTES = 147456;
constexpr int NWAVES = 8;

__device__ __forceinline__ unsigned cvt_pk_bf16(float lo, float hi) { unsigned r; asm volatile("v_cvt_pk_bf16_f32 %0, %1, %2" : "=v"(r) : "v"(lo), "v"(hi)); return r; }
__device__ __forceinline__ float bf2f(unsigned short h) { return __uint_as_float(((unsigned)h) << 16); }
__device__ __forceinline__ float wave_sum(float v) {
#pragma unroll
    for (int o = 1; o < 64; o <<= 1) v += __shfl_xor(v, o);
    return v;
}
__device__ __forceinline__ int wave_isum(int v) {
#pragma unroll
    for (int o = 1; o < 64; o <<= 1) v += __shfl_xor(v, o);
    return v;
}
__device__ __forceinline__ float sigmoidf_(float x) { return 1.0f / (1.0f + __expf(-x)); }
__device__ __forceinline__ float gelu_tanh(float x) {
    constexpr float A = 1.5957691216057308f * 1.4426950408889634f, B = A * 0.044715f;
    const float w = x * (A + B * (x * x));
    return x * __builtin_amdgcn_rcpf(1.0f + __builtin_amdgcn_exp2f(-w));
}

namespace pg8 {
constexpr int BM = 256, BK = 64, HALF = 128, HTB = HALF * BK * 2, STAGE_BYTES = 8 * HTB;
__device__ __forceinline__ int lds_byte(int r, int c) { const int st = (r >> 4) * 2 + (c >> 5), rr = r & 15, cc = c & 31, ob = rr * 64 + cc * 2; return st * 1024 + (ob ^ (((ob >> 9) & 1) << 5)); }
__device__ __forceinline__ void stage_rc(int b, int& R, int& C) { const int st = b / 1024, sb = b % 1024, swz = sb ^ (((sb >> 9) & 1) << 5); R = (st >> 1) * 16 + swz / 64; C = (st & 1) * 32 + (swz % 64) / 2; }
__device__ __forceinline__ int perm32(int rho) { const int n = rho >> 4, i = rho & 15; return 8 * (i >> 2) + 4 * n + (i & 3); }

struct Unit { int pm, pn, arow, boff; };

struct DenseOrder {
    int nM, nN, nwg, G, c, K;
    __device__ __forceinline__ void init(int M, int N, int K_, int G_, int c_) { nM = M / BM; nN = N / BM; nwg = nM * nN; G = G_; c = c_; K = K_; }
    __device__ __forceinline__ bool next(int i, Unit& u) const {
        const long L = (long)i * G + c; if (L >= nwg) return false;
        int wgid = (int)L; { const int q = nwg / 8, r = nwg % 8, xcd = wgid % 8, off = wgid / 8; wgid = (xcd < r ? xcd * (q + 1) : r * (q + 1) + (xcd - r) * q) + off; }
        const int nig = 8 * nN, gid = wgid / nig, fm = gid * 8, gsz = (nM - fm) < 8 ? (nM - fm) : 8;
        u.pm = fm + ((wgid % nig) % gsz); u.pn = (wgid % nig) / gsz; u.arow = u.pm * BM; u.boff = u.pn * BM * K; return true;
    }
};
struct MoeOrder {
    int nRT, nPN, G, vc, Nexp;
    __device__ __forceinline__ void init(int nRT_, int nPN_, int Nexp_, int G_, int c_) { nRT = nRT_; nPN = nPN_; Nexp = Nexp_; G = G_; vc = (G_ % 8 == 0) ? (c_ % 8) * (G_ / 8) + c_ / 8 : c_; }
    __device__ __forceinline__ bool next(int i, Unit& u) const {
        const long L = (long)i * G + vc; if (L >= (long)nRT * nPN) return false;
        const int rt = (int)(L / nPN), pn = (int)(L % nPN);
        const int e = rt < 256 ? (rt >> 4) : ((rt - 256) >> 1);
        u.pm = rt; u.pn = pn; u.arow = rt * BM; u.boff = (e * Nexp + pn * BM) * 1024; return true;
    }
};

template <class Epi, class Sched, bool GATHER>
__device__ __forceinline__ void gemm_phase(LAS unsigned char* lds, const bf16_t* A, int lda, const bf16_t* Bt, int K, const Sched& S, const Epi& E, const LAS unsigned* gidx) {
    const int tid = threadIdx.x, wid = __builtin_amdgcn_readfirstlane(tid >> 6), lane = tid & 63, wr = wid >> 2, wc = wid & 3, fr = lane & 15, fq = lane >> 4;
    const int nt = K / BK;
    int RA[2]; unsigned CA2[2], voffB[2];
#pragma unroll
    for (int i = 0; i < 2; ++i) { int R, C; stage_rc(tid * 16 + i * 8192, R, C); const int Rb = Epi::PERM ? ((R & ~31) + perm32(R & 31)) : R;
        RA[i] = R; CA2[i] = (unsigned)C * 2u; voffB[i] = (unsigned)(Rb * K + C) * 2u; }
    const size_t kstep = (size_t)(BK * 2);
    const size_t hstepB = (size_t)HALF * K * 2;
    const unsigned ldsw = (unsigned)wid * 1024u;
    const int aoff = lds_byte(wr * 64 + fr, fq * 8), boff = lds_byte(wc * 32 + fr, fq * 8);
    const char* Ab = (const char*)A; const char* Bb = (const char*)Bt;
#define PG8_SA(b, h) (((b) * 2 + (h)) * HTB)
#define PG8_SB(b, h) ((4 + (b) * 2 + (h)) * HTB)
#define PG8_STAGE(bufoff, gbase, voff) do { _Pragma("unroll") for (int _i = 0; _i < 2; ++_i) \
        __builtin_amdgcn_global_load_lds((const unsigned*)((const char*)(gbase) + (voff)[_i]), (LAS unsigned*)(lds + (bufoff) + ldsw + _i * 8192), 16, 0, 0); } while (0)
#define PG8_LDA(dst, b, h) do { _Pragma("unroll") for (int m = 0; m < 4; ++m) _Pragma("unroll") for (int k = 0; k < 2; ++k) dst[m][k] = *(const LAS bf16x8*)(lds + PG8_SA(b, h) + aoff + m * 2048 + k * 1024); } while (0)
#define PG8_LDB(dst, b, h) do { _Pragma("unroll") for (int n = 0; n < 2; ++n) _Pragma("unroll") for (int k = 0; k < 2; ++k) dst[n][k] = *(const LAS bf16x8*)(lds + PG8_SB(b, h) + boff + n * 2048 + k * 1024); } while (0)
#define PG8_MMA(ai, bj, At, Bt_) do { __builtin_amdgcn_s_setprio(1); _Pragma("unroll") for (int m = 0; m < 4; ++m) _Pragma("unroll") for (int n = 0; n < 2; ++n) _Pragma("unroll") for (int k = 0; k < 2; ++k) \
        acc[ai][bj][m][n] = __builtin_amdgcn_mfma_f32_16x16x32_bf16(Bt_[n][k], At[m][k], acc[ai][bj][m][n], 0, 0, 0); __builtin_amdgcn_s_setprio(0); } while (0)
#define PG8_WAIT_V(n) asm volatile("s_waitcnt vmcnt(" #n ")" ::: "memory")
#define PG8_WAIT_L(n) asm volatile("s_waitcnt lgkmcnt(" #n ")" ::: "memory")
#define PG8_BAR __builtin_amdgcn_s_barrier()
#define PG8_SCHED __builtin_amdgcn_sched_barrier(0)
#define PG8_SET_AOFF(ao, u, uidx) do { _Pragma("unroll") for (int _h = 0; _h < 2; ++_h) _Pragma("unroll") for (int _i = 0; _i < 2; ++_i) \
        ao[_h][_i] = (GATHER ? gidx[(uidx) * 256 + _h * 128 + RA[_i]] : (unsigned)(((u).arow + _h * 128 + RA[_i]) * lda) * 2u) + CA2[_i]; } while (0)
    Unit cur, nxt; int ui = 0;
    if (!S.next(0, cur)) return;
    f32x4 acc[2][2][4][2];
#pragma unroll
    for (int a = 0; a < 2; ++a)
#pragma unroll
        for (int b = 0; b < 2; ++b)
#pragma unroll
            for (int m = 0; m < 4; ++m)
#pragma unroll
                for (int n = 0; n < 2; ++n) acc[a][b][m][n] = (f32x4){0.f, 0.f, 0.f, 0.f};
    bf16x8 At[4][2], B0[2][2], B1[2][2];
    unsigned aoc[2][2], aon[2][2];
    PG8_SET_AOFF(aoc, cur, 0);
    const char* cB = Bb + (size_t)cur.boff * 2;
    PG8_STAGE(PG8_SB(0, 0), cB, voffB); PG8_STAGE(PG8_SB(0, 1), cB + hstepB, voffB); PG8_STAGE(PG8_SA(0, 0), Ab, aoc[0]); PG8_STAGE(PG8_SA(0, 1), Ab, aoc[1]);
    if (wr == 1) PG8_BAR;
    PG8_WAIT_V(2); PG8_BAR;
    PG8_STAGE(PG8_SB(1, 0), cB + kstep, voffB); PG8_STAGE(PG8_SA(1, 0), Ab + kstep, aoc[0]); PG8_STAGE(PG8_SB(1, 1), cB + hstepB + kstep, voffB);
    PG8_WAIT_V(6); PG8_BAR;
    for (;;) {
        const bool has_next = S.next(ui + 1, nxt);
        const char* nB = has_next ? Bb + (size_t)nxt.boff * 2 : cB;
        if (has_next) { PG8_SET_AOFF(aon, nxt, ui + 1); }
        else {
#pragma unroll
            for (int _h = 0; _h < 2; ++_h)
#pragma unroll
                for (int _i = 0; _i < 2; ++_i) aon[_h][_i] = aoc[_h][_i]; }
#pragma unroll 1
        for (int t = 0; t < nt; t += 2) {
            const bool last = (t == nt - 2);
            const char* a1 = Ab + (size_t)(t + 1) * kstep;
            const char* a2 = last ? Ab : Ab + (size_t)(t + 2) * kstep; const char* b2 = last ? nB : cB + (size_t)(t + 2) * kstep;
            const char* a3 = a2 + kstep; const char* b3 = b2 + kstep;
            unsigned a2o[2][2];
#pragma unroll
            for (int _h = 0; _h < 2; ++_h)
#pragma unroll
                for (int _i = 0; _i < 2; ++_i) a2o[_h][_i] = last ? aon[_h][_i] : aoc[_h][_i];
            PG8_LDB(B0, 0, 0); PG8_LDB(B1, 0, 1); PG8_SCHED; PG8_LDA(At, 0, 0); PG8_STAGE(PG8_SA(1, 1), a1, aoc[1]);
            PG8_WAIT_V(8); PG8_WAIT_L(0); PG8_BAR; PG8_MMA(0, 0, At, B0); PG8_MMA(0, 1, At, B1); PG8_BAR; PG8_SCHED;
            PG8_LDA(At, 0, 1); PG8_STAGE(PG8_SB(0, 0), b2, voffB); PG8_STAGE(PG8_SB(0, 1), b2 + hstepB, voffB); PG8_STAGE(PG8_SA(0, 0), a2, a2o[0]);
            PG8_WAIT_V(8); PG8_WAIT_L(0); PG8_BAR; PG8_MMA(1, 0, At, B0); PG8_MMA(1, 1, At, B1); PG8_BAR; PG8_SCHED;
            PG8_LDB(B0, 1, 0); PG8_LDB(B1, 1, 1); PG8_SCHED; PG8_LDA(At, 1, 0); PG8_STAGE(PG8_SA(0, 1), a2, a2o[1]);
            PG8_WAIT_V(8); PG8_WAIT_L(0); PG8_BAR; PG8_MMA(0, 0, At, B0); PG8_MMA(0, 1, At, B1); PG8_BAR; PG8_SCHED;
            PG8_LDA(At, 1, 1); PG8_STAGE(PG8_SB(1, 0), b3, voffB); PG8_STAGE(PG8_SB(1, 1), b3 + hstepB, voffB); PG8_STAGE(PG8_SA(1, 0), a3, a2o[0]);
            PG8_WAIT_V(8); PG8_WAIT_L(0); PG8_BAR; PG8_MMA(1, 0, At, B0); PG8_MMA(1, 1, At, B1); PG8_BAR; PG8_SCHED;
        }
        if (wr == 0) PG8_BAR;
        E(acc, cur, wr, wc, fr, fq);
        if (!has_next) break;
#pragma unroll
        for (int a = 0; a < 2; ++a)
#pragma unroll
            for (int b = 0; b < 2; ++b)
#pragma unroll
                for (int m = 0; m < 4; ++m)
#pragma unroll
                    for (int n = 0; n < 2; ++n) acc[a][b][m][n] = (f32x4){0.f, 0.f, 0.f, 0.f};
        cur = nxt; cB = nB; ++ui;
#pragma unroll
        for (int _h = 0; _h < 2; ++_h)
#pragma unroll
            for (int _i = 0; _i < 2; ++_i) aoc[_h][_i] = aon[_h][_i];
        if (wr == 1) PG8_BAR;
    }
    PG8_WAIT_V(0);
    PG8_BAR;
#undef PG8_SA
#undef PG8_SB
#undef PG8_STAGE
#undef PG8_LDA
#undef PG8_LDB
#undef PG8_MMA
#undef PG8_WAIT_V
#undef PG8_WAIT_L
#undef PG8_BAR
#undef PG8_SCHED
#undef PG8_SET_AOFF
}

#define EPI_ARGS const f32x4 (&acc)[2][2][4][2], const Unit& u, int wr, int wc, int fr, int fq
__device__ __forceinline__ u32x4 pack8(const f32x4& a, const f32x4& b) { u32x4 w; w.x = cvt_pk_bf16(a[0], a[1]); w.y = cvt_pk_bf16(a[2], a[3]); w.z = cvt_pk_bf16(b[0], b[1]); w.w = cvt_pk_bf16(b[2], b[3]); return w; }

__device__ __forceinline__ int coalesce_addr(int lane) { return (16 * (lane & 3) + (lane >> 2)) << 2; }
__device__ __forceinline__ u32x4 coalesce16(const u32x4& w, int paddr) {
    u32x4 r; r.x = (unsigned)__builtin_amdgcn_ds_bpermute(paddr, (int)w.x); r.y = (unsigned)__builtin_amdgcn_ds_bpermute(paddr, (int)w.y);
    r.z = (unsigned)__builtin_amdgcn_ds_bpermute(paddr, (int)w.z); r.w = (unsigned)__builtin_amdgcn_ds_bpermute(paddr, (int)w.w); return r;
}
struct EpiLruIn {
    static constexpr bool PERM = true;
    bf16_t* G; bf16_t* ZX;
    __device__ __forceinline__ void operator()(EPI_ARGS) const {
        const bool act = u.pn < 4; bf16_t* base = act ? G : ZX; const int colt = (u.pn & 3) * BM;
        const int lane = fq * 16 + fr, pa = coalesce_addr(lane), rl = lane >> 2, cl = lane & 3;
        const int rowdst = u.pm * BM + wr * 64 + rl, col0 = colt + wc * 32 + 8 * cl;
#pragma unroll
        for (int ai = 0; ai < 2; ++ai)
#pragma unroll
            for (int m = 0; m < 4; ++m) { bf16_t* rowp = base + (size_t)(rowdst + ai * HALF + m * 16) * D + col0;
#pragma unroll
                for (int bj = 0; bj < 2; ++bj) { f32x4 v0 = acc[ai][bj][m][0], v1 = acc[ai][bj][m][1];
                    if (act) {
#pragma unroll
                        for (int j = 0; j < 4; ++j) { v0[j] = gelu_tanh(v0[j]); v1[j] = gelu_tanh(v1[j]); } }
                    *(u32x4*)(rowp + bj * HALF) = coalesce16(pack8(v0, v1), pa); } }
    }
};
template <bool BASE_BF16> struct EpiResid {
    static constexpr bool PERM = true;
    const float* base_lat; const float* base_ctx; bf16_t* X; const float* modl;
    __device__ __forceinline__ void operator()(EPI_ARGS) const {
        const int rowt = u.pm * BM; const bool isl = rowt < MLAT;
        const float* bs = isl ? base_lat + (size_t)rowt * D : base_ctx + (size_t)(rowt - MLAT) * D;
        const int bidx = isl ? rowt / TL : 16;
        const float* gv = modl + bidx * 6144 + 2 * D;
        bf16_t* xo = X + (size_t)rowt * D;
        const int lane = fq * 16 + fr, pa = coalesce_addr(lane), rl = lane >> 2, cl = lane & 3;
        const int cols = u.pn * BM + wc * 32 + 8 * fq; int cold = u.pn * BM + wc * 32 + 8 * cl, r0 = wr * 64 + rl;
        asm volatile("" : "+v"(cold), "+v"(r0));
        f32x4 g[2][2];
#pragma unroll
        for (int bj = 0; bj < 2; ++bj)
#pragma unroll
            for (int n = 0; n < 2; ++n) g[bj][n] = *(const f32x4*)(gv + cols + bj * HALF + n * 4);
        constexpr int RDEPTH = 3;
        f32x4 bf[8][2][2]; u32x4 bw[8][2];
#define RESID_LOAD(s_) do { const size_t off_ = (size_t)(r0 + ((s_) >> 2) * HALF + ((s_) & 3) * 16) * D + cold; _Pragma("unroll") for (int bj = 0; bj < 2; ++bj) { \
            if (BASE_BF16) bw[s_][bj] = *(const u32x4*)(xo + off_ + bj * HALF); \
            else { bf[s_][bj][0] = *(const f32x4*)(bs + off_ + bj * HALF); bf[s_][bj][1] = *(const f32x4*)(bs + off_ + bj * HALF + 4); } } } while (0)
#pragma unroll
        for (int s = 0; s < RDEPTH; ++s) RESID_LOAD(s);
#pragma unroll
        for (int s = 0; s < 8; ++s) { const int ai = s >> 2, m = s & 3; const size_t off = (size_t)(r0 + ai * HALF + m * 16) * D + cold;
            if (s + RDEPTH < 8) RESID_LOAD(s + RDEPTH);
            asm volatile("" ::: "memory");
#pragma unroll
            for (int bj = 0; bj < 2; ++bj) { f32x4 b0, b1;
                if (BASE_BF16) { const u32x4 w = bw[s][bj];
                    b0 = (f32x4){__uint_as_float(w.x << 16), __uint_as_float(w.x & 0xffff0000u), __uint_as_float(w.y << 16), __uint_as_float(w.y & 0xffff0000u)};
                    b1 = (f32x4){__uint_as_float(w.z << 16), __uint_as_float(w.z & 0xffff0000u), __uint_as_float(w.w << 16), __uint_as_float(w.w & 0xffff0000u)}; }
                else { b0 = bf[s][bj][0]; b1 = bf[s][bj][1]; }
                const u32x4 d = coalesce16(pack8(g[bj][0] * acc[ai][bj][m][0], g[bj][1] * acc[ai][bj][m][1]), pa);
                const f32x4 d0 = (f32x4){__uint_as_float(d.x << 16), __uint_as_float(d.x & 0xffff0000u), __uint_as_float(d.y << 16), __uint_as_float(d.y & 0xffff0000u)};
                const f32x4 d1 = (f32x4){__uint_as_float(d.z << 16), __uint_as_float(d.z & 0xffff0000u), __uint_as_float(d.w << 16), __uint_as_float(d.w & 0xffff0000u)};
                *(u32x4*)(xo + off + bj * HALF) = pack8(b0 + d0, b1 + d1); }
            asm volatile("" ::: "memory"); }
#undef RESID_LOAD
    }
};
struct EpiZ {
    static constexpr bool PERM = true;
    bf16_t* Z; float* ssq; float* sskv;
    __device__ __forceinline__ void operator()(EPI_ARGS) const {
        const int lane = fq * 16 + fr, pa = coalesce_addr(lane), rl = lane >> 2, cl = lane & 3;
        const int rowsrc = u.pm * BM + wr * 64 + fr, rowdst = u.pm * BM + wr * 64 + rl, col0 = u.pn * BM + wc * 32 + 8 * cl;
#pragma unroll
        for (int ai = 0; ai < 2; ++ai)
#pragma unroll
            for (int m = 0; m < 4; ++m) { const int row = rowsrc + ai * HALF + m * 16; bf16_t* rowp = Z + (size_t)(rowdst + ai * HALF + m * 16) * ZW + col0;
#pragma unroll
                for (int bj = 0; bj < 2; ++bj) { const f32x4 v0 = acc[ai][bj][m][0], v1 = acc[ai][bj][m][1];
                    *(u32x4*)(rowp + bj * HALF) = coalesce16(pack8(v0, v1), pa);
                    const int hb = 2 * u.pn + bj;
                    if (hb < 5) { float s = (v0[0] * v0[0] + v0[1] * v0[1]) + (v0[2] * v0[2] + v0[3] * v0[3]) + (v1[0] * v1[0] + v1[1] * v1[1]) + (v1[2] * v1[2] + v1[3] * v1[3]);
                        s += __shfl_xor(s, 16); s += __shfl_xor(s, 32);
                        if (fq == 0) atomicAdd((hb < 3 ? ssq : sskv) + row, s); } } }
    }
};
struct EpiQ {
    static constexpr bool PERM = true;
    bf16_t* Q; const float* ssq; const float* rope;
    __device__ __forceinline__ void operator()(EPI_ARGS) const {
        const int row0 = u.pm * BM + wr * 64 + fr;
#pragma unroll
        for (int bj = 0; bj < 2; ++bj) {
            const int c0 = u.pn * BM + bj * HALF + wc * 32 + 8 * fq; const int h = c0 / DQK, dd = c0 - h * DQK;
            const bool isrope = dd >= 64; const int axis = (dd - 64) >> 4;
#pragma unroll
            for (int ai = 0; ai < 2; ++ai)
#pragma unroll
                for (int m = 0; m < 4; ++m) { const int row = row0 + ai * HALF + m * 16; const int b = row / TL, t = row - b * TL;
                    const float rs = rsqrtf(ssq[row] * (1.0f / QLORA) + EPS) * QSCALE;
                    f32x4 v0 = acc[ai][bj][m][0] * rs, v1 = acc[ai][bj][m][1] * rs;
                    if (isrope) {
                        const int pos = axis == 0 ? (t >> 6) : (t & 63);
                        const f32x4* cs = (const f32x4*)(rope + pos * 16);
                        const f32x4 t0 = cs[0], t1 = cs[1], t2 = cs[2], t3 = cs[3];
                        const float cosv[8] = {t0[0], t0[2], t1[0], t1[2], t2[0], t2[2], t3[0], t3[2]}, sinv[8] = {t0[1], t0[3], t1[1], t1[3], t2[1], t2[3], t3[1], t3[3]};
                        const bool second = fq & 1;
#pragma unroll
                        for (int j = 0; j < 4; ++j) { const float p0 = __shfl_xor(v0[j], 16), p1 = __shfl_xor(v1[j], 16);
                            v0[j] = second ? (p0 * sinv[j] + v0[j] * cosv[j]) : (v0[j] * cosv[j] - p0 * sinv[j]);
                            v1[j] = second ? (p1 * sinv[4 + j] + v1[j] * cosv[4 + j]) : (v1[j] * cosv[4 + j] - p1 * sinv[4 + j]); } }
                    { const int lane = fq * 16 + fr; const int rowd = u.pm * BM + wr * 64 + ai * HALF + m * 16 + (lane >> 2); const int bd = rowd / TL, td = rowd - bd * TL;
                      const int cd = u.pn * BM + bj * HALF + wc * 32 + 8 * (lane & 3); const int hd = cd / DQK, ddd = cd - hd * DQK;
                      *(u32x4*)(Q + ((size_t)(bd * NH + hd) * TL + td) * DQK + ddd) = coalesce16(pack8(v0, v1), coalesce_addr(lane)); }
                    asm volatile("" ::: "memory"); }
        }
    }
};
struct EpiKV {
    static constexpr bool PERM = true;
    bf16_t* Kc; bf16_t* Vc; const float* sskv;
    __device__ __forceinline__ void operator()(EPI_ARGS) const {
        const int rowt = u.pm * BM; const bool isl = rowt < MLAT;
        const int b = isl ? rowt / TL : (rowt - MLAT) / TCX; const int key0 = isl ? rowt - b * TL : TL + (rowt - MLAT - b * TCX);
        const int lane = fq * 16 + fr, pa = coalesce_addr(lane), rl = lane >> 2, cl = lane & 3;
        const int rsrc = wr * 64 + fr, rdst = wr * 64 + rl; const bool isv = wc >= 2; const int cc = (wc & 1) * 32 + 8 * cl;
#pragma unroll
        for (int ai = 0; ai < 2; ++ai)
#pragma unroll
            for (int m = 0; m < 4; ++m) { const float rs = rsqrtf(sskv[rowt + rsrc + ai * HALF + m * 16] * (1.0f / KVLORA) + EPS); const int rd = rdst + ai * HALF + m * 16;
#pragma unroll
                for (int bj = 0; bj < 2; ++bj) { const int h = 2 * u.pn + bj; const size_t kr = (size_t)(b * NH + h) * SKV + key0 + rd;
                    bf16_t* dst = isv ? Vc + kr * DV + cc : Kc + kr * DQK + cc;
                    *(u32x4*)dst = coalesce16(pack8(acc[ai][bj][m][0] * rs, acc[ai][bj][m][1] * rs), pa); } }
    }
};
struct EpiUp {
    static constexpr bool PERM = true;
    bf16_t* HID;
    __device__ __forceinline__ void operator()(EPI_ARGS) const {
        const int lane = fq * 16 + fr, pa = coalesce_addr(lane), rl = lane >> 2, cl = lane & 3;
        const int rowdst = u.pm * BM + wr * 64 + rl, col0 = u.pn * HALF + wc * 32 + 8 * cl;
#pragma unroll
        for (int ai = 0; ai < 2; ++ai)
#pragma unroll
            for (int m = 0; m < 4; ++m) { f32x4 o0, o1;
#pragma unroll
                for (int j = 0; j < 4; ++j) { const float g0 = acc[ai][0][m][0][j], g1 = acc[ai][0][m][1][j];
                    o0[j] = g0 * __builtin_amdgcn_rcpf(1.0f + __builtin_amdgcn_exp2f(-g0)) * acc[ai][1][m][0][j]; o1[j] = g1 * __builtin_amdgcn_rcpf(1.0f + __builtin_amdgcn_exp2f(-g1)) * acc[ai][1][m][1][j]; }
                *(u32x4*)(HID + (size_t)(rowdst + ai * HALF + m * 16) * DEXP + col0) = coalesce16(pack8(o0, o1), pa); }
    }
};
struct EpiDown {
    static constexpr bool PERM = true;
    bf16_t* Y; const float* gatev;
    __device__ __forceinline__ void operator()(EPI_ARGS) const {
        const int lane = fq * 16 + fr, pa = coalesce_addr(lane), rl = lane >> 2, cl = lane & 3;
        const int rowsrc = u.pm * BM + wr * 64 + fr, rowdst = u.pm * BM + wr * 64 + rl, col0 = u.pn * BM + wc * 32 + 8 * cl;
#pragma unroll
        for (int ai = 0; ai < 2; ++ai)
#pragma unroll
            for (int m = 0; m < 4; ++m) { const float gsc = gatev[rowsrc + ai * HALF + m * 16]; bf16_t* rowp = Y + (size_t)(rowdst + ai * HALF + m * 16) * D + col0;
#pragma unroll
                for (int bj = 0; bj < 2; ++bj) *(u32x4*)(rowp + bj * HALF) = coalesce16(pack8(acc[ai][bj][m][0] * gsc, acc[ai][bj][m][1] * gsc), pa); }
    }
};
}


#define XB_TMO      128
#define XB_XCNT(j)  (256  + 64 * (j))
#define XB_XSUB(j)  (1280 + 64 * (j))
#define XB_XGEN(j)  (2304 + 64 * (j))
#define XB_TOP      3328
#define XB_TOPGEN   3392
#define XCD_BAR_WORDS 3456
#define XB_SPIN_CAP (1u << 20)
__device__ __forceinline__ unsigned xb_ld(unsigned* p)              { return __hip_atomic_load(p, __ATOMIC_RELAXED, __HIP_MEMORY_SCOPE_AGENT); }
__device__ __forceinline__ unsigned xb_add(unsigned* p, unsigned v) { return __hip_atomic_fetch_add(p, v, __ATOMIC_RELAXED, __HIP_MEMORY_SCOPE_AGENT); }
__device__ __forceinline__ unsigned xb_xcc_id() { return (unsigned)__builtin_amdgcn_s_getreg((3 << 11) | 20) & 0xFu; }
#define XB_SPIN(cond, bar) do { unsigned _sp = 0; while (cond) { __builtin_amdgcn_s_sleep(1); \
    if ((++_sp & 255u) == 0u) { if (xb_ld(&(bar)[XB_TMO])) break; if (_sp > XB_SPIN_CAP) { atomicAdd(&(bar)[XB_TMO], 1u); break; } } } } while (0)
struct XcdBarrier { unsigned* bar; unsigned x; volatile LAS unsigned* st; };
__device__ __forceinline__ XcdBarrier xcd_barrier_post(unsigned* bar, volatile LAS unsigned* st) {
    XcdBarrier b; b.bar = bar; b.x = xb_xcc_id(); b.st = st;
    if (threadIdx.x == 0) (void)xb_add(&bar[XB_XCNT(b.x)], 1u);
    return b;
}
__device__ __forceinline__ void xcd_barrier_complete(unsigned* bar, unsigned x, unsigned& nloc, unsigned& nx) {
    const unsigned G = gridDim.x * gridDim.y * gridDim.z;
    unsigned sum, cnt, mine, sp = 0u;
    for (;;) {
        sum = 0u; cnt = 0u; mine = 0u;
#pragma unroll
        for (unsigned j = 0; j < 16; ++j) { const unsigned c = xb_ld(&bar[XB_XCNT(j)]); sum += c; cnt += (c > 0u) ? 1u : 0u; mine = (j == x) ? c : mine; }
        if (sum == G) break;
        __builtin_amdgcn_s_sleep(1);
        if ((++sp & 255u) == 0u) { if (xb_ld(&bar[XB_TMO])) break; if (sp > XB_SPIN_CAP) { atomicAdd(&bar[XB_TMO], 1u); break; } }
    }
    nloc = mine > 0u ? mine : 1u; nx = cnt > 0u ? cnt : 1u;
}
__device__ __forceinline__ void xcd_barrier(const XcdBarrier& b) {
    asm volatile("s_waitcnt vmcnt(0)" ::: "memory");
    __syncthreads();
    if (threadIdx.x == 0) {
        unsigned* bar = b.bar;
        __builtin_amdgcn_s_waitcnt(0);
        unsigned nloc = b.st[0], nx = b.st[1];
        if (nloc == 0u) { xcd_barrier_complete(bar, b.x, nloc, nx); b.st[0] = nloc; b.st[1] = nx; }
        const unsigned old = xb_add(&bar[XB_XSUB(b.x)], 1u);
        const unsigned gen = old / nloc;
        if (old + 1u == (gen + 1u) * nloc) {
            __builtin_amdgcn_fence(__ATOMIC_RELEASE, "agent");
            asm volatile("s_waitcnt vmcnt(0)" ::: "memory");
            const unsigned og = xb_add(&bar[XB_TOP], 1u);
            const unsigned tg = og / nx;
            if (og + 1u == (tg + 1u) * nx) xb_add(&bar[XB_TOPGEN], 1u);
            else XB_SPIN(xb_ld(&bar[XB_TOPGEN]) == tg, bar);
            __builtin_amdgcn_fence(__ATOMIC_ACQUIRE, "agent");
            xb_add(&bar[XB_XGEN(b.x)], 1u);
            asm volatile("s_waitcnt vmcnt(0)" ::: "memory");
        } else {
            XB_SPIN(xb_ld(&bar[XB_XGEN(b.x)]) == gen, bar);
            __builtin_amdgcn_fence(__ATOMIC_ACQUIRE, "agent");
            asm volatile("s_waitcnt vmcnt(0)" ::: "memory");
        }
    }
    __syncthreads();
}

struct Args { const float* in[25]; float* out; unsigned char* ws; int ph_lo, ph_hi; };
enum { I_X = 0, I_C, I_CTX, I_CCTX, I_ADAW, I_ADAB, I_NMIX, I_NFFN, I_NFIN, I_LWIN, I_LCW, I_LCB, I_LGW, I_LGB, I_LLAM, I_LWOUT, I_MWIN, I_MQN, I_MKVN, I_MWUQ, I_MWUKV, I_MWO, I_ROUTER, I_WUP, I_WDN };

struct Frame {
    LAS unsigned char* lds;
    int tid, lane, wave, G, bid;
    const Args* a;
    unsigned char* ws;
};
#define WSP(T, off) ((T*)(F.ws + (off)))

struct TItem { const float* W; bf16_t* WT; const float* ks; int ldw, nvalid, K, k0, n0, drow0; float scale; };
__device__ __forceinline__ TItem titem_decode(const Args& A, unsigned char* ws, int it) {
    constexpr int J0 = 32 * 16 * 32, J1 = 32 * 16 * 16, J2 = 16 * 32, J3 = 16 * 16, J4 = 16 * 12, J5 = 6 * 24, J6 = 4 * 32, J7 = 16 * 16;
    TItem t; t.ks = nullptr; t.scale = 1.0f; int r = it;
    if (r < J0) { const int mat = r / 512, q = r % 512, kb = q / 32, nb = q % 32; const int n0 = nb * 64; const int j = n0 & 1023;
        t.W = A.in[I_WUP] + (size_t)mat * 1024 * 2048; t.ldw = 2048; t.nvalid = 2048; t.WT = (bf16_t*)(ws + WS_WUP) + (size_t)mat * 2048 * 1024; t.K = 1024; t.k0 = kb * 64; t.n0 = n0; t.drow0 = (j >> 7) * 256 + (n0 >= 1024 ? 128 : 0) + (j & 127); t.scale = n0 >= 1024 ? 0.6931471805599453f : 1.4426950408889634f; return t; } r -= J0;
    if (r < J1) { const int mat = r / 256, q = r % 256, kb = q / 16, nb = q % 16;
        t.W = A.in[I_WDN] + (size_t)mat * 1024 * 1024; t.ldw = 1024; t.nvalid = 1024; t.WT = (bf16_t*)(ws + WS_WDN) + (size_t)mat * 1024 * 1024; t.K = 1024; t.k0 = kb * 64; t.n0 = nb * 64; t.drow0 = nb * 64; return t; } r -= J1;
    if (r < J2) { const int kb = r / 32, nb = r % 32; t.W = A.in[I_LWIN]; t.ldw = 2048; t.nvalid = 2048; t.WT = (bf16_t*)(ws + WS_WLIN); t.K = 1024; t.k0 = kb * 64; t.n0 = nb * 64; t.drow0 = nb * 64; return t; } r -= J2;
    if (r < J3) { const int kb = r / 16, nb = r % 16; t.W = A.in[I_LWOUT]; t.ldw = 1024; t.nvalid = 1024; t.WT = (bf16_t*)(ws + WS_WLOUT); t.K = 1024; t.k0 = kb * 64; t.n0 = nb * 64; t.drow0 = nb * 64; return t; } r -= J3;
    if (r < J4) { const int kb = r / 12, nb = r % 12; t.W = A.in[I_MWIN]; t.ldw = 672; t.nvalid = 672; t.WT = (bf16_t*)(ws + WS_WMIN); t.K = 1024; t.k0 = kb * 64; t.n0 = nb * 64; t.drow0 = nb * 64; return t; } r -= J4;
    if (r < J5) { const int kb = r / 24, nb = r % 24; t.W = A.in[I_MWUQ]; t.ldw = 1536; t.nvalid = 1536; t.WT = (bf16_t*)(ws + WS_WUQ); t.K = 384; t.k0 = kb * 64; t.n0 = nb * 64; t.drow0 = nb * 64; t.ks = A.in[I_MQN]; return t; } r -= J5;
    if (r < J6) { const int kb = r / 32, nb = r % 32; t.W = A.in[I_MWUKV]; t.ldw = 2048; t.nvalid = 2048; t.WT = (bf16_t*)(ws + WS_WUKV); t.K = 256; t.k0 = kb * 64; t.n0 = nb * 64; t.drow0 = nb * 64; t.ks = A.in[I_MKVN]; return t; } r -= J6;
    if (r < J7) { const int kb = r / 16, nb = r % 16; t.W = A.in[I_MWO]; t.ldw = 1024; t.nvalid = 1024; t.WT = (bf16_t*)(ws + WS_WO); t.K = 1024; t.k0 = kb * 64; t.n0 = nb * 64; t.drow0 = nb * 64; return t; } r -= J7;
    { const int mat = r / 4, q = r % 4, kb = q / 2, nb = q % 2; const int d = mat >> 4, g = (mat >> 3) & 1, n = mat & 7;
        t.W = A.in[I_LGW] + (size_t)mat * 128 * 128; t.ldw = 128; t.nvalid = 128; t.WT = (bf16_t*)(ws + WS_WG) + (size_t)((d * 8 + n) * 2 + g) * 128 * 128; t.K = 128; t.k0 = kb * 64; t.n0 = nb * 64; t.drow0 = nb * 64; return t; }
}
__device__ __forceinline__ void titem_load(const TItem& t, f32x4 (&v)[16], int lane) {
    const int col = t.n0 + 4 * (lane & 15); const bool ok = col < t.nvalid; const float* p = t.W + (size_t)(t.k0 + (lane >> 4)) * t.ldw + col;
#pragma unroll
    for (int i = 0; i < 16; ++i) v[i] = ok ? *(const f32x4*)(p + (size_t)(4 * i) * t.ldw) : (f32x4){0.f, 0.f, 0.f, 0.f};
}
__device__ __forceinline__ void titem_process(const TItem& t, f32x4 (&v)[16], LAS float* scr, int lane) {
    const int rq = lane >> 4, c4 = 4 * (lane & 15);
#pragma unroll
    for (int i = 0; i < 16; ++i) { f32x4 x = v[i] * t.scale; if (t.ks) x = x * t.ks[t.k0 + 4 * i + rq]; LAS float* d = scr + (4 * i + rq) * 65 + c4; d[0] = x[0]; d[1] = x[1]; d[2] = x[2]; d[3] = x[3]; }
    asm volatile("s_waitcnt lgkmcnt(0)" ::: "memory");
    const int c = lane & 7;
#pragma unroll
    for (int j = 0; j < 8; ++j) { const int n = (lane >> 3) + 8 * j; const LAS float* s = scr + (8 * c) * 65 + n;
        u32x4 o; o.x = cvt_pk_bf16(s[0 * 65], s[1 * 65]); o.y = cvt_pk_bf16(s[2 * 65], s[3 * 65]); o.z = cvt_pk_bf16(s[4 * 65], s[5 * 65]); o.w = cvt_pk_bf16(s[6 * 65], s[7 * 65]);
        *(u32x4*)(t.WT + (size_t)(t.drow0 + n) * t.K + t.k0 + 8 * c) = o; }
    asm volatile("s_waitcnt lgkmcnt(0)" ::: "memory");
}

__device__ __forceinline__ void p0_prologue(Frame& F) {
    const Args& A = *F.a;
    {
        LAS float* sc = (LAS float*)F.lds;
        LAS float* red = (LAS float*)(F.lds + 17 * 1024 * 4);
        bool loaded = false;
        for (int task = F.bid; task < 192; task += F.G) {
            if (!loaded) {
                f32x4 cv[9];
#pragma unroll
                for (int qi = 0; qi < 9; ++qi) { const int g = F.tid + 512 * qi; cv[qi] = g < 4096 ? ((const f32x4*)A.in[I_C])[g] : (g < 4352 ? ((const f32x4*)A.in[I_CCTX])[g - 4096] : (f32x4){0.f, 0.f, 0.f, 0.f}); }
#pragma unroll
                for (int qi = 0; qi < 9; ++qi) { const int g = F.tid + 512 * qi; if (g < 4352) { f32x4 r;
#pragma unroll
                    for (int j = 0; j < 4; ++j) r[j] = cv[qi][j] / (1.0f + __expf(-cv[qi][j]));
                    *(LAS f32x4*)(sc + 4 * g) = r; } }
                loaded = true; __syncthreads(); }
            const int l = task / 96, n0 = (task % 96) * 64; const float* W = A.in[I_ADAW] + (size_t)l * D * 6144;
            float acc[17];
#pragma unroll
            for (int r = 0; r < 17; ++r) acc[r] = 0.f;
            const int k0 = F.wave * 128;
            for (int kb = 0; kb < 128; kb += 32) { float wv[32];
#pragma unroll
                for (int kk = 0; kk < 32; ++kk) wv[kk] = W[(size_t)(k0 + kb + kk) * 6144 + n0 + F.lane];
#pragma unroll
                for (int kk = 0; kk < 32; ++kk) {
#pragma unroll
                    for (int r = 0; r < 17; ++r) acc[r] += sc[r * 1024 + k0 + kb + kk] * wv[kk]; } }
#pragma unroll
            for (int r = 0; r < 17; ++r) red[(F.wave * 17 + r) * 64 + F.lane] = acc[r];
            __syncthreads();
            for (int o = F.tid; o < 17 * 64; o += 512) { const int r = o >> 6, ln = o & 63; float s = A.in[I_ADAB][l * 6144 + n0 + ln];
#pragma unroll
                for (int w = 0; w < 8; ++w) s += red[(w * 17 + r) * 64 + ln];
                WSP(float, WS_MOD)[(size_t)(l * 17 + r) * 6144 + n0 + ln] = s; }
            __syncthreads();
        }
        __syncthreads();
    }
    if (F.bid == F.G - 1) { for (int i = F.tid; i < 512; i += 512) { const int pos = i >> 3, f = i & 7; const float fr = powf(10000.0f, -(float)f / 8.0f); const float ang = (float)pos * fr;
            WSP(float, WS_ROPE)[2 * i] = cosf(ang); WSP(float, WS_ROPE)[2 * i + 1] = sinf(ang); } }
    for (int i = F.bid * 512 + F.tid; i < MT; i += F.G * 512) { WSP(float, WS_SSQ)[i] = 0.f; WSP(float, WS_SSKV)[i] = 0.f; }
#ifdef DUP_P0B
    for (int rep_ = 0; rep_ < 2; ++rep_) {
#else
    {
#endif
    LAS float* scr = (LAS float*)(F.lds + F.wave * 16640);
    const int gw = F.bid * NWAVES + F.wave, NGW = F.G * NWAVES;
    constexpr int NITEMS = 32 * 16 * 32 + 32 * 16 * 16 + 16 * 32 + 16 * 16 + 16 * 12 + 6 * 24 + 4 * 32 + 16 * 16 + 32 * 4;
    {
        const int step = F.G * 16, nfull = NITEMS / step; const int base = F.bid * 16 + F.wave;
        const int nk = 2 * nfull + 1;
#define P0_IT(k_) ((k_) < 2 * nfull ? base + ((k_) >> 1) * step + ((k_) & 1) * 8 : ((k_) == 2 * nfull ? nfull * step + F.bid * 8 + F.wave : NITEMS))
        f32x4 va[16], vb[16];
        int k = 0; TItem ta; const bool h0 = P0_IT(0) < NITEMS;
        if (h0) { ta = titem_decode(A, F.ws, P0_IT(0)); titem_load(ta, va, F.lane); }
        if (h0) for (;;) {
            const int ib = (k + 1 < nk) ? P0_IT(k + 1) : NITEMS; const bool hb = ib < NITEMS; TItem tb = ta;
            if (hb) { tb = titem_decode(A, F.ws, ib); titem_load(tb, vb, F.lane); }
            titem_process(ta, va, scr, F.lane);
            const int ia2 = (k + 2 < nk) ? P0_IT(k + 2) : NITEMS; const bool ha = ia2 < NITEMS;
            if (ha) { ta = titem_decode(A, F.ws, ia2); titem_load(ta, va, F.lane); }
            if (hb) titem_process(tb, vb, scr, F.lane);
            if (!ha) break;
            k += 2;
        }
#undef P0_IT
    }
    }
}

__device__ __forceinline__ void row_load(const float* xrow, int lane, f32x4 (&v)[4]) {
    const f32x4* xr = (const f32x4*)xrow + lane;
#pragma unroll
    for (int j = 0; j < 4; ++j) v[j] = xr[64 * j];
}
__device__ __forceinline__ void row_load_bf16(const bf16_t* xrow, int lane, f32x4 (&v)[4]) {
    const u32x2* xr = (const u32x2*)xrow + lane;
#pragma unroll
    for (int j = 0; j < 4; ++j) { const u32x2 w = xr[64 * j]; v[j] = (f32x4){__uint_as_float(w.x << 16), __uint_as_float(w.x & 0xffff0000u), __uint_as_float(w.y << 16), __uint_as_float(w.y & 0xffff0000u)}; }
}
__device__ __forceinline__ float row_rs(const f32x4 (&v)[4]) {
    float s = 0.f;
#pragma unroll
    for (int j = 0; j < 4; ++j) s += (v[j][0] * v[j][0] + v[j][1] * v[j][1]) + (v[j][2] * v[j][2] + v[j][3] * v[j][3]);
    return rsqrtf(wave_sum(s) * (1.0f / D) + EPS);
}
__device__ __forceinline__ void row_modulate(f32x4 (&v)[4], float rs, const float* gamma, const float* shift, const float* scale, int lane) {
#pragma unroll
    for (int j = 0; j < 4; ++j) { const f32x4 g = ((const f32x4*)gamma)[lane + 64 * j], sh = ((const f32x4*)shift)[lane + 64 * j], sc = ((const f32x4*)scale)[lane + 64 * j];
        v[j] = v[j] * rs * g * (sc + 1.0f) + sh; }
}
__device__ __forceinline__ void row_store_bf16(const f32x4 (&v)[4], bf16_t* orow, int lane) {
    u32x2* o8 = (u32x2*)orow + lane;
#pragma unroll
    for (int j = 0; j < 4; ++j) { u32x2 w; w.x = cvt_pk_bf16(v[j][0], v[j][1]); w.y = cvt_pk_bf16(v[j][2], v[j][3]); o8[64 * j] = w; }
}
__device__ __forceinline__ int row_bidx(int row) { return row < MLAT ? row / TL : 16; }

__device__ __forceinline__ void p_norm_in(Frame& F) {
    const Args& A = *F.a; const int gw = F.bid * NWAVES + F.wave, NGW = F.G * NWAVES;
    const float* mod = WSP(float, WS_MOD);
    for (int row = gw; row < MT; row += NGW) {
        const float* src = row < MLAT ? A.in[I_X] + (size_t)row * D : A.in[I_CTX] + (size_t)(row - MLAT) * D;
        f32x4 v[4]; row_load(src, F.lane, v); const float rs = row_rs(v);
        const float* m = mod + (size_t)row_bidx(row) * 6144;
        row_modulate(v, rs, A.in[I_NMIX], m, m + D, F.lane);
        row_store_bf16(v, WSP(bf16_t, WS_H) + (size_t)row * D, F.lane);
    }
}

__device__ __forceinline__ void p_moe_norm(Frame& F, int layer, int nrows) {
    const Args& A = *F.a; const int gw = F.bid * NWAVES + F.wave, NGW = F.G * NWAVES;
    LAS float* Rl = (LAS float*)F.lds;
    const float* router = A.in[I_ROUTER] + (size_t)layer * D * NE;
    int tid_ = F.tid; asm volatile("" : "+v"(tid_));
    { f32x4 rv[8];
#pragma unroll
      for (int q = 0; q < 8; ++q) rv[q] = ((const f32x4*)router)[tid_ + q * 512];
#pragma unroll
      for (int q = 0; q < 8; ++q) { const int g = tid_ + q * 512, k = g >> 2, c = g & 3; const int j = k >> 8, l = (k & 255) >> 2, i = k & 3;
          *(LAS f32x4*)(Rl + (((j * 4 + i) * 4 + c) * 64 + l) * 4) = rv[q]; } }
    __syncthreads();
    const float* mod = WSP(float, WS_MOD) + (size_t)layer * 17 * 6144;
    const float* gamma = A.in[I_NFFN] + layer * D;
    const bf16_t* X = WSP(bf16_t, WS_X);
    for (int rg = gw; rg < nrows / 2; rg += NGW) {
        float y[2][16];
#pragma unroll
        for (int r = 0; r < 2; ++r) { const int row = rg * 2 + r;
            f32x4 v[4]; row_load_bf16(X + (size_t)row * D, F.lane, v); const float rs = row_rs(v);
            const float* m = mod + (size_t)row_bidx(row) * 6144;
            row_modulate(v, rs, gamma, m + 3 * D, m + 4 * D, F.lane);
            row_store_bf16(v, WSP(bf16_t, WS_H) + (size_t)row * D, F.lane);
#pragma unroll
            for (int j = 0; j < 4; ++j)
#pragma unroll
                for (int i = 0; i < 4; ++i) y[r][j * 4 + i] = v[j][i];
            asm volatile("" ::: "memory"); }
        float acc[32];
#pragma unroll
        for (int q = 0; q < 32; ++q) acc[q] = 0.f;
#pragma unroll
        for (int ji = 0; ji < 16; ++ji)
#pragma unroll
            for (int c = 0; c < 4; ++c) { const f32x4 w = *(const LAS f32x4*)(Rl + ((ji * 4 + c) * 64 + F.lane) * 4);
#pragma unroll
                for (int r = 0; r < 2; ++r)
#pragma unroll
                    for (int q = 0; q < 4; ++q) acc[r * 16 + c * 4 + q] += y[r][ji] * w[q]; }
#pragma unroll
        for (int s = 0; s < 5; ++s) { const int half = 16 >> s; const bool up = (F.lane >> (4 - s)) & 1;
#pragma unroll
            for (int i = 0; i < half; ++i) { const float mine = up ? acc[i + half] : acc[i]; const float other = up ? acc[i] : acc[i + half];
                acc[i] = mine + __shfl_xor(other, half); } }
        float lg = acc[0] + __shfl_xor(acc[0], 32);
        float mx = lg;
#pragma unroll
        for (int o = 1; o < 16; o <<= 1) mx = fmaxf(mx, __shfl_xor(mx, o));
        const float ex = __expf(lg - mx); float sm = ex;
#pragma unroll
        for (int o = 1; o < 16; o <<= 1) sm += __shfl_xor(sm, o);
        const float aff = ex / sm;
        const int row = rg * 2 + ((F.lane >> 4) & 1), e = F.lane & 15;
        if (F.lane < 32) {
            if (row < MLAT) { const int b = row / TL, t = row - b * TL; WSP(float, WS_AFFL)[(size_t)(b * NE + e) * TL + t] = aff; }
            else { const int b = (row - MLAT) / TCX, t = (row - MLAT) - b * TCX; WSP(float, WS_AFFC)[(size_t)(b * NE + e) * TCX + t] = aff; } }
    }
}

template <int NPL, int CAP>
__device__ __forceinline__ void topk_unit(Frame& F, const float* aff  , int tokrow0, int moerow0, int e) {
    unsigned v[NPL];
    const unsigned* p = (const unsigned*)aff + F.lane * NPL;
#pragma unroll
    for (int i = 0; i < NPL; i += 4) { const u32x4 q = *(const u32x4*)(p + i); v[i] = q.x; v[i + 1] = q.y; v[i + 2] = q.z; v[i + 3] = q.w; }
    unsigned prefix = 0u;
    for (int bit = 30; bit >= 0; --bit) { const unsigned cand = prefix | (1u << bit); int cnt = 0;
#pragma unroll
        for (int i = 0; i < NPL; ++i) cnt += (v[i] >= cand) ? 1 : 0;
        cnt = wave_isum(cnt); if (cnt >= CAP) prefix = cand; }
    int cg_ = 0, ce = 0;
#pragma unroll
    for (int i = 0; i < NPL; ++i) { cg_ += (v[i] > prefix) ? 1 : 0; ce += (v[i] == prefix) ? 1 : 0; }
    const int need = CAP - wave_isum(cg_);
    int eq_before = ce;
#pragma unroll
    for (int o = 1; o < 64; o <<= 1) { const int x = __shfl_up(eq_before, o); if (F.lane >= o) eq_before += x; }
    eq_before -= ce;
    int nsel = 0, eqi = eq_before; unsigned long long selmask = 0ull;
#pragma unroll
    for (int i = 0; i < NPL; ++i) { bool s = v[i] > prefix; if (v[i] == prefix) { s = eqi < need; ++eqi; } if (s) { selmask |= (1ull << i); ++nsel; } }
    int slot = nsel;
#pragma unroll
    for (int o = 1; o < 64; o <<= 1) { const int x = __shfl_up(slot, o); if (F.lane >= o) slot += x; }
    slot -= nsel;
    int* rowidx = WSP(int, WS_ROWIDX); float* gatev = WSP(float, WS_GATEV); int* sel = WSP(int, WS_SEL);
#pragma unroll
    for (int i = 0; i < NPL; ++i) { const int trow = tokrow0 + F.lane * NPL + i; const bool s = (selmask >> i) & 1ull;
        if (s) { const int mr = moerow0 + slot; rowidx[mr] = trow; gatev[mr] = __uint_as_float(v[i]); sel[(size_t)trow * NE + e] = mr; ++slot; }
        else sel[(size_t)trow * NE + e] = -1; }
}
__device__ __forceinline__ void p_topk(Frame& F, bool with_ctx) {
    const int gw = F.bid * NWAVES + F.wave, NGW = F.G * NWAVES;
    const int nunits = with_ctx ? 512 : 256;
    for (int u = gw; u < nunits; u += NGW) {
        if (u < 256) { const int b = u >> 4, e = u & 15; topk_unit<32, CAPL>(F, WSP(float, WS_AFFL) + (size_t)(b * NE + e) * TL, b * TL, (e * NB + b) * CAPL, e); }
        else { const int uu = u - 256, b = uu >> 4, e = uu & 15; topk_unit<4, CAPC>(F, WSP(float, WS_AFFC) + (size_t)(b * NE + e) * TCX, MLAT + b * TCX, MOE_LAT_ROWS + (e * NB + b) * CAPC, e); }
    }
}

__device__ __forceinline__ void p_combine(Frame& F, int layer, bool final_) {
    const Args& A = *F.a; const int gw = F.bid * NWAVES + F.wave, NGW = F.G * NWAVES;
    const int nrows = final_ ? MLAT : MT;
    const float* mod = WSP(float, WS_MOD);
    const int* sel = WSP(int, WS_SEL); const bf16_t* Y = WSP(bf16_t, WS_Y); bf16_t* X = WSP(bf16_t, WS_X);
    u32x2 xw[2][4]; int myr[2] = {-1, -1};
#pragma unroll
    for (int p = 0; p < 2; ++p)
#pragma unroll
        for (int j = 0; j < 4; ++j) xw[p][j] = (u32x2){0u, 0u};
#define CMB_PRE(r0_) do { _Pragma("unroll") for (int p = 0; p < 2; ++p) { const int r_ = (r0_) + p * NGW; if (r_ < nrows) { const u32x2* xr = (const u32x2*)(X + (size_t)r_ * D) + F.lane; \
        _Pragma("unroll") for (int j = 0; j < 4; ++j) xw[p][j] = xr[64 * j]; myr[p] = sel[(size_t)r_ * NE + (F.lane & 15)]; } else myr[p] = -1; } } while (0)
    CMB_PRE(gw);
    for (int row = gw; row < nrows; row += 2 * NGW) {
        f32x4 v[2][4], s[2][4]; int myc[2]; unsigned long long mask[2];
#pragma unroll
        for (int p = 0; p < 2; ++p) { myc[p] = myr[p];
#pragma unroll
            for (int j = 0; j < 4; ++j) { v[p][j] = (f32x4){__uint_as_float(xw[p][j].x << 16), __uint_as_float(xw[p][j].x & 0xffff0000u), __uint_as_float(xw[p][j].y << 16), __uint_as_float(xw[p][j].y & 0xffff0000u)};
                s[p][j] = (f32x4){0.f, 0.f, 0.f, 0.f}; } }
        CMB_PRE(row + 2 * NGW);
#pragma unroll
        for (int p = 0; p < 2; ++p) mask[p] = __ballot(myc[p] >= 0) & 0xffffull;
        while (mask[0] | mask[1]) {
            int mr[2][4]; u32x2 w[2][4][4];
#pragma unroll
            for (int p = 0; p < 2; ++p)
#pragma unroll
                for (int q = 0; q < 4; ++q) { if (mask[p]) { const int e = __builtin_ctzll(mask[p]); mask[p] &= mask[p] - 1; mr[p][q] = __builtin_amdgcn_readlane(myc[p], e); } else mr[p][q] = -1; }
#pragma unroll
            for (int p = 0; p < 2; ++p)
#pragma unroll
                for (int q = 0; q < 4; ++q) { if (mr[p][q] >= 0) { const u32x2* yr = (const u32x2*)(Y + (size_t)mr[p][q] * D) + F.lane;
#pragma unroll
                    for (int j = 0; j < 4; ++j) w[p][q][j] = yr[64 * j]; } else {
#pragma unroll
                    for (int j = 0; j < 4; ++j) w[p][q][j] = (u32x2){0u, 0u}; } }
#pragma unroll
            for (int p = 0; p < 2; ++p)
#pragma unroll
                for (int q = 0; q < 4; ++q)
#pragma unroll
                    for (int j = 0; j < 4; ++j) { s[p][j][0] += __uint_as_float(w[p][q][j].x << 16); s[p][j][1] += __uint_as_float(w[p][q][j].x & 0xffff0000u);
                        s[p][j][2] += __uint_as_float(w[p][q][j].y << 16); s[p][j][3] += __uint_as_float(w[p][q][j].y & 0xffff0000u); }
        }
#pragma unroll
        for (int p = 0; p < 2; ++p) { const int r = row + p * NGW;
            if (r < nrows) {
                const float* m0 = mod + (size_t)(layer * 17 + row_bidx(r)) * 6144;
#pragma unroll
                for (int j = 0; j < 4; ++j) { const f32x4 g2 = ((const f32x4*)(m0 + 5 * D))[F.lane + 64 * j]; v[p][j] = v[p][j] + g2 * s[p][j]; }
                if (!final_) {
                    row_store_bf16(v[p], X + (size_t)r * D, F.lane);
                    const float rs = row_rs(v[p]); const float* m1 = mod + (size_t)(17 + row_bidx(r)) * 6144;
                    row_modulate(v[p], rs, A.in[I_NMIX] + D, m1, m1 + D, F.lane);
                    row_store_bf16(v[p], WSP(bf16_t, WS_H) + (size_t)r * D, F.lane);
                } else {
                    const float rs = row_rs(v[p]); f32x4* o = (f32x4*)(A.out + (size_t)r * D) + F.lane;
#pragma unroll
                    for (int j = 0; j < 4; ++j) { const f32x4 g = ((const f32x4*)A.in[I_NFIN])[F.lane + 64 * j]; o[64 * j] = v[p][j] * rs * g; }
                } } }
    }
#undef CMB_PRE
}

__device__ __forceinline__ void p_scan(Frame& F) {
    const Args& A = *F.a;
    const int tid = F.tid, dir = tid >> 8, lt = tid & 255, wv = (tid >> 6) & 3, lane = F.lane, cl = lane & 15, q = lane >> 4;
    constexpr int RS = 68;
    LAS unsigned char* base = F.lds + dir * 51200;
    LAS unsigned char* At = base;
    LAS float* UX = (LAS float*)(base + 16384);
    LAS float* AY = (LAS float*)(base + 16384 + 17408);
    LAS float* CW = (LAS float*)(F.lds + 102400);
    const bf16_t* ZX = WSP(bf16_t, WS_ZX); const bf16_t* Gb = WSP(bf16_t, WS_G); bf16_t* YG = WSP(bf16_t, WS_YG);
    constexpr float L2E = 1.4426950408889634f;
    for (int u = F.bid; u < 256; u += F.G) {
        const int b = u >> 4, n = (u & 15) >> 1, half = u & 1; const int cb = n * 128 + half * 64;
        __syncthreads();
        for (int i = tid; i < 640; i += 512) CW[i] = i < 512 ? A.in[I_LCW][(i >> 7) * D + n * 128 + (i & 127)] : A.in[I_LCB][n * 128 + (i - 512)];
        bf16x8 bw[2][4];
        { const bf16_t* wg = WSP(bf16_t, WS_WG) + (size_t)((dir * 8 + n) * 2) * 128 * 128;
#pragma unroll
          for (int g = 0; g < 2; ++g)
#pragma unroll
            for (int ks = 0; ks < 4; ++ks) bw[g][ks] = *(const bf16x8*)(wg + (size_t)g * 128 * 128 + (half * 64 + 16 * wv + cl) * 128 + ks * 32 + q * 8); }
        const int chl = 16 * wv + cl;
        const float bias0 = A.in[I_LGB][(dir * 2 + 0) * D + cb + chl] * (-L2E), bias1 = A.in[I_LGB][(dir * 2 + 1) * D + cb + chl] * (-L2E);
        float sp8l; { const float lam = A.in[I_LLAM][dir * D + cb + chl]; sp8l = 8.0f * log1pf(__expf(-lam)) * L2E; }
        float hcar = 0.f;
        __syncthreads();
        const int o = lt & 15, tq = lt >> 4;
        float w[4][8], bsv[8];
#pragma unroll
        for (int k = 0; k < 4; ++k) { const f32x4 w0 = *(const LAS f32x4*)(CW + k * 128 + 8 * o), w1 = *(const LAS f32x4*)(CW + k * 128 + 8 * o + 4);
#pragma unroll
            for (int j = 0; j < 4; ++j) { w[k][j] = w0[j]; w[k][4 + j] = w1[j]; } }
        { const f32x4 b0 = *(const LAS f32x4*)(CW + 512 + 8 * o), b1 = *(const LAS f32x4*)(CW + 512 + 8 * o + 4);
#pragma unroll
          for (int j = 0; j < 4; ++j) { bsv[j] = b0[j]; bsv[4 + j] = b1[j]; } }
        const int sh16 = (q >= 1 ? lane - 16 : lane) << 2, sh32 = (q >= 2 ? lane - 32 : lane) << 2, shtot = (cl + 48) << 2;
        u32x4 z[7];
#define SCAN_GEOM(it_, c_, t0_, L_, rowbase_, first_) const bool isctx_##it_ = (it_) < 4; const int ci_##it_ = isctx_##it_ ? (it_) : (it_) - 4, nch_##it_ = isctx_##it_ ? 4 : 32; \
        const int c_ = dir == 0 ? ci_##it_ : nch_##it_ - 1 - ci_##it_; const int t0_ = c_ * 64, L_ = isctx_##it_ ? TCX : TL; const int rowbase_ = isctx_##it_ ? MLAT + b * TCX : b * TL; \
        const bool first_ = dir == 0 ? (c_ < nch_##it_ / 2) : (c_ >= nch_##it_ / 2);
#define SCAN_ZLOAD(t0_, L_, rowbase_) do { _Pragma("unroll") for (int r = 0; r < 7; ++r) { const int t = (t0_) + 4 * tq - 2 + r; \
        z[r] = (t >= 0 && t < (L_)) ? *(const u32x4*)(ZX + (size_t)((rowbase_) + t) * D + n * 128 + 8 * o) : (u32x4){0u, 0u, 0u, 0u}; } } while (0)
        { SCAN_GEOM(0, c0, t00, L0, rb0, f0) (void)f0; SCAN_ZLOAD(t00, L0, rb0); }
        for (int it = 0; it < 36; ++it) {
            SCAN_GEOM(it, c, t0, L, rowbase, first)
            {
#pragma unroll
              for (int tt = 0; tt < 4; ++tt) { float xc[8];
#pragma unroll
                  for (int j = 0; j < 8; ++j) xc[j] = bsv[j];
#pragma unroll
                  for (int k = 0; k < 4; ++k) { const u32x4 zz = z[tt + k]; const unsigned zw[4] = {zz.x, zz.y, zz.z, zz.w};
#pragma unroll
                      for (int j = 0; j < 4; ++j) { xc[2 * j] += w[k][2 * j] * __uint_as_float(zw[j] << 16); xc[2 * j + 1] += w[k][2 * j + 1] * __uint_as_float(zw[j] & 0xffff0000u); } }
                  const int tl = 4 * tq + tt, rr = dir == 0 ? tl : 63 - tl;
                  u32x4 pk; pk.x = cvt_pk_bf16(xc[0], xc[1]); pk.y = cvt_pk_bf16(xc[2], xc[3]); pk.z = cvt_pk_bf16(xc[4], xc[5]); pk.w = cvt_pk_bf16(xc[6], xc[7]);
                  *(LAS u32x4*)(At + rr * 256 + ((16 * o) ^ ((rr & 7) << 4))) = pk;
                  if ((o >> 3) == half) { LAS f32x4* ux = (LAS f32x4*)(UX + rr * RS + 8 * (o & 7)); ux[0] = (f32x4){xc[0], xc[1], xc[2], xc[3]}; ux[1] = (f32x4){xc[4], xc[5], xc[6], xc[7]}; } } }
            if (it + 1 < 36) { const int itn = it + 1; SCAN_GEOM(itn, cn, t0n, Ln, rbn, fn) (void)fn; (void)cn; SCAN_ZLOAD(t0n, Ln, rbn); }
            __syncthreads();
            u32x4 ps[2]; u32x4 pg[2];
#pragma unroll
            for (int qq = 0; qq < 2; ++qq) { const int item = lt + 256 * qq, tl = item >> 3, oc = item & 7; const size_t off = (size_t)(rowbase + t0 + tl) * D + cb + 8 * oc;
                if (!first) { ps[qq] = *(const u32x4*)(YG + off); pg[qq] = *(const u32x4*)(Gb + off); }
                else { ps[qq] = (u32x4){0u, 0u, 0u, 0u}; pg[qq] = ps[qq]; } }
            { f32x4 ga[2][4];
#pragma unroll
              for (int g = 0; g < 2; ++g)
#pragma unroll
                for (int mf = 0; mf < 4; ++mf) ga[g][mf] = (f32x4){0.f, 0.f, 0.f, 0.f};
#pragma unroll
              for (int mf = 0; mf < 4; ++mf)
#pragma unroll
                for (int ks = 0; ks < 4; ++ks) { const int row = 16 * mf + cl; const int colb = ks * 64 + q * 16;
                    const bf16x8 af = *(const LAS bf16x8*)(At + row * 256 + (colb ^ ((row & 7) << 4)));
                    ga[0][mf] = __builtin_amdgcn_mfma_f32_16x16x32_bf16(af, bw[0][ks], ga[0][mf], 0, 0, 0);
                    ga[1][mf] = __builtin_amdgcn_mfma_f32_16x16x32_bf16(af, bw[1][ks], ga[1][mf], 0, 0, 0); }
#pragma unroll
              for (int mf = 0; mf < 4; ++mf) {
#pragma unroll
                for (int rg = 0; rg < 4; ++rg) { const int row = 16 * mf + 4 * q + rg;
                    const float r = __builtin_amdgcn_rcpf(1.0f + __builtin_amdgcn_exp2f(ga[0][mf][rg] * (-L2E) + bias0)), ig = __builtin_amdgcn_rcpf(1.0f + __builtin_amdgcn_exp2f(ga[1][mf][rg] * (-L2E) + bias1));
                    const float av = __builtin_amdgcn_exp2f(-sp8l * r); const float mlt = __builtin_amdgcn_sqrtf(1.0f - av * av);
                    ga[0][mf][rg] = av; ga[1][mf][rg] = mlt * ig * UX[row * RS + chl]; }
#pragma unroll
                for (int rg = 1; rg < 4; ++rg) { ga[1][mf][rg] = ga[0][mf][rg] * ga[1][mf][rg - 1] + ga[1][mf][rg]; ga[0][mf][rg] = ga[0][mf][rg - 1] * ga[0][mf][rg]; } }
              float s = hcar;
#pragma unroll
              for (int mf = 0; mf < 4; ++mf) { float Ai = ga[0][mf][3], Hi = ga[1][mf][3];
#define BPERM(a_, v_) __int_as_float(__builtin_amdgcn_ds_bpermute((a_), __float_as_int(v_)))
                  { const float Ap = BPERM(sh16, Ai), Hp = BPERM(sh16, Hi); if (q >= 1) { Hi = Ai * Hp + Hi; Ai = Ai * Ap; } }
                  { const float Ap = BPERM(sh32, Ai), Hp = BPERM(sh32, Hi); if (q >= 2) { Hi = Ai * Hp + Hi; Ai = Ai * Ap; } }
                  const float ea = BPERM(sh16, Ai), eh = BPERM(sh16, Hi); const float Aex = q >= 1 ? ea : 1.0f, Hex = q >= 1 ? eh : 0.0f;
                  const float Ab = BPERM(shtot, Ai), Hb = BPERM(shtot, Hi);
#undef BPERM
                  const float hin = Aex * s + Hex;
#pragma unroll
                  for (int rg = 0; rg < 4; ++rg) AY[(16 * mf + 4 * q + rg) * RS + chl] = ga[0][mf][rg] * hin + ga[1][mf][rg];
                  s = Ab * s + Hb; }
              hcar = s; }
            __syncthreads();
#pragma unroll
            for (int qq = 0; qq < 2; ++qq) { const int item = lt + 256 * qq, tl = item >> 3, oc = item & 7, rr = dir == 0 ? tl : 63 - tl; const size_t off = (size_t)(rowbase + t0 + tl) * D + cb + 8 * oc;
                const f32x4 y0 = *(const LAS f32x4*)(AY + rr * RS + 8 * oc), y1 = *(const LAS f32x4*)(AY + rr * RS + 8 * oc + 4);
                if (first) { *(u32x4*)(YG + off) = pg8::pack8(y0, y1); }
                else { const u32x4 pw = ps[qq]; const u32x4 gg = pg[qq];
                    const f32x4 p0 = {__uint_as_float(pw.x << 16), __uint_as_float(pw.x & 0xffff0000u), __uint_as_float(pw.y << 16), __uint_as_float(pw.y & 0xffff0000u)};
                    const f32x4 p1 = {__uint_as_float(pw.z << 16), __uint_as_float(pw.z & 0xffff0000u), __uint_as_float(pw.w << 16), __uint_as_float(pw.w & 0xffff0000u)};
                    f32x4 o0, o1; o0[0] = (p0[0] + y0[0]) * __uint_as_float(gg.x << 16); o0[1] = (p0[1] + y0[1]) * __uint_as_float(gg.x & 0xffff0000u); o0[2] = (p0[2] + y0[2]) * __uint_as_float(gg.y << 16); o0[3] = (p0[3] + y0[3]) * __uint_as_float(gg.y & 0xffff0000u);
                    o1[0] = (p1[0] + y1[0]) * __uint_as_float(gg.z << 16); o1[1] = (p1[1] + y1[1]) * __uint_as_float(gg.z & 0xffff0000u); o1[2] = (p1[2] + y1[2]) * __uint_as_float(gg.w << 16); o1[3] = (p1[3] + y1[3]) * __uint_as_float(gg.w & 0xffff0000u);
                    *(u32x4*)(YG + off) = pg8::pack8(o0, o1); } }
        }
#undef SCAN_GEOM
#undef SCAN_ZLOAD
    }
    __syncthreads();
}

__device__ __forceinline__ void p_krope(Frame& F) {
    const bf16_t* Z = WSP(bf16_t, WS_Z); bf16_t* Kc = WSP(bf16_t, WS_K); const float* rope = WSP(float, WS_ROPE);
    for (int it = F.bid * 512 + F.tid; it < MT * NH; it += F.G * 512) {
        const int row = it >> 4, h = it & 15; const bool isl = row < MLAT;
        const int b = isl ? row / TL : (row - MLAT) / TCX; const int t = isl ? row - b * TL : (row - MLAT) - b * TCX; const int key = isl ? t : TL + t;
        const u32x4* zp = (const u32x4*)(Z + (size_t)row * ZW + 640);
        float x[32];
#pragma unroll
        for (int q = 0; q < 4; ++q) { const u32x4 w = zp[q]; const unsigned ww[4] = {w.x, w.y, w.z, w.w};
#pragma unroll
            for (int i = 0; i < 4; ++i) { x[8 * q + 2 * i] = __uint_as_float(ww[i] << 16); x[8 * q + 2 * i + 1] = __uint_as_float(ww[i] & 0xffff0000u); } }
        if (isl) {
#pragma unroll
            for (int ax = 0; ax < 2; ++ax) { const int pos = ax == 0 ? (t >> 6) : (t & 63);
#pragma unroll
                for (int f = 0; f < 8; ++f) { const float cs = rope[(pos * 8 + f) * 2], sn = rope[(pos * 8 + f) * 2 + 1]; const float x1 = x[ax * 16 + f], x2 = x[ax * 16 + 8 + f];
                    x[ax * 16 + f] = x1 * cs - x2 * sn; x[ax * 16 + 8 + f] = x1 * sn + x2 * cs; } } }
        u32x4* kp = (u32x4*)(Kc + ((size_t)(b * NH + h) * SKV + key) * DQK + 64);
#pragma unroll
        for (int q = 0; q < 4; ++q) { u32x4 w; w.x = cvt_pk_bf16(x[8 * q], x[8 * q + 1]); w.y = cvt_pk_bf16(x[8 * q + 2], x[8 * q + 3]); w.z = cvt_pk_bf16(x[8 * q + 4], x[8 * q + 5]); w.w = cvt_pk_bf16(x[8 * q + 6], x[8 * q + 7]); kp[q] = w; }
    }
}

namespace att {
constexpr int KVBLK = 64, QBLK = 32;
constexpr int SHM_K = KVBLK * 256, SHM_V = KVBLK * DV * 2;
constexpr float THRL = 8.0f;
#define KSWZ(row, colB) ((row) * 256 + ((colB) ^ (((row) & 7) << 4)))
#define SBAR() __builtin_amdgcn_sched_barrier(0)
__device__ __forceinline__ int crow(int r, int hi) { return (r & 3) + 8 * (r >> 2) + 4 * hi; }
__device__ __forceinline__ void partialSM(f32x16& p0, f32x16& p1, float& m_ref, unsigned& q6x, float& alpha, bool first, int hi) {
    float pmax = p0[0];
#pragma unroll
    for (int r = 1; r < 16; ++r) pmax = fmaxf(pmax, p0[r]);
#pragma unroll
    for (int r = 0; r < 16; ++r) pmax = fmaxf(pmax, p1[r]);
    { auto rr = __builtin_amdgcn_permlane32_swap(__float_as_uint(pmax), __float_as_uint(pmax), false, false); pmax = fmaxf(__uint_as_float(rr[0]), __uint_as_float(rr[1])); }
    if (__builtin_expect(!first && __all(pmax <= THRL), 1)) { alpha = 1.f; }
    else { const float dl = first ? pmax : fmaxf(pmax, 0.f);
        const float mnew = __uint_as_float(cvt_pk_bf16(m_ref + dl, 0.f) << 16);
        const float delta = mnew - m_ref;
#pragma unroll
        for (int r = 0; r < 16; ++r) { p0[r] -= delta; p1[r] -= delta; }
        alpha = first ? 1.f : __builtin_amdgcn_exp2f(-delta); m_ref = mnew;
        q6x = hi == 0 ? ((__float_as_uint(-mnew) >> 16) & 0xffffu) : 0u; }
#pragma unroll
    for (int r = 0; r < 16; ++r) p0[r] = __builtin_amdgcn_exp2f(p0[r]);
}
__device__ __forceinline__ void finishSM(f32x16& p0, f32x16& p1, bf16x8& pa0, bf16x8& pa1, bf16x8& pa2, bf16x8& pa3) {
#pragma unroll
    for (int r = 0; r < 16; ++r) p1[r] = __builtin_amdgcn_exp2f(p1[r]);
#define PK4(P, BASE, OUT) do { unsigned a0 = cvt_pk_bf16(P[BASE + 0], P[BASE + 1]), a1 = cvt_pk_bf16(P[BASE + 2], P[BASE + 3]);   \
    unsigned b0 = cvt_pk_bf16(P[BASE + 4], P[BASE + 5]), b1 = cvt_pk_bf16(P[BASE + 6], P[BASE + 7]);                              \
    auto r0 = __builtin_amdgcn_permlane32_swap(a0, b0, false, false); auto r1 = __builtin_amdgcn_permlane32_swap(a1, b1, false, false); \
    u32x4 w = {r0[0], r1[0], r0[1], r1[1]}; OUT = *reinterpret_cast<bf16x8*>(&w); } while (0)
    PK4(p0, 0, pa0); PK4(p0, 8, pa1); PK4(p1, 0, pa2); PK4(p1, 8, pa3);
#undef PK4
}
__device__ __forceinline__ void qkt(f32x16& p0, f32x16& p1, const char* Ks, const bf16x8* qr, unsigned q6x, int r32, int hi) {
    p0 = f32x16{}; p1 = f32x16{};
#pragma unroll
    for (int d0 = 0; d0 < 6; ++d0) { const int cb = (d0 * 16 + hi * 8) * 2;
        const bf16x8 b0 = *reinterpret_cast<const bf16x8*>(Ks + KSWZ(r32, cb));
        const bf16x8 b1 = *reinterpret_cast<const bf16x8*>(Ks + KSWZ(32 + r32, cb));
        p0 = __builtin_amdgcn_mfma_f32_32x32x16_bf16(b0, qr[d0], p0, 0, 0, 0);
        p1 = __builtin_amdgcn_mfma_f32_32x32x16_bf16(b1, qr[d0], p1, 0, 0, 0); }
    { const u32x4 kw = {hi == 0 ? 0x00003F80u : 0u, 0u, 0u, 0u}, qw = {q6x, 0u, 0u, 0u};
      const bf16x8 k6 = *reinterpret_cast<const bf16x8*>(&kw), q6 = *reinterpret_cast<const bf16x8*>(&qw);
      p0 = __builtin_amdgcn_mfma_f32_32x32x16_bf16(k6, q6, p0, 0, 0, 0);
      p1 = __builtin_amdgcn_mfma_f32_32x32x16_bf16(k6, q6, p1, 0, 0, 0); }
}
__device__ __forceinline__ int v_st(int k, int c) { const int kk = (k & ~0xC) | ((k & 4) << 1) | ((k & 8) >> 1); return ((kk >> 3) * 2 + (c >> 5)) * 512 + ((kk & 7) * 32 + (c & 31)) * 2; }
__device__ __forceinline__ int v_rd_base(int lane) { return ((lane & 3) << 3) | (((lane >> 2) & 3) << 6) | (((lane >> 4) & 1) << 5) | (((lane >> 5) & 1) << 8); }
constexpr int v_rd_off(int d0, int ks, int half) { return d0 * 512 + ks * 2048 + half * 1024; }
template <int OFF> __device__ __forceinline__ s16x4 tr_read(int vb) { s16x4 r; asm volatile("ds_read_b64_tr_b16 %0, %1 offset:%2" : "=&v"(r) : "v"(vb), "i"(OFF) : "memory"); return r; }
template <int D0> __device__ __forceinline__ void pv_one(f32x16& od, int vb, bf16x8 pa0, bf16x8 pa1, bf16x8 pa2, bf16x8 pa3) {
    const s16x4 l0 = tr_read<v_rd_off(D0, 0, 0)>(vb), h0 = tr_read<v_rd_off(D0, 0, 1)>(vb), l1 = tr_read<v_rd_off(D0, 1, 0)>(vb), h1 = tr_read<v_rd_off(D0, 1, 1)>(vb);
    const s16x4 l2 = tr_read<v_rd_off(D0, 2, 0)>(vb), h2 = tr_read<v_rd_off(D0, 2, 1)>(vb), l3 = tr_read<v_rd_off(D0, 3, 0)>(vb), h3 = tr_read<v_rd_off(D0, 3, 1)>(vb);
    asm volatile("s_waitcnt lgkmcnt(0)" ::: "memory"); SBAR();
#define PK(L, H) (bf16x8){L[0], L[1], L[2], L[3], H[0], H[1], H[2], H[3]}
    od = __builtin_amdgcn_mfma_f32_32x32x16_bf16(pa0, PK(l0, h0), od, 0, 0, 0);
    od = __builtin_amdgcn_mfma_f32_32x32x16_bf16(pa1, PK(l1, h1), od, 0, 0, 0);
    od = __builtin_amdgcn_mfma_f32_32x32x16_bf16(pa2, PK(l2, h2), od, 0, 0, 0);
    od = __builtin_amdgcn_mfma_f32_32x32x16_bf16(pa3, PK(l3, h3), od, 0, 0, 0);
#undef PK
}
__device__ __forceinline__ void pv_d0(f32x16* o, f32x16& osum, int vb, bf16x8 pa0, bf16x8 pa1, bf16x8 pa2, bf16x8 pa3) {
    pv_one<0>(o[0], vb, pa0, pa1, pa2, pa3); pv_one<1>(o[1], vb, pa0, pa1, pa2, pa3);
    const u32x4 ow = {0x3F803F80u, 0x3F803F80u, 0x3F803F80u, 0x3F803F80u}; const bf16x8 ones = *reinterpret_cast<const bf16x8*>(&ow);
    osum = __builtin_amdgcn_mfma_f32_32x32x16_bf16(pa0, ones, osum, 0, 0, 0);
    osum = __builtin_amdgcn_mfma_f32_32x32x16_bf16(pa1, ones, osum, 0, 0, 0);
    osum = __builtin_amdgcn_mfma_f32_32x32x16_bf16(pa2, ones, osum, 0, 0, 0);
    osum = __builtin_amdgcn_mfma_f32_32x32x16_bf16(pa3, ones, osum, 0, 0, 0);
}

__device__ __forceinline__ void pv_partial(f32x16* o, f32x16& osum, int vb, bf16x8 pa0, bf16x8 pa1, bf16x8 pa2, bf16x8 pa3,
                                           f32x16& p0, f32x16& p1, float& m_ref, unsigned& q6x, float& alpha, int hi) {
    pv_one<0>(o[0], vb, pa0, pa1, pa2, pa3);
    float pmax = p0[0];
#pragma unroll
    for (int r = 1; r < 16; ++r) pmax = fmaxf(pmax, p0[r]);
#pragma unroll
    for (int r = 0; r < 8; ++r) p0[r] = __builtin_amdgcn_exp2f(p0[r]);
    pv_one<1>(o[1], vb, pa0, pa1, pa2, pa3);
#pragma unroll
    for (int r = 8; r < 16; ++r) p0[r] = __builtin_amdgcn_exp2f(p0[r]);
#pragma unroll
    for (int r = 0; r < 16; ++r) pmax = fmaxf(pmax, p1[r]);
    { auto rr = __builtin_amdgcn_permlane32_swap(__float_as_uint(pmax), __float_as_uint(pmax), false, false); pmax = fmaxf(__uint_as_float(rr[0]), __uint_as_float(rr[1])); }
    const u32x4 ow = {0x3F803F80u, 0x3F803F80u, 0x3F803F80u, 0x3F803F80u}; const bf16x8 ones = *reinterpret_cast<const bf16x8*>(&ow);
    osum = __builtin_amdgcn_mfma_f32_32x32x16_bf16(pa0, ones, osum, 0, 0, 0);
    osum = __builtin_amdgcn_mfma_f32_32x32x16_bf16(pa1, ones, osum, 0, 0, 0);
    osum = __builtin_amdgcn_mfma_f32_32x32x16_bf16(pa2, ones, osum, 0, 0, 0);
    osum = __builtin_amdgcn_mfma_f32_32x32x16_bf16(pa3, ones, osum, 0, 0, 0);
    if (__builtin_expect(__all(pmax <= THRL), 1)) { alpha = 1.f; }
    else { const float dl = fmaxf(pmax, 0.f);
        const float mnew = __uint_as_float(cvt_pk_bf16(m_ref + dl, 0.f) << 16);
        const float delta = mnew - m_ref;
        alpha = __builtin_amdgcn_exp2f(-delta); m_ref = mnew;
#pragma unroll
        for (int r = 0; r < 16; ++r) { p0[r] *= alpha; p1[r] -= delta; }
        q6x = hi == 0 ? ((__float_as_uint(-mnew) >> 16) & 0xffffu) : 0u; }
}
__device__ __forceinline__ void attn_units(const bf16_t* __restrict__ Q, const bf16_t* __restrict__ Kc, const bf16_t* __restrict__ Vc, bf16_t* __restrict__ O, int u0, int ustep, int nunits, char* lds, LAS unsigned char* ldsl) {
    const int tid = threadIdx.x, wid = __builtin_amdgcn_readfirstlane(tid >> 6), lane = tid & 63, r32 = lane & 31, hi = lane >> 5;
    char* V_lds = lds; char* K_lds = lds + 2 * SHM_V;
    float* wsf = (float*)(lds + 2 * SHM_V + 2 * SHM_K) + wid * 64; float* al_l = wsf + 32;
    unsigned kofs[2], vofs;
#pragma unroll
    for (int i = 0; i < 2; ++i) { const int r = 4 * (2 * wid + i) + (lane >> 4), q = lane & 15; int c = q ^ (r & 7); c = c < 12 ? c : c - 4; kofs[i] = (unsigned)((r * DQK + c * 8) * 2); }
    { const int o = wid * 1024 + lane * 16, sI = o >> 9, wd = (o & 511) >> 1; const int kk = (sI >> 1) * 8 + (wd >> 5); const int k = (kk & ~0xC) | ((kk & 4) << 1) | ((kk & 8) >> 1);
      const int c = (sI & 1) * 32 + (wd & 31); vofs = (unsigned)((k * DV + c) * 2); }
    const int vb0 = (int)(uintptr_t)V_lds + v_rd_base(lane);
    bf16x8 qr[6];
#define DMA_K(Kp, t, b) do { const char* g_ = (const char*)(Kp) + (size_t)(t) * (KVBLK * DQK * 2); _Pragma("unroll") for (int i_ = 0; i_ < 2; ++i_) \
    __builtin_amdgcn_global_load_lds((const unsigned*)(g_ + kofs[i_]), (LAS unsigned*)(ldsl + 2 * SHM_V + (b) * SHM_K + (2 * wid + i_) * 1024), 16, 0, 0); } while (0)
#define DMA_V(Vp, t, b) do { const char* g_ = (const char*)(Vp) + (size_t)(t) * (KVBLK * DV * 2); \
    __builtin_amdgcn_global_load_lds((const unsigned*)(g_ + vofs), (LAS unsigned*)(ldsl + (b) * SHM_V + wid * 1024), 16, 0, 0); } while (0)
#define SWAIT() asm volatile("s_waitcnt vmcnt(0)" ::: "memory")
#define RESC(a) do { if (__any((a) < 1.f)) { if (hi == 0) al_l[r32] = (a); asm volatile("s_waitcnt lgkmcnt(0)" ::: "memory"); \
    _Pragma("unroll") for (int r = 0; r < 16; ++r) { const float f_ = al_l[crow(r, hi)]; o[0][r] *= f_; o[1][r] *= f_; osum[r] *= f_; } } } while (0)
#define UNIT_PTRS(u_, Kp, Vp, Qp) do { const int bh_ = (u_) >> 3, qb_ = (u_) & 7; Kp = Kc + (size_t)bh_ * SKV * DQK; Vp = Vc + (size_t)bh_ * SKV * DV; \
    Qp = Q + ((size_t)bh_ * TL + qb_ * 256 + wid * QBLK + r32) * DQK + hi * 8; } while (0)
#define QLOAD(Qp) do { _Pragma("unroll") for (int d0 = 0; d0 < 6; ++d0) qr[d0] = *reinterpret_cast<const bf16x8*>((Qp) + d0 * 16); } while (0)
    constexpr int NT = SKV / KVBLK;
    int u = u0; if (u >= nunits) return;
    const bf16_t* Kh; const bf16_t* Vh; const bf16_t* Qw;
    UNIT_PTRS(u, Kh, Vh, Qw);
    __syncthreads();
    DMA_K(Kh, 0, 0); DMA_V(Vh, 0, 0); DMA_K(Kh, 1, 1); QLOAD(Qw);
    for (;;) {
        float m_ref = 0.f; unsigned q6x = 0u; f32x16 o[2] = {}; f32x16 osum = {};
        f32x16 pA0, pA1, pB0, pB1; float alA, alB; bf16x8 pa0, pa1, pa2, pa3;
        bf16_t* Ow = O + ((size_t)((u >> 3) >> 4) * TL + (u & 7) * 256 + wid * QBLK) * D + ((u >> 3) & 15) * DV;
        SWAIT(); __syncthreads();
        qkt(pA0, pA1, K_lds, qr, q6x, r32, hi); partialSM(pA0, pA1, m_ref, q6x, alA, true, hi);
        __syncthreads();
        for (int j = 0; j + 2 < NT; j += 2) {
            DMA_K(Kh, j + 2, 0); DMA_V(Vh, j + 1, 1);
            SBAR(); qkt(pB0, pB1, K_lds + SHM_K, qr, q6x, r32, hi);
            finishSM(pA0, pA1, pa0, pa1, pa2, pa3); SBAR();
            pv_partial(o, osum, vb0, pa0, pa1, pa2, pa3, pB0, pB1, m_ref, q6x, alB, hi);
            RESC(alB); SWAIT(); __syncthreads();
            DMA_K(Kh, j + 3, 1); DMA_V(Vh, j + 2, 0);
            SBAR(); qkt(pA0, pA1, K_lds, qr, q6x, r32, hi);
            finishSM(pB0, pB1, pa0, pa1, pa2, pa3); SBAR();
            pv_partial(o, osum, vb0 + SHM_V, pa0, pa1, pa2, pa3, pA0, pA1, m_ref, q6x, alA, hi);
            RESC(alA); SWAIT(); __syncthreads();
        }
        const int un = u + ustep; const bool has_next = un < nunits;
        const bf16_t* Kn = Kh; const bf16_t* Vn = Vh; const bf16_t* Qn = Qw;
        if (has_next) UNIT_PTRS(un, Kn, Vn, Qn);
        if (has_next) DMA_K(Kn, 0, 0);
        DMA_V(Vh, NT - 1, 1);
        SBAR(); qkt(pB0, pB1, K_lds + SHM_K, qr, q6x, r32, hi);
        finishSM(pA0, pA1, pa0, pa1, pa2, pa3); SBAR();
        if (has_next) QLOAD(Qn);
        SBAR();
        pv_partial(o, osum, vb0, pa0, pa1, pa2, pa3, pB0, pB1, m_ref, q6x, alB, hi);
        RESC(alB); SWAIT(); __syncthreads();
        if (has_next) { DMA_K(Kn, 1, 1); DMA_V(Vn, 0, 0); }
        finishSM(pB0, pB1, pa0, pa1, pa2, pa3); SBAR();
        pv_d0(o, osum, vb0 + SHM_V, pa0, pa1, pa2, pa3);
        float rli[16];
#pragma unroll
        for (int r = 0; r < 16; ++r) rli[r] = __builtin_amdgcn_rcpf(osum[r]);
        { bf16_t* stg = (bf16_t*)(lds + 65536) + wid * 2048;
#pragma unroll
          for (int r = 0; r < 16; ++r) { const int orow = crow(r, hi);
#pragma unroll
              for (int d0 = 0; d0 < 2; ++d0) { const float val = o[d0][r] * rli[r]; stg[orow * 64 + d0 * 32 + r32] = (bf16_t)(cvt_pk_bf16(val, val) & 0xffffu); } }
          asm volatile("s_waitcnt lgkmcnt(0)" ::: "memory");
#pragma unroll
          for (int i = 0; i < 4; ++i) { const int row = i * 8 + (lane >> 3), ch = lane & 7; const u32x4 v = *(const u32x4*)(stg + row * 64 + ch * 8); *(u32x4*)(Ow + (size_t)row * D + ch * 8) = v; }
          asm volatile("s_waitcnt lgkmcnt(0)" ::: "memory"); }
        if (!has_next) break;
        u = un; Kh = Kn; Vh = Vn; Qw = Qn;
    }
    SWAIT();
#undef DMA_K
#undef DMA_V
#undef SWAIT
#undef RESC
#undef UNIT_PTRS
#undef QLOAD
}
#undef KSWZ
#undef SBAR
}

__device__ __forceinline__ void p_attention(Frame& F) {
    const int vcu = (F.G % 8 == 0) ? (F.bid % 8) * (F.G / 8) + F.bid / 8 : F.bid;
    att::attn_units(WSP(bf16_t, WS_Q), WSP(bf16_t, WS_K), WSP(bf16_t, WS_V), WSP(bf16_t, WS_O), vcu, F.G, NB * NH * 8, (char*)F.lds, F.lds);
    __syncthreads();
}

__device__ __forceinline__ void stage_gather_idx(Frame& F, const pg8::MoeOrder& S) {
    LAS unsigned* gi = (LAS unsigned*)(F.lds + pg8::STAGE_BYTES);
    const int* rowidx = WSP(int, WS_ROWIDX); pg8::Unit u;
    for (int i = 0; S.next(i, u); ++i) for (int r = F.tid; r < 256; r += 512) gi[i * 256 + r] = (unsigned)rowidx[u.arow + r] * (unsigned)(D * 2);
    __syncthreads();
}

constexpr int N_PHASES = 19;
__global__ void __launch_bounds__(NWAVES * 64, 2) mega_fwd(Args args) {
    extern __shared__ __attribute__((aligned(16))) unsigned char lds_raw[];
    Frame F; F.lds = (LAS unsigned char*)lds_raw; F.tid = threadIdx.x; F.lane = F.tid & 63; F.wave = __builtin_amdgcn_readfirstlane(F.tid >> 6);
    F.G = gridDim.x; F.bid = blockIdx.x; F.a = &args; F.ws = args.ws;
    cg::grid_group grid = cg::this_grid();
    const int lo = args.ph_lo, hi = args.ph_hi;
    volatile LAS unsigned* misc = (volatile LAS unsigned*)(F.lds + LDS_BYTES - 256);
    if (F.tid < 2) misc[F.tid] = 0u;
    __syncthreads();
    (void)xcd_barrier_post((unsigned*)args.ws, misc);
    if (lo < 0) grid.sync();
#ifdef ONLY_PHASE
#define IN(k) ((k) == ONLY_PHASE && lo <= (k) && (k) < hi)
#else
#define IN(k) (lo <= (k) && (k) < hi)
#endif
#define GRIDBAR() do { XcdBarrier xb_; xb_.bar = (unsigned*)args.ws; xb_.x = xb_xcc_id(); xb_.st = (volatile LAS unsigned*)(F.lds + LDS_BYTES - 256); xcd_barrier(xb_); } while (0)
#define PH(k, ...) if (IN(k)) { __VA_ARGS__ if ((DUP_MASK >> (k)) & 1u) { GRIDBAR(); __VA_ARGS__ } } SEAM(k);
#define SEAM(k) do { if (IN(k) && IN((k) + 1)) { XcdBarrier xb_; xb_.bar = (unsigned*)args.ws; xb_.x = xb_xcc_id(); xb_.st = (volatile LAS unsigned*)(F.lds + LDS_BYTES - 256); xcd_barrier(xb_); } } while (0)
    const Args& A = args;
    PH(0,  p0_prologue(F); )
    PH(1,  p_norm_in(F); )
    PH(2,
        pg8::DenseOrder S; S.init(MT, 2048, D, F.G, F.bid); pg8::EpiLruIn E{WSP(bf16_t, WS_G), WSP(bf16_t, WS_ZX)};
        pg8::gemm_phase<pg8::EpiLruIn, pg8::DenseOrder, false>(F.lds, WSP(bf16_t, WS_H), D, WSP(bf16_t, WS_WLIN), D, S, E, nullptr); )
    PH(3,  p_scan(F); )
    PH(4,
        pg8::DenseOrder S; S.init(MT, D, D, F.G, F.bid); pg8::EpiResid<false> E{A.in[I_X], A.in[I_CTX], WSP(bf16_t, WS_X), WSP(float, WS_MOD)};
        pg8::gemm_phase<pg8::EpiResid<false>, pg8::DenseOrder, false>(F.lds, WSP(bf16_t, WS_YG), D, WSP(bf16_t, WS_WLOUT), D, S, E, nullptr); )
    PH(5,  p_moe_norm(F, 0, MT); )
    PH(6,  p_topk(F, true); )
    PH(7,
        pg8::MoeOrder S; S.init(288, 8, 2048, F.G, F.bid); stage_gather_idx(F, S); pg8::EpiUp E{WSP(bf16_t, WS_HID)};
        pg8::gemm_phase<pg8::EpiUp, pg8::MoeOrder, true>(F.lds, WSP(bf16_t, WS_H), D, WSP(bf16_t, WS_WUP), D, S, E, (const LAS unsigned*)(F.lds + pg8::STAGE_BYTES)); )
    PH(8,
        pg8::MoeOrder S; S.init(288, 4, 1024, F.G, F.bid); pg8::EpiDown E{WSP(bf16_t, WS_Y), WSP(float, WS_GATEV)};
        pg8::gemm_phase<pg8::EpiDown, pg8::MoeOrder, false>(F.lds, WSP(bf16_t, WS_HID), D, WSP(bf16_t, WS_WDN), D, S, E, nullptr); )
    PH(9,  p_combine(F, 0, false); )
    PH(10,
        pg8::DenseOrder S; S.init(MT, ZW, D, F.G, F.bid); pg8::EpiZ E{WSP(bf16_t, WS_Z), WSP(float, WS_SSQ), WSP(float, WS_SSKV)};
        pg8::gemm_phase<pg8::EpiZ, pg8::DenseOrder, false>(F.lds, WSP(bf16_t, WS_H), D, WSP(bf16_t, WS_WMIN), D, S, E, nullptr); )
    PH(11,
        { pg8::DenseOrder S; S.init(MLAT, NH * DQK, QLORA, F.G, F.bid); pg8::EpiQ E{WSP(bf16_t, WS_Q), WSP(float, WS_SSQ), WSP(float, WS_ROPE)};
          pg8::gemm_phase<pg8::EpiQ, pg8::DenseOrder, false>(F.lds, WSP(bf16_t, WS_Z), ZW, WSP(bf16_t, WS_WUQ), QLORA, S, E, nullptr); }
        { pg8::DenseOrder S; S.init(MT, NH * 128, KVLORA, F.G, F.bid); pg8::EpiKV E{WSP(bf16_t, WS_K), WSP(bf16_t, WS_V), WSP(float, WS_SSKV)};
          pg8::gemm_phase<pg8::EpiKV, pg8::DenseOrder, false>(F.lds, WSP(bf16_t, WS_Z) + QLORA, ZW, WSP(bf16_t, WS_WUKV), KVLORA, S, E, nullptr); }
        p_krope(F); )
    PH(12,  p_attention(F); )
    PH(13,
        pg8::DenseOrder S; S.init(MLAT, D, D, F.G, F.bid); pg8::EpiResid<true> E{nullptr, nullptr, WSP(bf16_t, WS_X), WSP(float, WS_MOD) + 17 * 6144};
        pg8::gemm_phase<pg8::EpiResid<true>, pg8::DenseOrder, false>(F.lds, WSP(bf16_t, WS_O), D, WSP(bf16_t, WS_WO), D, S, E, nullptr); )
    PH(14,  p_moe_norm(F, 1, MLAT); )
    PH(15,  p_topk(F, false); )
    PH(16,
        pg8::MoeOrder S; S.init(256, 8, 2048, F.G, F.bid); stage_gather_idx(F, S); pg8::EpiUp E{WSP(bf16_t, WS_HID)};
        pg8::gemm_phase<pg8::EpiUp, pg8::MoeOrder, true>(F.lds, WSP(bf16_t, WS_H), D, WSP(bf16_t, WS_WUP) + (size_t)NE * 2048 * 1024, D, S, E, (const LAS unsigned*)(F.lds + pg8::STAGE_BYTES)); )
    PH(17,
        pg8::MoeOrder S; S.init(256, 4, 1024, F.G, F.bid); pg8::EpiDown E{WSP(bf16_t, WS_Y), WSP(float, WS_GATEV)};
        pg8::gemm_phase<pg8::EpiDown, pg8::MoeOrder, false>(F.lds, WSP(bf16_t, WS_HID), D, WSP(bf16_t, WS_WDN) + (size_t)NE * 1024 * 1024, D, S, E, nullptr); )
    PH(18,  p_combine(F, 1, true); )
#undef IN
#undef SEAM
#undef PH
#undef GRIDBAR
}

extern "C" void kernel_launch(void* const* d_in, const int* in_sizes, int n_in, void* d_out, int out_size, void* d_ws, size_t ws_size, hipStream_t stream) {
    static int grid = 0;
    if (grid == 0) {
        if (n_in != 25 || in_sizes[0] != MLAT * D || out_size != MLAT * D || ws_size < WS_END) { fprintf(stderr, "kernel_launch: unexpected shapes (n_in %d, in0 %d, out %d, ws %zu)\n", n_in, n_in > 0 ? in_sizes[0] : -1, out_size, ws_size); grid = -1; return; }
        int dev = 0, cus = 0, per_cu = 0;
        if (hipGetDevice(&dev) != hipSuccess || hipDeviceGetAttribute(&cus, hipDeviceAttributeMultiprocessorCount, dev) != hipSuccess) { grid = -1; return; }
        if (hipFuncSetAttribute((const void*)mega_fwd, hipFuncAttributeMaxDynamicSharedMemorySize, LDS_BYTES) != hipSuccess) { fprintf(stderr, "kernel_launch: hipFuncSetAttribute failed\n"); grid = -1; return; }
        if (hipOccupancyMaxActiveBlocksPerMultiprocessor(&per_cu, (const void*)mega_fwd, NWAVES * 64, LDS_BYTES) != hipSuccess || per_cu < 1) { fprintf(stderr, "kernel_launch: occupancy query says %d\n", per_cu); (void)hipGetLastError(); per_cu = 1; }
        grid = cus * 1;
    }
    if (grid < 0) return;
    if (hipMemsetAsync(d_ws, 0, 16384, stream) != hipSuccess) { fprintf(stderr, "kernel_launch: memset of the barrier words failed\n"); return; }
    Args a{};
    for (int i = 0; i < 25; ++i) a.in[i] = (const float*)d_in[i];
    a.out = (float*)d_out; a.ws = (unsigned char*)d_ws;
#if MK_N_LAUNCHES == 1
    a.ph_lo = 0; a.ph_hi = N_PHASES;
    void* kargs[] = {&a};
    hipError_t e = hipLaunchCooperativeKernel((const void*)mega_fwd, dim3(grid), dim3(NWAVES * 64), kargs, LDS_BYTES, stream);
    if (e != hipSuccess) fprintf(stderr, "kernel_launch: cooperative launch failed: %s (grid %d)\n", hipGetErrorString(e), grid);
#else
    for (int p = 0; p < N_PHASES; ++p) { a.ph_lo = p; a.ph_hi = p + 1; void* kargs[] = {&a};
        hipError_t e = hipLaunchCooperativeKernel((const void*)mega_fwd, dim3(grid), dim3(NWAVES * 64), kargs, LDS_BYTES, stream);
        if (e != hipSuccess) { fprintf(stderr, "kernel_launch: launch %d failed: %s\n", p, hipGetErrorString(e)); break; } }
#endif
}
```

```cpp
#include <hip/hip_runtime.h>
#include <hip/hip_cooperative_groups.h>
#include <cstdio>
#include <cstdint>
namespace cg = cooperative_groups;

#ifndef DUP_MASK
#define DUP_MASK 0u
#endif
#ifndef MK_N_LAUNCHES
#define MK_N_LAUNCHES 1
#endif

#define LAS __attribute__((address_space(3)))
typedef unsigned short bf16_t;
typedef short bf16x8 __attribute__((ext_vector_type(8)));
typedef short s16x4 __attribute__((ext_vector_type(4)));
typedef float f32x2 __attribute__((ext_vector_type(2)));
typedef float f32x4 __attribute__((ext_vector_type(4)));
typedef float f32x16 __attribute__((ext_vector_type(16)));
typedef unsigned u32x2 __attribute__((ext_vector_type(2)));
typedef unsigned u32x4 __attribute__((ext_vector_type(4)));

constexpr int D = 1024, NB = 16, TL = 2048, TCX = 256, MLAT = NB * TL, MCTX = NB * TCX, MT = MLAT + MCTX;
constexpr int NE = 16, CAPL = 256, CAPC = 32, DEXP = 1024;
constexpr int MOE_LAT_ROWS = NB * NE * CAPL;
constexpr int MOE_ROWS0 = MOE_LAT_ROWS + NB * NE * CAPC;
constexpr int NH = 16, DQK = 96, DV = 64, QLORA = 384, KVLORA = 256, ZW = 768, SKV = TL + TCX;
constexpr float EPS = 1e-6f;
constexpr float QSCALE = 0.10206207261596575f * 1.4426950408889634f;

constexpr size_t MiB = 1u << 20;
constexpr size_t WS_MOD = 1 * MiB;
constexpr size_t WS_ROPE = 2 * MiB;
constexpr size_t WS_SSQ = 2 * MiB + 512 * 1024;
constexpr size_t WS_SSKV = WS_SSQ + 256 * 1024;
constexpr size_t WS_AFFL = 3 * MiB;
constexpr size_t WS_AFFC = 5 * MiB;
constexpr size_t WS_ROWIDX = 6 * MiB;
constexpr size_t WS_GATEV = 6 * MiB + 512 * 1024;
constexpr size_t WS_SEL = 7 * MiB;
constexpr size_t WS_WG = 10 * MiB;
constexpr size_t WS_WLIN = 16 * MiB;
constexpr size_t WS_WLOUT = 20 * MiB;
constexpr size_t WS_WMIN = 22 * MiB;
constexpr size_t WS_WUQ = 24 * MiB;
constexpr size_t WS_WUKV = 26 * MiB;
constexpr size_t WS_WO = 27 * MiB;
constexpr size_t WS_WUP = 32 * MiB;
constexpr size_t WS_WDN = 160 * MiB;
constexpr size_t WS_H = 224 * MiB;
constexpr size_t WS_G = 296 * MiB;
constexpr size_t WS_ZX = 368 * MiB;
constexpr size_t WS_YG = 440 * MiB;
constexpr size_t WS_Z = 296 * MiB;
constexpr size_t WS_Q = 352 * MiB;
constexpr size_t WS_X = 512 * MiB;
constexpr size_t WS_HID = 656 * MiB;
constexpr size_t WS_K = 656 * MiB;
constexpr size_t WS_Y = 800 * MiB;
constexpr size_t WS_V = 800 * MiB;
constexpr size_t WS_O = 872 * MiB;
constexpr size_t WS_END = 944 * MiB;

constexpr int LDS_BYTES = 147456;
constexpr int NWAVES = 8;

__device__ __forceinline__ unsigned cvt_pk_bf16(float lo, float hi) { unsigned r; asm volatile("v_cvt_pk_bf16_f32 %0, %1, %2" : "=v"(r) : "v"(lo), "v"(hi)); return r; }
__device__ __forceinline__ float bf2f(unsigned short h) { return __uint_as_float(((unsigned)h) << 16); }
__device__ __forceinline__ float wave_sum(float v) {
#pragma unroll
    for (int o = 1; o < 64; o <<= 1) v += __shfl_xor(v, o);
    return v;
}
__device__ __forceinline__ int wave_isum(int v) {
#pragma unroll
    for (int o = 1; o < 64; o <<= 1) v += __shfl_xor(v, o);
    return v;
}
__device__ __forceinline__ float sigmoidf_(float x) { return 1.0f / (1.0f + __expf(-x)); }
__device__ __forceinline__ float gelu_tanh(float x) {
    constexpr float A = 1.5957691216057308f * 1.4426950408889634f, B = A * 0.044715f;
    const float w = x * (A + B * (x * x));
    return x * __builtin_amdgcn_rcpf(1.0f + __builtin_amdgcn_exp2f(-w));
}

namespace pg8 {
constexpr int BM = 256, BK = 64, HALF = 128, HTB = HALF * BK * 2, STAGE_BYTES = 8 * HTB;
__device__ __forceinline__ int lds_byte(int r, int c) { const int st = (r >> 4) * 2 + (c >> 5), rr = r & 15, cc = c & 31, ob = rr * 64 + cc * 2; return st * 1024 + (ob ^ (((ob >> 9) & 1) << 5)); }
__device__ __forceinline__ void stage_rc(int b, int& R, int& C) { const int st = b / 1024, sb = b % 1024, swz = sb ^ (((sb >> 9) & 1) << 5); R = (st >> 1) * 16 + swz / 64; C = (st & 1) * 32 + (swz % 64) / 2; }
__device__ __forceinline__ int perm32(int rho) { const int n = rho >> 4, i = rho & 15; return 8 * (i >> 2) + 4 * n + (i & 3); }

struct Unit { int pm, pn, arow, boff; };

struct DenseOrder {
    int nM, nN, nwg, G, c, K;
    __device__ __forceinline__ void init(int M, int N, int K_, int G_, int c_) { nM = M / BM; nN = N / BM; nwg = nM * nN; G = G_; c = c_; K = K_; }
    __device__ __forceinline__ bool next(int i, Unit& u) const {
        const long L = (long)i * G + c; if (L >= nwg) return false;
        int wgid = (int)L; { const int q = nwg / 8, r = nwg % 8, xcd = wgid % 8, off = wgid / 8; wgid = (xcd < r ? xcd * (q + 1) : r * (q + 1) + (xcd - r) * q) + off; }
        const int nig = 8 * nN, gid = wgid / nig, fm = gid * 8, gsz = (nM - fm) < 8 ? (nM - fm) : 8;
        u.pm = fm + ((wgid % nig) % gsz); u.pn = (wgid % nig) / gsz; u.arow = u.pm * BM; u.boff = u.pn * BM * K; return true;
    }
};
struct MoeOrder {
    int nRT, nPN, G, vc, Nexp;
    __device__ __forceinline__ void init(int nRT_, int nPN_, int Nexp_, int G_, int c_) { nRT = nRT_; nPN = nPN_; Nexp = Nexp_; G = G_; vc = (G_ % 8 == 0) ? (c_ % 8) * (G_ / 8) + c_ / 8 : c_; }
    __device__ __forceinline__ bool next(int i, Unit& u) const {
        const long L = (long)i * G + vc; if (L >= (long)nRT * nPN) return false;
        const int rt = (int)(L / nPN), pn = (int)(L % nPN);
        const int e = rt < 256 ? (rt >> 4) : ((rt - 256) >> 1);
        u.pm = rt; u.pn = pn; u.arow = rt * BM; u.boff = (e * Nexp + pn * BM) * 1024; return true;
    }
};

template <class Epi, class Sched, bool GATHER>
__device__ __forceinline__ void gemm_phase(LAS unsigned char* lds, const bf16_t* A, int lda, const bf16_t* Bt, int K, const Sched& S, const Epi& E, const LAS unsigned* gidx) {
    const int tid = threadIdx.x, wid = __builtin_amdgcn_readfirstlane(tid >> 6), lane = tid & 63, wr = wid >> 2, wc = wid & 3, fr = lane & 15, fq = lane >> 4;
    const int nt = K / BK;
    int RA[2]; unsigned CA2[2], voffB[2];
#pragma unroll
    for (int i = 0; i < 2; ++i) { int R, C; stage_rc(tid * 16 + i * 8192, R, C); const int Rb = Epi::PERM ? ((R & ~31) + perm32(R & 31)) : R;
        RA[i] = R; CA2[i] = (unsigned)C * 2u; voffB[i] = (unsigned)(Rb * K + C) * 2u; }
    const size_t kstep = (size_t)(BK * 2);
    const size_t hstepB = (size_t)HALF * K * 2;
    const unsigned ldsw = (unsigned)wid * 1024u;
    const int aoff = lds_byte(wr * 64 + fr, fq * 8), boff = lds_byte(wc * 32 + fr, fq * 8);
    const char* Ab = (const char*)A; const char* Bb = (const char*)Bt;
#define PG8_SA(b, h) (((b) * 2 + (h)) * HTB)
#define PG8_SB(b, h) ((4 + (b) * 2 + (h)) * HTB)
#define PG8_STAGE(bufoff, gbase, voff) do { _Pragma("unroll") for (int _i = 0; _i < 2; ++_i) \
        __builtin_amdgcn_global_load_lds((const unsigned*)((const char*)(gbase) + (voff)[_i]), (LAS unsigned*)(lds + (bufoff) + ldsw + _i * 8192), 16, 0, 0); } while (0)
#define PG8_LDA(dst, b, h) do { _Pragma("unroll") for (int m = 0; m < 4; ++m) _Pragma("unroll") for (int k = 0; k < 2; ++k) dst[m][k] = *(const LAS bf16x8*)(lds + PG8_SA(b, h) + aoff + m * 2048 + k * 1024); } while (0)
#define PG8_LDB(dst, b, h) do { _Pragma("unroll") for (int n = 0; n < 2; ++n) _Pragma("unroll") for (int k = 0; k < 2; ++k) dst[n][k] = *(const LAS bf16x8*)(lds + PG8_SB(b, h) + boff + n * 2048 + k * 1024); } while (0)
#define PG8_MMA(ai, bj, At, Bt_) do { __builtin_amdgcn_s_setprio(1); _Pragma("unroll") for (int m = 0; m < 4; ++m) _Pragma("unroll") for (int n = 0; n < 2; ++n) _Pragma("unroll") for (int k = 0; k < 2; ++k) \
        acc[ai][bj][m][n] = __builtin_amdgcn_mfma_f32_16x16x32_bf16(Bt_[n][k], At[m][k], acc[ai][bj][m][n], 0, 0, 0); __builtin_amdgcn_s_setprio(0); } while (0)
#define PG8_WAIT_V(n) asm volatile("s_waitcnt vmcnt(" #n ")" ::: "memory")
#define PG8_WAIT_L(n) asm volatile("s_waitcnt lgkmcnt(" #n ")" ::: "memory")
#define PG8_BAR __builtin_amdgcn_s_barrier()
#define PG8_SCHED __builtin_amdgcn_sched_barrier(0)
#define PG8_SET_AOFF(ao, u, uidx) do { _Pragma("unroll") for (int _h = 0; _h < 2; ++_h) _Pragma("unroll") for (int _i = 0; _i < 2; ++_i) \
        ao[_h][_i] = (GATHER ? gidx[(uidx) * 256 + _h * 128 + RA[_i]] : (unsigned)(((u).arow + _h * 128 + RA[_i]) * lda) * 2u) + CA2[_i]; } while (0)
    Unit cur, nxt; int ui = 0;
    if (!S.next(0, cur)) return;
    f32x4 acc[2][2][4][2];
#pragma unroll
    for (int a = 0; a < 2; ++a)
#pragma unroll
        for (int b = 0; b < 2; ++b)
#pragma unroll
            for (int m = 0; m < 4; ++m)
#pragma unroll
                for (int n = 0; n < 2; ++n) acc[a][b][m][n] = (f32x4){0.f, 0.f, 0.f, 0.f};
    bf16x8 At[4][2], B0[2][2], B1[2][2];
    unsigned aoc[2][2], aon[2][2];
    PG8_SET_AOFF(aoc, cur, 0);
    const char* cB = Bb + (size_t)cur.boff * 2;
    PG8_STAGE(PG8_SB(0, 0), cB, voffB); PG8_STAGE(PG8_SB(0, 1), cB + hstepB, voffB); PG8_STAGE(PG8_SA(0, 0), Ab, aoc[0]); PG8_STAGE(PG8_SA(0, 1), Ab, aoc[1]);
    if (wr == 1) PG8_BAR;
    PG8_WAIT_V(2); PG8_BAR;
    PG8_STAGE(PG8_SB(1, 0), cB + kstep, voffB); PG8_STAGE(PG8_SA(1, 0), Ab + kstep, aoc[0]); PG8_STAGE(PG8_SB(1, 1), cB + hstepB + kstep, voffB);
    PG8_WAIT_V(6); PG8_BAR;
    for (;;) {
        const bool has_next = S.next(ui + 1, nxt);
        const char* nB = has_next ? Bb + (size_t)nxt.boff * 2 : cB;
        if (has_next) { PG8_SET_AOFF(aon, nxt, ui + 1); }
        else {
#pragma unroll
            for (int _h = 0; _h < 2; ++_h)
#pragma unroll
                for (int _i = 0; _i < 2; ++_i) aon[_h][_i] = aoc[_h][_i]; }
#pragma unroll 1
        for (int t = 0; t < nt; t += 2) {
            const bool last = (t == nt - 2);
            const char* a1 = Ab + (size_t)(t + 1) * kstep;
            const char* a2 = last ? Ab : Ab + (size_t)(t + 2) * kstep; const char* b2 = last ? nB : cB + (size_t)(t + 2) * kstep;
            const char* a3 = a2 + kstep; const char* b3 = b2 + kstep;
            unsigned a2o[2][2];
#pragma unroll
            for (int _h = 0; _h < 2; ++_h)
#pragma unroll
                for (int _i = 0; _i < 2; ++_i) a2o[_h][_i] = last ? aon[_h][_i] : aoc[_h][_i];
            PG8_LDB(B0, 0, 0); PG8_LDB(B1, 0, 1); PG8_SCHED; PG8_LDA(At, 0, 0); PG8_STAGE(PG8_SA(1, 1), a1, aoc[1]);
            PG8_WAIT_V(8); PG8_WAIT_L(0); PG8_BAR; PG8_MMA(0, 0, At, B0); PG8_MMA(0, 1, At, B1); PG8_BAR; PG8_SCHED;
            PG8_LDA(At, 0, 1); PG8_STAGE(PG8_SB(0, 0), b2, voffB); PG8_STAGE(PG8_SB(0, 1), b2 + hstepB, voffB); PG8_STAGE(PG8_SA(0, 0), a2, a2o[0]);
            PG8_WAIT_V(8); PG8_WAIT_L(0); PG8_BAR; PG8_MMA(1, 0, At, B0); PG8_MMA(1, 1, At, B1); PG8_BAR; PG8_SCHED;
            PG8_LDB(B0, 1, 0); PG8_LDB(B1, 1, 1); PG8_SCHED; PG8_LDA(At, 1, 0); PG8_STAGE(PG8_SA(0, 1), a2, a2o[1]);
            PG8_WAIT_V(8); PG8_WAIT_L(0); PG8_BAR; PG8_MMA(0, 0, At, B0); PG8_MMA(0, 1, At, B1); PG8_BAR; PG8_SCHED;
            PG8_LDA(At, 1, 1); PG8_STAGE(PG8_SB(1, 0), b3, voffB); PG8_STAGE(PG8_SB(1, 1), b3 + hstepB, voffB); PG8_STAGE(PG8_SA(1, 0), a3, a2o[0]);
            PG8_WAIT_V(8); PG8_WAIT_L(0); PG8_BAR; PG8_MMA(1, 0, At, B0); PG8_MMA(1, 1, At, B1); PG8_BAR; PG8_SCHED;
        }
        if (wr == 0) PG8_BAR;
        E(acc, cur, wr, wc, fr, fq);
        if (!has_next) break;
#pragma unroll
        for (int a = 0; a < 2; ++a)
#pragma unroll
            for (int b = 0; b < 2; ++b)
#pragma unroll
                for (int m = 0; m < 4; ++m)
#pragma unroll
                    for (int n = 0; n < 2; ++n) acc[a][b][m][n] = (f32x4){0.f, 0.f, 0.f, 0.f};
        cur = nxt; cB = nB; ++ui;
#pragma unroll
        for (int _h = 0; _h < 2; ++_h)
#pragma unroll
            for (int _i = 0; _i < 2; ++_i) aoc[_h][_i] = aon[_h][_i];
        if (wr == 1) PG8_BAR;
    }
    PG8_WAIT_V(0);
    PG8_BAR;
#undef PG8_SA
#undef PG8_SB
#undef PG8_STAGE
#undef PG8_LDA
#undef PG8_LDB
#undef PG8_MMA
#undef PG8_WAIT_V
#undef PG8_WAIT_L
#undef PG8_BAR
#undef PG8_SCHED
#undef PG8_SET_AOFF
}

#define EPI_ARGS const f32x4 (&acc)[2][2][4][2], const Unit& u, int wr, int wc, int fr, int fq
__device__ __forceinline__ u32x4 pack8(const f32x4& a, const f32x4& b) { u32x4 w; w.x = cvt_pk_bf16(a[0], a[1]); w.y = cvt_pk_bf16(a[2], a[3]); w.z = cvt_pk_bf16(b[0], b[1]); w.w = cvt_pk_bf16(b[2], b[3]); return w; }

__device__ __forceinline__ int coalesce_addr(int lane) { return (16 * (lane & 3) + (lane >> 2)) << 2; }
__device__ __forceinline__ u32x4 coalesce16(const u32x4& w, int paddr) {
    u32x4 r; r.x = (unsigned)__builtin_amdgcn_ds_bpermute(paddr, (int)w.x); r.y = (unsigned)__builtin_amdgcn_ds_bpermute(paddr, (int)w.y);
    r.z = (unsigned)__builtin_amdgcn_ds_bpermute(paddr, (int)w.z); r.w = (unsigned)__builtin_amdgcn_ds_bpermute(paddr, (int)w.w); return r;
}
struct EpiLruIn {
    static constexpr bool PERM = true;
    bf16_t* G; bf16_t* ZX;
    __device__ __forceinline__ void operator()(EPI_ARGS) const {
        const bool act = u.pn < 4; bf16_t* base = act ? G : ZX; const int colt = (u.pn & 3) * BM;
        const int lane = fq * 16 + fr, pa = coalesce_addr(lane), rl = lane >> 2, cl = lane & 3;
        const int rowdst = u.pm * BM + wr * 64 + rl, col0 = colt + wc * 32 + 8 * cl;
#pragma unroll
        for (int ai = 0; ai < 2; ++ai)
#pragma unroll
            for (int m = 0; m < 4; ++m) { bf16_t* rowp = base + (size_t)(rowdst + ai * HALF + m * 16) * D + col0;
#pragma unroll
                for (int bj = 0; bj < 2; ++bj) { f32x4 v0 = acc[ai][bj][m][0], v1 = acc[ai][bj][m][1];
                    if (act) {
#pragma unroll
                        for (int j = 0; j < 4; ++j) { v0[j] = gelu_tanh(v0[j]); v1[j] = gelu_tanh(v1[j]); } }
                    *(u32x4*)(rowp + bj * HALF) = coalesce16(pack8(v0, v1), pa); } }
    }
};
template <bool BASE_BF16> struct EpiResid {
    static constexpr bool PERM = true;
    const float* base_lat; const float* base_ctx; bf16_t* X; const float* modl;
    __device__ __forceinline__ void operator()(EPI_ARGS) const {
        const int rowt = u.pm * BM; const bool isl = rowt < MLAT;
        const float* bs = isl ? base_lat + (size_t)rowt * D : base_ctx + (size_t)(rowt - MLAT) * D;
        const int bidx = isl ? rowt / TL : 16;
        const float* gv = modl + bidx * 6144 + 2 * D;
        bf16_t* xo = X + (size_t)rowt * D;
        const int lane = fq * 16 + fr, pa = coalesce_addr(lane), rl = lane >> 2, cl = lane & 3;
        const int cols = u.pn * BM + wc * 32 + 8 * fq; int cold = u.pn * BM + wc * 32 + 8 * cl, r0 = wr * 64 + rl;
        asm volatile("" : "+v"(cold), "+v"(r0));
        f32x4 g[2][2];
#pragma unroll
        for (int bj = 0; bj < 2; ++bj)
#pragma unroll
            for (int n = 0; n < 2; ++n) g[bj][n] = *(const f32x4*)(gv + cols + bj * HALF + n * 4);
        constexpr int RDEPTH = 3;
        f32x4 bf[8][2][2]; u32x4 bw[8][2];
#define RESID_LOAD(s_) do { const size_t off_ = (size_t)(r0 + ((s_) >> 2) * HALF + ((s_) & 3) * 16) * D + cold; _Pragma("unroll") for (int bj = 0; bj < 2; ++bj) { \
            if (BASE_BF16) bw[s_][bj] = *(const u32x4*)(xo + off_ + bj * HALF); \
            else { bf[s_][bj][0] = *(const f32x4*)(bs + off_ + bj * HALF); bf[s_][bj][1] = *(const f32x4*)(bs + off_ + bj * HALF + 4); } } } while (0)
#pragma unroll
        for (int s = 0; s < RDEPTH; ++s) RESID_LOAD(s);
#pragma unroll
        for (int s = 0; s < 8; ++s) { const int ai = s >> 2, m = s & 3; const size_t off = (size_t)(r0 + ai * HALF + m * 16) * D + cold;
            if (s + RDEPTH < 8) RESID_LOAD(s + RDEPTH);
            asm volatile("" ::: "memory");
#pragma unroll
            for (int bj = 0; bj < 2; ++bj) { f32x4 b0, b1;
                if (BASE_BF16) { const u32x4 w = bw[s][bj];
                    b0 = (f32x4){__uint_as_float(w.x << 16), __uint_as_float(w.x & 0xffff0000u), __uint_as_float(w.y << 16), __uint_as_float(w.y & 0xffff0000u)};
                    b1 = (f32x4){__uint_as_float(w.z << 16), __uint_as_float(w.z & 0xffff0000u), __uint_as_float(w.w << 16), __uint_as_float(w.w & 0xffff0000u)}; }
                else { b0 = bf[s][bj][0]; b1 = bf[s][bj][1]; }
                const u32x4 d = coalesce16(pack8(g[bj][0] * acc[ai][bj][m][0], g[bj][1] * acc[ai][bj][m][1]), pa);
                const f32x4 d0 = (f32x4){__uint_as_float(d.x << 16), __uint_as_float(d.x & 0xffff0000u), __uint_as_float(d.y << 16), __uint_as_float(d.y & 0xffff0000u)};
                const f32x4 d1 = (f32x4){__uint_as_float(d.z << 16), __uint_as_float(d.z & 0xffff0000u), __uint_as_float(d.w << 16), __uint_as_float(d.w & 0xffff0000u)};
                *(u32x4*)(xo + off + bj * HALF) = pack8(b0 + d0, b1 + d1); }
            asm volatile("" ::: "memory"); }
#undef RESID_LOAD
    }
};
struct EpiZ {
    static constexpr bool PERM = true;
    bf16_t* Z; float* ssq; float* sskv;
    __device__ __forceinline__ void operator()(EPI_ARGS) const {
        const int lane = fq * 16 + fr, pa = coalesce_addr(lane), rl = lane >> 2, cl = lane & 3;
        const int rowsrc = u.pm * BM + wr * 64 + fr, rowdst = u.pm * BM + wr * 64 + rl, col0 = u.pn * BM + wc * 32 + 8 * cl;
#pragma unroll
        for (int ai = 0; ai < 2; ++ai)
#pragma unroll
            for (int m = 0; m < 4; ++m) { const int row = rowsrc + ai * HALF + m * 16; bf16_t* rowp = Z + (size_t)(rowdst + ai * HALF + m * 16) * ZW + col0;
#pragma unroll
                for (int bj = 0; bj < 2; ++bj) { const f32x4 v0 = acc[ai][bj][m][0], v1 = acc[ai][bj][m][1];
                    *(u32x4*)(rowp + bj * HALF) = coalesce16(pack8(v0, v1), pa);
                    const int hb = 2 * u.pn + bj;
                    if (hb < 5) { float s = (v0[0] * v0[0] + v0[1] * v0[1]) + (v0[2] * v0[2] + v0[3] * v0[3]) + (v1[0] * v1[0] + v1[1] * v1[1]) + (v1[2] * v1[2] + v1[3] * v1[3]);
                        s += __shfl_xor(s, 16); s += __shfl_xor(s, 32);
                        if (fq == 0) atomicAdd((hb < 3 ? ssq : sskv) + row, s); } } }
    }
};
struct EpiQ {
    static constexpr bool PERM = true;
    bf16_t* Q; const float* ssq; const LAS float* ropel;
    __device__ __forceinline__ void operator()(EPI_ARGS) const {
        int row0 = u.pm * BM + wr * 64 + fr;
        asm volatile("" : "+v"(row0));
        float rsv[2][4];
#pragma unroll
        for (int ai = 0; ai < 2; ++ai)
#pragma unroll
            for (int m = 0; m < 4; ++m) rsv[ai][m] = ssq[row0 + ai * HALF + m * 16];
#pragma unroll
        for (int ai = 0; ai < 2; ++ai)
#pragma unroll
            for (int m = 0; m < 4; ++m) rsv[ai][m] = rsqrtf(rsv[ai][m] * (1.0f / QLORA) + EPS) * QSCALE;
        const int lane = fq * 16 + fr, pa = coalesce_addr(lane);
#pragma unroll
        for (int bj = 0; bj < 2; ++bj) {
            const int c0 = u.pn * BM + bj * HALF + wc * 32 + 8 * fq; const int h = c0 / DQK, dd = c0 - h * DQK;
            const bool isrope = dd >= 64; const int axis = (dd - 64) >> 4;
            const int cd = u.pn * BM + bj * HALF + wc * 32 + 8 * (lane & 3); const int hd = cd / DQK, ddd = cd - hd * DQK;
            bf16_t* qbase = Q + (size_t)hd * TL * DQK + ddd;
#pragma unroll
            for (int ai = 0; ai < 2; ++ai)
#pragma unroll
                for (int m = 0; m < 4; ++m) { const int row = row0 + ai * HALF + m * 16; const int t = row & (TL - 1);
                    const float rs = rsv[ai][m];
                    f32x4 v0 = acc[ai][bj][m][0] * rs, v1 = acc[ai][bj][m][1] * rs;
                    if (isrope) {
                        const int pos = axis == 0 ? (t >> 6) : (t & 63);
                        const LAS f32x4* cs = (const LAS f32x4*)(ropel + pos * 16);
                        const f32x4 t0 = cs[0], t1 = cs[1], t2 = cs[2], t3 = cs[3];
                        const float cosv[8] = {t0[0], t0[2], t1[0], t1[2], t2[0], t2[2], t3[0], t3[2]}, sinv[8] = {t0[1], t0[3], t1[1], t1[3], t2[1], t2[3], t3[1], t3[3]};
                        const bool second = fq & 1;
#pragma unroll
                        for (int j = 0; j < 4; ++j) { const float p0 = __shfl_xor(v0[j], 16), p1 = __shfl_xor(v1[j], 16);
                            v0[j] = second ? (p0 * sinv[j] + v0[j] * cosv[j]) : (v0[j] * cosv[j] - p0 * sinv[j]);
                            v1[j] = second ? (p1 * sinv[4 + j] + v1[j] * cosv[4 + j]) : (v1[j] * cosv[4 + j] - p1 * sinv[4 + j]); } }
                    { const int rowd = u.pm * BM + wr * 64 + ai * HALF + m * 16 + (lane >> 2); const int bd = rowd / TL, td = rowd - bd * TL;
                      *(u32x4*)(qbase + ((size_t)(bd * NH) * TL + td) * DQK) = coalesce16(pack8(v0, v1), pa); }
                    asm volatile("" ::: "memory"); }
        }
    }
};
struct EpiKV {
    static constexpr bool PERM = true;
    bf16_t* Kc; bf16_t* Vc; const float* sskv;
    __device__ __forceinline__ void operator()(EPI_ARGS) const {
        const int rowt = u.pm * BM; const bool isl = rowt < MLAT;
        const int b = isl ? rowt / TL : (rowt - MLAT) / TCX; const int key0 = isl ? rowt - b * TL : TL + (rowt - MLAT - b * TCX);
        const int lane = fq * 16 + fr, pa = coalesce_addr(lane), rl = lane >> 2, cl = lane & 3;
        const int rsrc = wr * 64 + fr, rdst = wr * 64 + rl; const bool isv = wc >= 2; const int cc = (wc & 1) * 32 + 8 * cl;
#pragma unroll
        for (int ai = 0; ai < 2; ++ai)
#pragma unroll
            for (int m = 0; m < 4; ++m) { const float rs = rsqrtf(sskv[rowt + rsrc + ai * HALF + m * 16] * (1.0f / KVLORA) + EPS); const int rd = rdst + ai * HALF + m * 16;
#pragma unroll
                for (int bj = 0; bj < 2; ++bj) { const int h = 2 * u.pn + bj; const size_t kr = (size_t)(b * NH + h) * SKV + key0 + rd;
                    bf16_t* dst = isv ? Vc + kr * DV + cc : Kc + kr * DQK + cc;
                    *(u32x4*)dst = coalesce16(pack8(acc[ai][bj][m][0] * rs, acc[ai][bj][m][1] * rs), pa); } }
    }
};
struct EpiUp {
    static constexpr bool PERM = true;
    bf16_t* HID;
    __device__ __forceinline__ void operator()(EPI_ARGS) const {
        const int lane = fq * 16 + fr, pa = coalesce_addr(lane), rl = lane >> 2, cl = lane & 3;
        const int rowdst = u.pm * BM + wr * 64 + rl, col0 = u.pn * HALF + wc * 32 + 8 * cl;
#pragma unroll
        for (int ai = 0; ai < 2; ++ai)
#pragma unroll
            for (int m = 0; m < 4; ++m) { f32x4 o0, o1;
#pragma unroll
                for (int j = 0; j < 4; ++j) { const float g0 = acc[ai][0][m][0][j], g1 = acc[ai][0][m][1][j];
                    o0[j] = g0 * __builtin_amdgcn_rcpf(1.0f + __builtin_amdgcn_exp2f(-g0)) * acc[ai][1][m][0][j]; o1[j] = g1 * __builtin_amdgcn_rcpf(1.0f + __builtin_amdgcn_exp2f(-g1)) * acc[ai][1][m][1][j]; }
                *(u32x4*)(HID + (size_t)(rowdst + ai * HALF + m * 16) * DEXP + col0) = coalesce16(pack8(o0, o1), pa); }
    }
};
struct EpiDown {
    static constexpr bool PERM = true;
    bf16_t* Y; const float* gatev;
    __device__ __forceinline__ void operator()(EPI_ARGS) const {
        const int lane = fq * 16 + fr, pa = coalesce_addr(lane), rl = lane >> 2, cl = lane & 3;
        const int rowsrc = u.pm * BM + wr * 64 + fr, rowdst = u.pm * BM + wr * 64 + rl, col0 = u.pn * BM + wc * 32 + 8 * cl;
#pragma unroll
        for (int ai = 0; ai < 2; ++ai)
#pragma unroll
            for (int m = 0; m < 4; ++m) { const float gsc = gatev[rowsrc + ai * HALF + m * 16]; bf16_t* rowp = Y + (size_t)(rowdst + ai * HALF + m * 16) * D + col0;
#pragma unroll
                for (int bj = 0; bj < 2; ++bj) *(u32x4*)(rowp + bj * HALF) = coalesce16(pack8(acc[ai][bj][m][0] * gsc, acc[ai][bj][m][1] * gsc), pa); }
    }
};
}


#define XB_TMO      128
#define XB_XCNT(j)  (256  + 64 * (j))
#define XB_XSUB(j)  (1280 + 64 * (j))
#define XB_XGEN(j)  (2304 + 64 * (j))
#define XB_TOP      3328
#define XB_TOPGEN   3392
#define XCD_BAR_WORDS 3456
#define XB_SPIN_CAP (1u << 20)
__device__ __forceinline__ unsigned xb_ld(unsigned* p)              { return __hip_atomic_load(p, __ATOMIC_RELAXED, __HIP_MEMORY_SCOPE_AGENT); }
__device__ __forceinline__ unsigned xb_add(unsigned* p, unsigned v) { return __hip_atomic_fetch_add(p, v, __ATOMIC_RELAXED, __HIP_MEMORY_SCOPE_AGENT); }
__device__ __forceinline__ unsigned xb_xcc_id() { return (unsigned)__builtin_amdgcn_s_getreg((3 << 11) | 20) & 0xFu; }
#define XB_SPIN(cond, bar) do { unsigned _sp = 0; while (cond) { __builtin_amdgcn_s_sleep(1); \
    if ((++_sp & 255u) == 0u) { if (xb_ld(&(bar)[XB_TMO])) break; if (_sp > XB_SPIN_CAP) { atomicAdd(&(bar)[XB_TMO], 1u); break; } } } } while (0)
struct XcdBarrier { unsigned* bar; unsigned x; volatile LAS unsigned* st; };
__device__ __forceinline__ XcdBarrier xcd_barrier_post(unsigned* bar, volatile LAS unsigned* st) {
    XcdBarrier b; b.bar = bar; b.x = xb_xcc_id(); b.st = st;
    if (threadIdx.x == 0) (void)xb_add(&bar[XB_XCNT(b.x)], 1u);
    return b;
}
__device__ __forceinline__ void xcd_barrier_complete(unsigned* bar, unsigned x, unsigned& nloc, unsigned& nx) {
    const unsigned G = gridDim.x * gridDim.y * gridDim.z;
    unsigned sum, cnt, mine, sp = 0u;
    for (;;) {
        sum = 0u; cnt = 0u; mine = 0u;
#pragma unroll
        for (unsigned j = 0; j < 16; ++j) { const unsigned c = xb_ld(&bar[XB_XCNT(j)]); sum += c; cnt += (c > 0u) ? 1u : 0u; mine = (j == x) ? c : mine; }
        if (sum == G) break;
        __builtin_amdgcn_s_sleep(1);
        if ((++sp & 255u) == 0u) { if (xb_ld(&bar[XB_TMO])) break; if (sp > XB_SPIN_CAP) { atomicAdd(&bar[XB_TMO], 1u); break; } }
    }
    nloc = mine > 0u ? mine : 1u; nx = cnt > 0u ? cnt : 1u;
}
__device__ __forceinline__ void xcd_barrier(const XcdBarrier& b) {
    asm volatile("s_waitcnt vmcnt(0)" ::: "memory");
    __syncthreads();
    if (threadIdx.x == 0) {
        unsigned* bar = b.bar;
        __builtin_amdgcn_s_waitcnt(0);
        unsigned nloc = b.st[0], nx = b.st[1];
        if (nloc == 0u) { xcd_barrier_complete(bar, b.x, nloc, nx); b.st[0] = nloc; b.st[1] = nx; }
        const unsigned old = xb_add(&bar[XB_XSUB(b.x)], 1u);
        const unsigned gen = old / nloc;
        if (old + 1u == (gen + 1u) * nloc) {
            __builtin_amdgcn_fence(__ATOMIC_RELEASE, "agent");
            asm volatile("s_waitcnt vmcnt(0)" ::: "memory");
            const unsigned og = xb_add(&bar[XB_TOP], 1u);
            const unsigned tg = og / nx;
            if (og + 1u == (tg + 1u) * nx) xb_add(&bar[XB_TOPGEN], 1u);
            else XB_SPIN(xb_ld(&bar[XB_TOPGEN]) == tg, bar);
            __builtin_amdgcn_fence(__ATOMIC_ACQUIRE, "agent");
            xb_add(&bar[XB_XGEN(b.x)], 1u);
            asm volatile("s_waitcnt vmcnt(0)" ::: "memory");
        } else {
            XB_SPIN(xb_ld(&bar[XB_XGEN(b.x)]) == gen, bar);
            __builtin_amdgcn_fence(__ATOMIC_ACQUIRE, "agent");
            asm volatile("s_waitcnt vmcnt(0)" ::: "memory");
        }
    }
    __syncthreads();
}

struct Args { const float* in[25]; float* out; unsigned char* ws; int ph_lo, ph_hi; };
enum { I_X = 0, I_C, I_CTX, I_CCTX, I_ADAW, I_ADAB, I_NMIX, I_NFFN, I_NFIN, I_LWIN, I_LCW, I_LCB, I_LGW, I_LGB, I_LLAM, I_LWOUT, I_MWIN, I_MQN, I_MKVN, I_MWUQ, I_MWUKV, I_MWO, I_ROUTER, I_WUP, I_WDN };

struct Frame {
    LAS unsigned char* lds;
    int tid, lane, wave, G, bid;
    const Args* a;
    unsigned char* ws;
};
#define WSP(T, off) ((T*)(F.ws + (off)))

struct TItem { const float* W; bf16_t* WT; const float* ks; int ldw, nvalid, K, k0, n0, drow0; float scale; };
__device__ __forceinline__ TItem titem_decode(const Args& A, unsigned char* ws, int it) {
    constexpr int J0 = 32 * 16 * 32, J1 = 32 * 16 * 16, J2 = 16 * 32, J3 = 16 * 16, J4 = 16 * 12, J5 = 6 * 24, J6 = 4 * 32, J7 = 16 * 16;
    TItem t; t.ks = nullptr; t.scale = 1.0f; int r = it;
    if (r < J0) { const int mat = r / 512, q = r % 512, kb = q / 32, nb = q % 32; const int n0 = nb * 64; const int j = n0 & 1023;
        t.W = A.in[I_WUP] + (size_t)mat * 1024 * 2048; t.ldw = 2048; t.nvalid = 2048; t.WT = (bf16_t*)(ws + WS_WUP) + (size_t)mat * 2048 * 1024; t.K = 1024; t.k0 = kb * 64; t.n0 = n0; t.drow0 = (j >> 7) * 256 + (n0 >= 1024 ? 128 : 0) + (j & 127); t.scale = n0 >= 1024 ? 0.6931471805599453f : 1.4426950408889634f; return t; } r -= J0;
    if (r < J1) { const int mat = r / 256, q = r % 256, kb = q / 16, nb = q % 16;
        t.W = A.in[I_WDN] + (size_t)mat * 1024 * 1024; t.ldw = 1024; t.nvalid = 1024; t.WT = (bf16_t*)(ws + WS_WDN) + (size_t)mat * 1024 * 1024; t.K = 1024; t.k0 = kb * 64; t.n0 = nb * 64; t.drow0 = nb * 64; return t; } r -= J1;
    if (r < J2) { const int kb = r / 32, nb = r % 32; t.W = A.in[I_LWIN]; t.ldw = 2048; t.nvalid = 2048; t.WT = (bf16_t*)(ws + WS_WLIN); t.K = 1024; t.k0 = kb * 64; t.n0 = nb * 64; t.drow0 = nb * 64; return t; } r -= J2;
    if (r < J3) { const int kb = r / 16, nb = r % 16; t.W = A.in[I_LWOUT]; t.ldw = 1024; t.nvalid = 1024; t.WT = (bf16_t*)(ws + WS_WLOUT); t.K = 1024; t.k0 = kb * 64; t.n0 = nb * 64; t.drow0 = nb * 64; return t; } r -= J3;
    if (r < J4) { const int kb = r / 12, nb = r % 12; t.W = A.in[I_MWIN]; t.ldw = 672; t.nvalid = 672; t.WT = (bf16_t*)(ws + WS_WMIN); t.K = 1024; t.k0 = kb * 64; t.n0 = nb * 64; t.drow0 = nb * 64; return t; } r -= J4;
    if (r < J5) { const int kb = r / 24, nb = r % 24; t.W = A.in[I_MWUQ]; t.ldw = 1536; t.nvalid = 1536; t.WT = (bf16_t*)(ws + WS_WUQ); t.K = 384; t.k0 = kb * 64; t.n0 = nb * 64; t.drow0 = nb * 64; t.ks = A.in[I_MQN]; return t; } r -= J5;
    if (r < J6) { const int kb = r / 32, nb = r % 32; t.W = A.in[I_MWUKV]; t.ldw = 2048; t.nvalid = 2048; t.WT = (bf16_t*)(ws + WS_WUKV); t.K = 256; t.k0 = kb * 64; t.n0 = nb * 64; t.drow0 = nb * 64; t.ks = A.in[I_MKVN]; return t; } r -= J6;
    if (r < J7) { const int kb = r / 16, nb = r % 16; t.W = A.in[I_MWO]; t.ldw = 1024; t.nvalid = 1024; t.WT = (bf16_t*)(ws + WS_WO); t.K = 1024; t.k0 = kb * 64; t.n0 = nb * 64; t.drow0 = nb * 64; return t; } r -= J7;
    { const int mat = r / 4, q = r % 4, kb = q / 2, nb = q % 2; const int d = mat >> 4, g = (mat >> 3) & 1, n = mat & 7;
        t.W = A.in[I_LGW] + (size_t)mat * 128 * 128; t.ldw = 128; t.nvalid = 128; t.WT = (bf16_t*)(ws + WS_WG) + (size_t)((d * 8 + n) * 2 + g) * 128 * 128; t.K = 128; t.k0 = kb * 64; t.n0 = nb * 64; t.drow0 = nb * 64; return t; }
}
__device__ __forceinline__ void titem_load(const TItem& t, f32x4 (&v)[16], int lane) {
    const int col = t.n0 + 4 * (lane & 15); const bool ok = col < t.nvalid; const float* p = t.W + (size_t)(t.k0 + (lane >> 4)) * t.ldw + col;
#pragma unroll
    for (int i = 0; i < 16; ++i) v[i] = ok ? *(const f32x4*)(p + (size_t)(4 * i) * t.ldw) : (f32x4){0.f, 0.f, 0.f, 0.f};
}
__device__ __forceinline__ void titem_process(const TItem& t, f32x4 (&v)[16], LAS float* scr, int lane) {
    const int rq = lane >> 4, c4 = 4 * (lane & 15);
#pragma unroll
    for (int i = 0; i < 16; ++i) { f32x4 x = v[i] * t.scale; if (t.ks) x = x * t.ks[t.k0 + 4 * i + rq]; LAS float* d = scr + (4 * i + rq) * 65 + c4; d[0] = x[0]; d[1] = x[1]; d[2] = x[2]; d[3] = x[3]; }
    asm volatile("s_waitcnt lgkmcnt(0)" ::: "memory");
    const int c = lane & 7;
#pragma unroll
    for (int j = 0; j < 8; ++j) { const int n = (lane >> 3) + 8 * j; const LAS float* s = scr + (8 * c) * 65 + n;
        u32x4 o; o.x = cvt_pk_bf16(s[0 * 65], s[1 * 65]); o.y = cvt_pk_bf16(s[2 * 65], s[3 * 65]); o.z = cvt_pk_bf16(s[4 * 65], s[5 * 65]); o.w = cvt_pk_bf16(s[6 * 65], s[7 * 65]);
        *(u32x4*)(t.WT + (size_t)(t.drow0 + n) * t.K + t.k0 + 8 * c) = o; }
    asm volatile("s_waitcnt lgkmcnt(0)" ::: "memory");
}

__device__ __forceinline__ void p0_prologue(Frame& F) {
    const Args& A = *F.a;
    {
        LAS float* sc = (LAS float*)F.lds;
        LAS float* red = (LAS float*)(F.lds + 17 * 1024 * 4);
        bool loaded = false;
        for (int task = F.bid; task < 192; task += F.G) {
            if (!loaded) {
                f32x4 cv[9];
#pragma unroll
                for (int qi = 0; qi < 9; ++qi) { const int g = F.tid + 512 * qi; cv[qi] = g < 4096 ? ((const f32x4*)A.in[I_C])[g] : (g < 4352 ? ((const f32x4*)A.in[I_CCTX])[g - 4096] : (f32x4){0.f, 0.f, 0.f, 0.f}); }
#pragma unroll
                for (int qi = 0; qi < 9; ++qi) { const int g = F.tid + 512 * qi; if (g < 4352) { f32x4 r;
#pragma unroll
                    for (int j = 0; j < 4; ++j) r[j] = cv[qi][j] / (1.0f + __expf(-cv[qi][j]));
                    *(LAS f32x4*)(sc + 4 * g) = r; } }
                loaded = true; __syncthreads(); }
            const int l = task / 96, n0 = (task % 96) * 64; const float* W = A.in[I_ADAW] + (size_t)l * D * 6144;
            float acc[17];
#pragma unroll
            for (int r = 0; r < 17; ++r) acc[r] = 0.f;
            const int k0 = F.wave * 128;
            for (int kb = 0; kb < 128; kb += 32) { float wv[32];
#pragma unroll
                for (int kk = 0; kk < 32; ++kk) wv[kk] = W[(size_t)(k0 + kb + kk) * 6144 + n0 + F.lane];
#pragma unroll
                for (int kk = 0; kk < 32; ++kk) {
#pragma unroll
                    for (int r = 0; r < 17; ++r) acc[r] += sc[r * 1024 + k0 + kb + kk] * wv[kk]; } }
#pragma unroll
            for (int r = 0; r < 17; ++r) red[(F.wave * 17 + r) * 64 + F.lane] = acc[r];
            __syncthreads();
            for (int o = F.tid; o < 17 * 64; o += 512) { const int r = o >> 6, ln = o & 63; float s = A.in[I_ADAB][l * 6144 + n0 + ln];
#pragma unroll
                for (int w = 0; w < 8; ++w) s += red[(w * 17 + r) * 64 + ln];
                WSP(float, WS_MOD)[(size_t)(l * 17 + r) * 6144 + n0 + ln] = s; }
            __syncthreads();
        }
        __syncthreads();
    }
    if (F.bid == F.G - 1) { for (int i = F.tid; i < 512; i += 512) { const int pos = i >> 3, f = i & 7; const float fr = powf(10000.0f, -(float)f / 8.0f); const float ang = (float)pos * fr;
            WSP(float, WS_ROPE)[2 * i] = cosf(ang); WSP(float, WS_ROPE)[2 * i + 1] = sinf(ang); } }
    for (int i = F.bid * 512 + F.tid; i < MT; i += F.G * 512) { WSP(float, WS_SSQ)[i] = 0.f; WSP(float, WS_SSKV)[i] = 0.f; }
#ifdef DUP_P0B
    for (int rep_ = 0; rep_ < 2; ++rep_) {
#else
    {
#endif
    LAS float* scr = (LAS float*)(F.lds + F.wave * 16640);
    const int gw = F.bid * NWAVES + F.wave, NGW = F.G * NWAVES;
    constexpr int NITEMS = 32 * 16 * 32 + 32 * 16 * 16 + 16 * 32 + 16 * 16 + 16 * 12 + 6 * 24 + 4 * 32 + 16 * 16 + 32 * 4;
    if (gw < NITEMS) {
        f32x4 va[16], vb[16];
        TItem ta = titem_decode(A, F.ws, gw); titem_load(ta, va, F.lane);
        for (int it = gw; it < NITEMS; it += 2 * NGW) {
            const bool hb = it + NGW < NITEMS; TItem tb = ta;
            if (hb) { tb = titem_decode(A, F.ws, it + NGW); titem_load(tb, vb, F.lane); }
            titem_process(ta, va, scr, F.lane);
            if (!hb) break;
            const bool ha = it + 2 * NGW < NITEMS;
            if (ha) { ta = titem_decode(A, F.ws, it + 2 * NGW); titem_load(ta, va, F.lane); }
            titem_process(tb, vb, scr, F.lane);
            if (!ha) break;
        }
    }
    }
}

__device__ __forceinline__ void row_load(const float* xrow, int lane, f32x4 (&v)[4]) {
    const f32x4* xr = (const f32x4*)xrow + lane;
#pragma unroll
    for (int j = 0; j < 4; ++j) v[j] = xr[64 * j];
}
__device__ __forceinline__ void row_load_bf16(const bf16_t* xrow, int lane, f32x4 (&v)[4]) {
    const u32x2* xr = (const u32x2*)xrow + lane;
#pragma unroll
    for (int j = 0; j < 4; ++j) { const u32x2 w = xr[64 * j]; v[j] = (f32x4){__uint_as_float(w.x << 16), __uint_as_float(w.x & 0xffff0000u), __uint_as_float(w.y << 16), __uint_as_float(w.y & 0xffff0000u)}; }
}
__device__ __forceinline__ float row_rs(const f32x4 (&v)[4]) {
    float s = 0.f;
#pragma unroll
    for (int j = 0; j < 4; ++j) s += (v[j][0] * v[j][0] + v[j][1] * v[j][1]) + (v[j][2] * v[j][2] + v[j][3] * v[j][3]);
    return rsqrtf(wave_sum(s) * (1.0f / D) + EPS);
}
__device__ __forceinline__ void row_modulate(f32x4 (&v)[4], float rs, const float* gamma, const float* shift, const float* scale, int lane) {
#pragma unroll
    for (int j = 0; j < 4; ++j) { const f32x4 g = ((const f32x4*)gamma)[lane + 64 * j], sh = ((const f32x4*)shift)[lane + 64 * j], sc = ((const f32x4*)scale)[lane + 64 * j];
        v[j] = v[j] * rs * g * (sc + 1.0f) + sh; }
}
__device__ __forceinline__ void row_store_bf16(const f32x4 (&v)[4], bf16_t* orow, int lane) {
    u32x2* o8 = (u32x2*)orow + lane;
#pragma unroll
    for (int j = 0; j < 4; ++j) { u32x2 w; w.x = cvt_pk_bf16(v[j][0], v[j][1]); w.y = cvt_pk_bf16(v[j][2], v[j][3]); o8[64 * j] = w; }
}
__device__ __forceinline__ int row_bidx(int row) { return row < MLAT ? row / TL : 16; }

__device__ __forceinline__ void p_norm_in(Frame& F) {
    const Args& A = *F.a; const int gw = F.bid * NWAVES + F.wave, NGW = F.G * NWAVES;
    const float* mod = WSP(float, WS_MOD);
    for (int row = gw; row < MT; row += NGW) {
        const float* src = row < MLAT ? A.in[I_X] + (size_t)row * D : A.in[I_CTX] + (size_t)(row - MLAT) * D;
        f32x4 v[4]; row_load(src, F.lane, v); const float rs = row_rs(v);
        const float* m = mod + (size_t)row_bidx(row) * 6144;
        row_modulate(v, rs, A.in[I_NMIX], m, m + D, F.lane);
        row_store_bf16(v, WSP(bf16_t, WS_H) + (size_t)row * D, F.lane);
    }
}

__device__ __forceinline__ void p_moe_norm(Frame& F, int layer, int nrows) {
    const Args& A = *F.a; const int gw = F.bid * NWAVES + F.wave, NGW = F.G * NWAVES;
    LAS float* Rl = (LAS float*)F.lds;
    const float* router = A.in[I_ROUTER] + (size_t)layer * D * NE;
    int tid_ = F.tid; asm volatile("" : "+v"(tid_));
    { f32x4 rv[8];
#pragma unroll
      for (int q = 0; q < 8; ++q) rv[q] = ((const f32x4*)router)[tid_ + q * 512];
#pragma unroll
      for (int q = 0; q < 8; ++q) { const int g = tid_ + q * 512, k = g >> 2, c = g & 3; const int j = k >> 8, l = (k & 255) >> 2, i = k & 3;
          *(LAS f32x4*)(Rl + (((j * 4 + i) * 4 + c) * 64 + l) * 4) = rv[q]; } }
    __syncthreads();
    const float* mod = WSP(float, WS_MOD) + (size_t)layer * 17 * 6144;
    const float* gamma = A.in[I_NFFN] + layer * D;
    const bf16_t* X = WSP(bf16_t, WS_X);
    for (int rg = gw; rg < nrows / 2; rg += NGW) {
        float y[2][16];
#pragma unroll
        for (int r = 0; r < 2; ++r) { const int row = rg * 2 + r;
            f32x4 v[4]; row_load_bf16(X + (size_t)row * D, F.lane, v); const float rs = row_rs(v);
            const float* m = mod + (size_t)row_bidx(row) * 6144;
            row_modulate(v, rs, gamma, m + 3 * D, m + 4 * D, F.lane);
            row_store_bf16(v, WSP(bf16_t, WS_H) + (size_t)row * D, F.lane);
#pragma unroll
            for (int j = 0; j < 4; ++j)
#pragma unroll
                for (int i = 0; i < 4; ++i) y[r][j * 4 + i] = v[j][i];
            asm volatile("" ::: "memory"); }
        float acc[32];
#pragma unroll
        for (int q = 0; q < 32; ++q) acc[q] = 0.f;
#pragma unroll
        for (int ji = 0; ji < 16; ++ji)
#pragma unroll
            for (int c = 0; c < 4; ++c) { const f32x4 w = *(const LAS f32x4*)(Rl + ((ji * 4 + c) * 64 + F.lane) * 4);
#pragma unroll
                for (int r = 0; r < 2; ++r)
#pragma unroll
                    for (int q = 0; q < 4; ++q) acc[r * 16 + c * 4 + q] += y[r][ji] * w[q]; }
#pragma unroll
        for (int s = 0; s < 5; ++s) { const int half = 16 >> s; const bool up = (F.lane >> (4 - s)) & 1;
#pragma unroll
            for (int i = 0; i < half; ++i) { const float mine = up ? acc[i + half] : acc[i]; const float other = up ? acc[i] : acc[i + half];
                acc[i] = mine + __shfl_xor(other, half); } }
        float lg = acc[0] + __shfl_xor(acc[0], 32);
        float mx = lg;
#pragma unroll
        for (int o = 1; o < 16; o <<= 1) mx = fmaxf(mx, __shfl_xor(mx, o));
        const float ex = __expf(lg - mx); float sm = ex;
#pragma unroll
        for (int o = 1; o < 16; o <<= 1) sm += __shfl_xor(sm, o);
        const float aff = ex / sm;
        const int row = rg * 2 + ((F.lane >> 4) & 1), e = F.lane & 15;
        if (F.lane < 32) {
            if (row < MLAT) { const int b = row / TL, t = row - b * TL; WSP(float, WS_AFFL)[(size_t)(b * NE + e) * TL + t] = aff; }
            else { const int b = (row - MLAT) / TCX, t = (row - MLAT) - b * TCX; WSP(float, WS_AFFC)[(size_t)(b * NE + e) * TCX + t] = aff; } }
    }
}

template <int NPL, int CAP>
__device__ __forceinline__ void topk_unit(Frame& F, const float* aff  , int tokrow0, int moerow0, int e) {
    unsigned v[NPL];
    const unsigned* p = (const unsigned*)aff + F.lane * NPL;
#pragma unroll
    for (int i = 0; i < NPL; i += 4) { const u32x4 q = *(const u32x4*)(p + i); v[i] = q.x; v[i + 1] = q.y; v[i + 2] = q.z; v[i + 3] = q.w; }
    unsigned prefix = 0u;
    for (int bit = 30; bit >= 0; --bit) { const unsigned cand = prefix | (1u << bit); int cnt = 0;
#pragma unroll
        for (int i = 0; i < NPL; ++i) cnt += (v[i] >= cand) ? 1 : 0;
        cnt = wave_isum(cnt); if (cnt >= CAP) prefix = cand; }
    int cg_ = 0, ce = 0;
#pragma unroll
    for (int i = 0; i < NPL; ++i) { cg_ += (v[i] > prefix) ? 1 : 0; ce += (v[i] == prefix) ? 1 : 0; }
    const int need = CAP - wave_isum(cg_);
    int eq_before = ce;
#pragma unroll
    for (int o = 1; o < 64; o <<= 1) { const int x = __shfl_up(eq_before, o); if (F.lane >= o) eq_before += x; }
    eq_before -= ce;
    int nsel = 0, eqi = eq_before; unsigned long long selmask = 0ull;
#pragma unroll
    for (int i = 0; i < NPL; ++i) { bool s = v[i] > prefix; if (v[i] == prefix) { s = eqi < need; ++eqi; } if (s) { selmask |= (1ull << i); ++nsel; } }
    int slot = nsel;
#pragma unroll
    for (int o = 1; o < 64; o <<= 1) { const int x = __shfl_up(slot, o); if (F.lane >= o) slot += x; }
    slot -= nsel;
    int* rowidx = WSP(int, WS_ROWIDX); float* gatev = WSP(float, WS_GATEV); int* sel = WSP(int, WS_SEL);
#pragma unroll
    for (int i = 0; i < NPL; ++i) { const int trow = tokrow0 + F.lane * NPL + i; const bool s = (selmask >> i) & 1ull;
        if (s) { const int mr = moerow0 + slot; rowidx[mr] = trow; gatev[mr] = __uint_as_float(v[i]); sel[(size_t)trow * NE + e] = mr; ++slot; }
        else sel[(size_t)trow * NE + e] = -1; }
}
__device__ __forceinline__ void p_topk(Frame& F, bool with_ctx) {
    const int gw = F.bid * NWAVES + F.wave, NGW = F.G * NWAVES;
    const int nunits = with_ctx ? 512 : 256;
    for (int u = gw; u < nunits; u += NGW) {
        if (u < 256) { const int b = u >> 4, e = u & 15; topk_unit<32, CAPL>(F, WSP(float, WS_AFFL) + (size_t)(b * NE + e) * TL, b * TL, (e * NB + b) * CAPL, e); }
        else { const int uu = u - 256, b = uu >> 4, e = uu & 15; topk_unit<4, CAPC>(F, WSP(float, WS_AFFC) + (size_t)(b * NE + e) * TCX, MLAT + b * TCX, MOE_LAT_ROWS + (e * NB + b) * CAPC, e); }
    }
}

__device__ __forceinline__ void p_combine(Frame& F, int layer, bool final_) {
    const Args& A = *F.a; const int gw = F.bid * NWAVES + F.wave, NGW = F.G * NWAVES;
    const int nrows = final_ ? MLAT : MT;
    const float* mod = WSP(float, WS_MOD);
    const int* sel = WSP(int, WS_SEL); const bf16_t* Y = WSP(bf16_t, WS_Y); bf16_t* X = WSP(bf16_t, WS_X);
    u32x2 xw[2][4]; int myr[2] = {-1, -1};
#pragma unroll
    for (int p = 0; p < 2; ++p)
#pragma unroll
        for (int j = 0; j < 4; ++j) xw[p][j] = (u32x2){0u, 0u};
#define CMB_PRE(r0_) do { _Pragma("unroll") for (int p = 0; p < 2; ++p) { const int r_ = (r0_) + p * NGW; if (r_ < nrows) { const u32x2* xr = (const u32x2*)(X + (size_t)r_ * D) + F.lane; \
        _Pragma("unroll") for (int j = 0; j < 4; ++j) xw[p][j] = xr[64 * j]; myr[p] = sel[(size_t)r_ * NE + (F.lane & 15)]; } else myr[p] = -1; } } while (0)
    CMB_PRE(gw);
    for (int row = gw; row < nrows; row += 2 * NGW) {
        f32x4 v[2][4], s[2][4]; int myc[2]; unsigned long long mask[2];
#pragma unroll
        for (int p = 0; p < 2; ++p) { myc[p] = myr[p];
#pragma unroll
            for (int j = 0; j < 4; ++j) { v[p][j] = (f32x4){__uint_as_float(xw[p][j].x << 16), __uint_as_float(xw[p][j].x & 0xffff0000u), __uint_as_float(xw[p][j].y << 16), __uint_as_float(xw[p][j].y & 0xffff0000u)};
                s[p][j] = (f32x4){0.f, 0.f, 0.f, 0.f}; } }
        CMB_PRE(row + 2 * NGW);
#pragma unroll
        for (int p = 0; p < 2; ++p) mask[p] = __ballot(myc[p] >= 0) & 0xffffull;
        while (mask[0] | mask[1]) {
            int mr[2][4]; u32x2 w[2][4][4];
#pragma unroll
            for (int p = 0; p < 2; ++p)
#pragma unroll
                for (int q = 0; q < 4; ++q) { if (mask[p]) { const int e = __builtin_ctzll(mask[p]); mask[p] &= mask[p] - 1; mr[p][q] = __builtin_amdgcn_readlane(myc[p], e); } else mr[p][q] = -1; }
#pragma unroll
            for (int p = 0; p < 2; ++p)
#pragma unroll
                for (int q = 0; q < 4; ++q) { if (mr[p][q] >= 0) { const u32x2* yr = (const u32x2*)(Y + (size_t)mr[p][q] * D) + F.lane;
#pragma unroll
                    for (int j = 0; j < 4; ++j) w[p][q][j] = yr[64 * j]; } else {
#pragma unroll
                    for (int j = 0; j < 4; ++j) w[p][q][j] = (u32x2){0u, 0u}; } }
#pragma unroll
            for (int p = 0; p < 2; ++p)
#pragma unroll
                for (int q = 0; q < 4; ++q)
#pragma unroll
                    for (int j = 0; j < 4; ++j) { s[p][j][0] += __uint_as_float(w[p][q][j].x << 16); s[p][j][1] += __uint_as_float(w[p][q][j].x & 0xffff0000u);
                        s[p][j][2] += __uint_as_float(w[p][q][j].y << 16); s[p][j][3] += __uint_as_float(w[p][q][j].y & 0xffff0000u); }
        }
#pragma unroll
        for (int p = 0; p < 2; ++p) { const int r = row + p * NGW;
            if (r < nrows) {
                const float* m0 = mod + (size_t)(layer * 17 + row_bidx(r)) * 6144;
#pragma unroll
                for (int j = 0; j < 4; ++j) { const f32x4 g2 = ((const f32x4*)(m0 + 5 * D))[F.lane + 64 * j]; v[p][j] = v[p][j] + g2 * s[p][j]; }
                if (!final_) {
                    row_store_bf16(v[p], X + (size_t)r * D, F.lane);
                    const float rs = row_rs(v[p]); const float* m1 = mod + (size_t)(17 + row_bidx(r)) * 6144;
                    row_modulate(v[p], rs, A.in[I_NMIX] + D, m1, m1 + D, F.lane);
                    row_store_bf16(v[p], WSP(bf16_t, WS_H) + (size_t)r * D, F.lane);
                } else {
                    const float rs = row_rs(v[p]); f32x4* o = (f32x4*)(A.out + (size_t)r * D) + F.lane;
#pragma unroll
                    for (int j = 0; j < 4; ++j) { const f32x4 g = ((const f32x4*)A.in[I_NFIN])[F.lane + 64 * j]; o[64 * j] = v[p][j] * rs * g; }
                } } }
    }
#undef CMB_PRE
}

__device__ __forceinline__ void p_scan(Frame& F) {
    const Args& A = *F.a;
    const int tid = F.tid, dir = tid >> 8, lt = tid & 255, wv = (tid >> 6) & 3, lane = F.lane, cl = lane & 15, q = lane >> 4;
    constexpr int RS = 68;
    LAS unsigned char* base = F.lds + dir * 51200;
    LAS unsigned char* At = base;
    LAS float* UX = (LAS float*)(base + 16384);
    LAS float* AY = (LAS float*)(base + 16384 + 17408);
    LAS float* CW = (LAS float*)(F.lds + 102400);
    const bf16_t* ZX = WSP(bf16_t, WS_ZX); const bf16_t* Gb = WSP(bf16_t, WS_G); bf16_t* YG = WSP(bf16_t, WS_YG);
    constexpr float L2E = 1.4426950408889634f;
    for (int u = F.bid; u < 256; u += F.G) {
        const int b = u >> 4, n = (u & 15) >> 1, half = u & 1; const int cb = n * 128 + half * 64;
        __syncthreads();
        for (int i = tid; i < 640; i += 512) CW[i] = i < 512 ? A.in[I_LCW][(i >> 7) * D + n * 128 + (i & 127)] : A.in[I_LCB][n * 128 + (i - 512)];
        bf16x8 bw[2][4];
        { const bf16_t* wg = WSP(bf16_t, WS_WG) + (size_t)((dir * 8 + n) * 2) * 128 * 128;
#pragma unroll
          for (int g = 0; g < 2; ++g)
#pragma unroll
            for (int ks = 0; ks < 4; ++ks) bw[g][ks] = *(const bf16x8*)(wg + (size_t)g * 128 * 128 + (half * 64 + 16 * wv + cl) * 128 + ks * 32 + q * 8); }
        const int chl = 16 * wv + cl;
        const float bias0 = A.in[I_LGB][(dir * 2 + 0) * D + cb + chl] * (-L2E), bias1 = A.in[I_LGB][(dir * 2 + 1) * D + cb + chl] * (-L2E);
        float sp8l; { const float lam = A.in[I_LLAM][dir * D + cb + chl]; sp8l = 8.0f * log1pf(__expf(-lam)) * L2E; }
        float hcar = 0.f;
        __syncthreads();
        const int o = lt & 15, tq = lt >> 4;
        float w[4][8], bsv[8];
#pragma unroll
        for (int k = 0; k < 4; ++k) { const f32x4 w0 = *(const LAS f32x4*)(CW + k * 128 + 8 * o), w1 = *(const LAS f32x4*)(CW + k * 128 + 8 * o + 4);
#pragma unroll
            for (int j = 0; j < 4; ++j) { w[k][j] = w0[j]; w[k][4 + j] = w1[j]; } }
        { const f32x4 b0 = *(const LAS f32x4*)(CW + 512 + 8 * o), b1 = *(const LAS f32x4*)(CW + 512 + 8 * o + 4);
#pragma unroll
          for (int j = 0; j < 4; ++j) { bsv[j] = b0[j]; bsv[4 + j] = b1[j]; } }
        const int sh16 = (q >= 1 ? lane - 16 : lane) << 2, sh32 = (q >= 2 ? lane - 32 : lane) << 2, shtot = (cl + 48) << 2;
        u32x4 z[7];
#define SCAN_GEOM(it_, c_, t0_, L_, rowbase_, first_) const bool isctx_##it_ = (it_) < 4; const int ci_##it_ = isctx_##it_ ? (it_) : (it_) - 4, nch_##it_ = isctx_##it_ ? 4 : 32; \
        const int c_ = dir == 0 ? ci_##it_ : nch_##it_ - 1 - ci_##it_; const int t0_ = c_ * 64, L_ = isctx_##it_ ? TCX : TL; const int rowbase_ = isctx_##it_ ? MLAT + b * TCX : b * TL; \
        const bool first_ = dir == 0 ? (c_ < nch_##it_ / 2) : (c_ >= nch_##it_ / 2);
#define SCAN_ZLOAD(t0_, L_, rowbase_) do { _Pragma("unroll") for (int r = 0; r < 7; ++r) { const int t = (t0_) + 4 * tq - 2 + r; \
        z[r] = (t >= 0 && t < (L_)) ? *(const u32x4*)(ZX + (size_t)((rowbase_) + t) * D + n * 128 + 8 * o) : (u32x4){0u, 0u, 0u, 0u}; } } while (0)
        { SCAN_GEOM(0, c0, t00, L0, rb0, f0) (void)f0; SCAN_ZLOAD(t00, L0, rb0); }
        for (int it = 0; it < 36; ++it) {
            SCAN_GEOM(it, c, t0, L, rowbase, first)
            {
#pragma unroll
              for (int tt = 0; tt < 4; ++tt) { float xc[8];
#pragma unroll
                  for (int j = 0; j < 8; ++j) xc[j] = bsv[j];
#pragma unroll
                  for (int k = 0; k < 4; ++k) { const u32x4 zz = z[tt + k]; const unsigned zw[4] = {zz.x, zz.y, zz.z, zz.w};
#pragma unroll
                      for (int j = 0; j < 4; ++j) { xc[2 * j] += w[k][2 * j] * __uint_as_float(zw[j] << 16); xc[2 * j + 1] += w[k][2 * j + 1] * __uint_as_float(zw[j] & 0xffff0000u); } }
                  const int tl = 4 * tq + tt, rr = dir == 0 ? tl : 63 - tl;
                  u32x4 pk; pk.x = cvt_pk_bf16(xc[0], xc[1]); pk.y = cvt_pk_bf16(xc[2], xc[3]); pk.z = cvt_pk_bf16(xc[4], xc[5]); pk.w = cvt_pk_bf16(xc[6], xc[7]);
                  *(LAS u32x4*)(At + rr * 256 + ((16 * o) ^ ((rr & 7) << 4))) = pk;
                  if ((o >> 3) == half) { LAS f32x4* ux = (LAS f32x4*)(UX + rr * RS + 8 * (o & 7)); ux[0] = (f32x4){xc[0], xc[1], xc[2], xc[3]}; ux[1] = (f32x4){xc[4], xc[5], xc[6], xc[7]}; } } }
            if (it + 1 < 36) { const int itn = it + 1; SCAN_GEOM(itn, cn, t0n, Ln, rbn, fn) (void)fn; (void)cn; SCAN_ZLOAD(t0n, Ln, rbn); }
            __syncthreads();
            u32x4 ps[2]; u32x4 pg[2];
#pragma unroll
            for (int qq = 0; qq < 2; ++qq) { const int item = lt + 256 * qq, tl = item >> 3, oc = item & 7; const size_t off = (size_t)(rowbase + t0 + tl) * D + cb + 8 * oc;
                if (!first) { ps[qq] = *(const u32x4*)(YG + off); pg[qq] = *(const u32x4*)(Gb + off); }
                else { ps[qq] = (u32x4){0u, 0u, 0u, 0u}; pg[qq] = ps[qq]; } }
            { f32x4 ga[2][4];
#pragma unroll
              for (int g = 0; g < 2; ++g)
#pragma unroll
                for (int mf = 0; mf < 4; ++mf) ga[g][mf] = (f32x4){0.f, 0.f, 0.f, 0.f};
#pragma unroll
              for (int mf = 0; mf < 4; ++mf)
#pragma unroll
                for (int ks = 0; ks < 4; ++ks) { const int row = 16 * mf + cl; const int colb = ks * 64 + q * 16;
                    const bf16x8 af = *(const LAS bf16x8*)(At + row * 256 + (colb ^ ((row & 7) << 4)));
                    ga[0][mf] = __builtin_amdgcn_mfma_f32_16x16x32_bf16(af, bw[0][ks], ga[0][mf], 0, 0, 0);
                    ga[1][mf] = __builtin_amdgcn_mfma_f32_16x16x32_bf16(af, bw[1][ks], ga[1][mf], 0, 0, 0); }
#pragma unroll
              for (int mf = 0; mf < 4; ++mf) {
#pragma unroll
                for (int rg = 0; rg < 4; ++rg) { const int row = 16 * mf + 4 * q + rg;
                    const float r = __builtin_amdgcn_rcpf(1.0f + __builtin_amdgcn_exp2f(ga[0][mf][rg] * (-L2E) + bias0)), ig = __builtin_amdgcn_rcpf(1.0f + __builtin_amdgcn_exp2f(ga[1][mf][rg] * (-L2E) + bias1));
                    const float av = __builtin_amdgcn_exp2f(-sp8l * r); const float mlt = __builtin_amdgcn_sqrtf(1.0f - av * av);
                    ga[0][mf][rg] = av; ga[1][mf][rg] = mlt * ig * UX[row * RS + chl]; }
#pragma unroll
                for (int rg = 1; rg < 4; ++rg) { ga[1][mf][rg] = ga[0][mf][rg] * ga[1][mf][rg - 1] + ga[1][mf][rg]; ga[0][mf][rg] = ga[0][mf][rg - 1] * ga[0][mf][rg]; } }
              float s = hcar;
#pragma unroll
              for (int mf = 0; mf < 4; ++mf) { float Ai = ga[0][mf][3], Hi = ga[1][mf][3];
#define BPERM(a_, v_) __int_as_float(__builtin_amdgcn_ds_bpermute((a_), __float_as_int(v_)))
                  { const float Ap = BPERM(sh16, Ai), Hp = BPERM(sh16, Hi); if (q >= 1) { Hi = Ai * Hp + Hi; Ai = Ai * Ap; } }
                  { const float Ap = BPERM(sh32, Ai), Hp = BPERM(sh32, Hi); if (q >= 2) { Hi = Ai * Hp + Hi; Ai = Ai * Ap; } }
                  const float ea = BPERM(sh16, Ai), eh = BPERM(sh16, Hi); const float Aex = q >= 1 ? ea : 1.0f, Hex = q >= 1 ? eh : 0.0f;
                  const float Ab = BPERM(shtot, Ai), Hb = BPERM(shtot, Hi);
#undef BPERM
                  const float hin = Aex * s + Hex;
#pragma unroll
                  for (int rg = 0; rg < 4; ++rg) AY[(16 * mf + 4 * q + rg) * RS + chl] = ga[0][mf][rg] * hin + ga[1][mf][rg];
                  s = Ab * s + Hb; }
              hcar = s; }
            __syncthreads();
#pragma unroll
            for (int qq = 0; qq < 2; ++qq) { const int item = lt + 256 * qq, tl = item >> 3, oc = item & 7, rr = dir == 0 ? tl : 63 - tl; const size_t off = (size_t)(rowbase + t0 + tl) * D + cb + 8 * oc;
                const f32x4 y0 = *(const LAS f32x4*)(AY + rr * RS + 8 * oc), y1 = *(const LAS f32x4*)(AY + rr * RS + 8 * oc + 4);
                if (first) { *(u32x4*)(YG + off) = pg8::pack8(y0, y1); }
                else { const u32x4 pw = ps[qq]; const u32x4 gg = pg[qq];
                    const f32x4 p0 = {__uint_as_float(pw.x << 16), __uint_as_float(pw.x & 0xffff0000u), __uint_as_float(pw.y << 16), __uint_as_float(pw.y & 0xffff0000u)};
                    const f32x4 p1 = {__uint_as_float(pw.z << 16), __uint_as_float(pw.z & 0xffff0000u), __uint_as_float(pw.w << 16), __uint_as_float(pw.w & 0xffff0000u)};
                    f32x4 o0, o1; o0[0] = (p0[0] + y0[0]) * __uint_as_float(gg.x << 16); o0[1] = (p0[1] + y0[1]) * __uint_as_float(gg.x & 0xffff0000u); o0[2] = (p0[2] + y0[2]) * __uint_as_float(gg.y << 16); o0[3] = (p0[3] + y0[3]) * __uint_as_float(gg.y & 0xffff0000u);
                    o1[0] = (p1[0] + y1[0]) * __uint_as_float(gg.z << 16); o1[1] = (p1[1] + y1[1]) * __uint_as_float(gg.z & 0xffff0000u); o1[2] = (p1[2] + y1[2]) * __uint_as_float(gg.w << 16); o1[3] = (p1[3] + y1[3]) * __uint_as_float(gg.w & 0xffff0000u);
                    *(u32x4*)(YG + off) = pg8::pack8(o0, o1); } }
        }
#undef SCAN_GEOM
#undef SCAN_ZLOAD
    }
    __syncthreads();
}

__device__ __forceinline__ void p_krope(Frame& F) {
    const bf16_t* Z = WSP(bf16_t, WS_Z); bf16_t* Kc = WSP(bf16_t, WS_K); const float* rope = WSP(float, WS_ROPE);
    for (int it = F.bid * 512 + F.tid; it < MT * NH; it += F.G * 512) {
        const int row = it >> 4, h = it & 15; const bool isl = row < MLAT;
        const int b = isl ? row / TL : (row - MLAT) / TCX; const int t = isl ? row - b * TL : (row - MLAT) - b * TCX; const int key = isl ? t : TL + t;
        const u32x4* zp = (const u32x4*)(Z + (size_t)row * ZW + 640);
        float x[32];
#pragma unroll
        for (int q = 0; q < 4; ++q) { const u32x4 w = zp[q]; const unsigned ww[4] = {w.x, w.y, w.z, w.w};
#pragma unroll
            for (int i = 0; i < 4; ++i) { x[8 * q + 2 * i] = __uint_as_float(ww[i] << 16); x[8 * q + 2 * i + 1] = __uint_as_float(ww[i] & 0xffff0000u); } }
        if (isl) {
#pragma unroll
            for (int ax = 0; ax < 2; ++ax) { const int pos = ax == 0 ? (t >> 6) : (t & 63);
#pragma unroll
                for (int f = 0; f < 8; ++f) { const float cs = rope[(pos * 8 + f) * 2], sn = rope[(pos * 8 + f) * 2 + 1]; const float x1 = x[ax * 16 + f], x2 = x[ax * 16 + 8 + f];
                    x[ax * 16 + f] = x1 * cs - x2 * sn; x[ax * 16 + 8 + f] = x1 * sn + x2 * cs; } } }
        u32x4* kp = (u32x4*)(Kc + ((size_t)(b * NH + h) * SKV + key) * DQK + 64);
#pragma unroll
        for (int q = 0; q < 4; ++q) { u32x4 w; w.x = cvt_pk_bf16(x[8 * q], x[8 * q + 1]); w.y = cvt_pk_bf16(x[8 * q + 2], x[8 * q + 3]); w.z = cvt_pk_bf16(x[8 * q + 4], x[8 * q + 5]); w.w = cvt_pk_bf16(x[8 * q + 6], x[8 * q + 7]); kp[q] = w; }
    }
}

namespace att {
constexpr int KVBLK = 64, QBLK = 32;
constexpr int SHM_K = KVBLK * 256, SHM_V = KVBLK * DV * 2;
constexpr float THRL = 8.0f;
#define KSWZ(row, colB) ((row) * 256 + ((colB) ^ (((row) & 7) << 4)))
#define SBAR() __builtin_amdgcn_sched_barrier(0)
__device__ __forceinline__ int crow(int r, int hi) { return (r & 3) + 8 * (r >> 2) + 4 * hi; }
__device__ __forceinline__ void partialSM(f32x16& p0, f32x16& p1, float& m_ref, unsigned& q6x, float& alpha, bool first, int hi) {
    float pmax = p0[0];
#pragma unroll
    for (int r = 1; r < 16; ++r) pmax = fmaxf(pmax, p0[r]);
#pragma unroll
    for (int r = 0; r < 16; ++r) pmax = fmaxf(pmax, p1[r]);
    { auto rr = __builtin_amdgcn_permlane32_swap(__float_as_uint(pmax), __float_as_uint(pmax), false, false); pmax = fmaxf(__uint_as_float(rr[0]), __uint_as_float(rr[1])); }
    if (__builtin_expect(!first && __all(pmax <= THRL), 1)) { alpha = 1.f; }
    else { const float dl = first ? pmax : fmaxf(pmax, 0.f);
        const float mnew = __uint_as_float(cvt_pk_bf16(m_ref + dl, 0.f) << 16);
        const float delta = mnew - m_ref;
#pragma unroll
        for (int r = 0; r < 16; ++r) { p0[r] -= delta; p1[r] -= delta; }
        alpha = first ? 1.f : __builtin_amdgcn_exp2f(-delta); m_ref = mnew;
        q6x = hi == 0 ? ((__float_as_uint(-mnew) >> 16) & 0xffffu) : 0u; }
#pragma unroll
    for (int r = 0; r < 16; ++r) p0[r] = __builtin_amdgcn_exp2f(p0[r]);
}
__device__ __forceinline__ void finishSM(f32x16& p0, f32x16& p1, bf16x8& pa0, bf16x8& pa1, bf16x8& pa2, bf16x8& pa3) {
#pragma unroll
    for (int r = 0; r < 16; ++r) p1[r] = __builtin_amdgcn_exp2f(p1[r]);
#define PK4(P, BASE, OUT) do { unsigned a0 = cvt_pk_bf16(P[BASE + 0], P[BASE + 1]), a1 = cvt_pk_bf16(P[BASE + 2], P[BASE + 3]);   \
    unsigned b0 = cvt_pk_bf16(P[BASE + 4], P[BASE + 5]), b1 = cvt_pk_bf16(P[BASE + 6], P[BASE + 7]);                              \
    auto r0 = __builtin_amdgcn_permlane32_swap(a0, b0, false, false); auto r1 = __builtin_amdgcn_permlane32_swap(a1, b1, false, false); \
    u32x4 w = {r0[0], r1[0], r0[1], r1[1]}; OUT = *reinterpret_cast<bf16x8*>(&w); } while (0)
    PK4(p0, 0, pa0); PK4(p0, 8, pa1); PK4(p1, 0, pa2); PK4(p1, 8, pa3);
#undef PK4
}
__device__ __forceinline__ void qkt(f32x16& p0, f32x16& p1, const char* Ks, const bf16x8* qr, unsigned q6x, int r32, int hi) {
    p0 = f32x16{}; p1 = f32x16{};
#pragma unroll
    for (int d0 = 0; d0 < 6; ++d0) { const int cb = (d0 * 16 + hi * 8) * 2;
        const bf16x8 b0 = *reinterpret_cast<const bf16x8*>(Ks + KSWZ(r32, cb));
        const bf16x8 b1 = *reinterpret_cast<const bf16x8*>(Ks + KSWZ(32 + r32, cb));
        p0 = __builtin_amdgcn_mfma_f32_32x32x16_bf16(b0, qr[d0], p0, 0, 0, 0);
        p1 = __builtin_amdgcn_mfma_f32_32x32x16_bf16(b1, qr[d0], p1, 0, 0, 0); }
    { const u32x4 kw = {hi == 0 ? 0x00003F80u : 0u, 0u, 0u, 0u}, qw = {q6x, 0u, 0u, 0u};
      const bf16x8 k6 = *reinterpret_cast<const bf16x8*>(&kw), q6 = *reinterpret_cast<const bf16x8*>(&qw);
      p0 = __builtin_amdgcn_mfma_f32_32x32x16_bf16(k6, q6, p0, 0, 0, 0);
      p1 = __builtin_amdgcn_mfma_f32_32x32x16_bf16(k6, q6, p1, 0, 0, 0); }
}
__device__ __forceinline__ int v_st(int k, int c) { const int kk = (k & ~0xC) | ((k & 4) << 1) | ((k & 8) >> 1); return ((kk >> 3) * 2 + (c >> 5)) * 512 + ((kk & 7) * 32 + (c & 31)) * 2; }
__device__ __forceinline__ int v_rd_base(int lane) { return ((lane & 3) << 3) | (((lane >> 2) & 3) << 6) | (((lane >> 4) & 1) << 5) | (((lane >> 5) & 1) << 8); }
constexpr int v_rd_off(int d0, int ks, int half) { return d0 * 512 + ks * 2048 + half * 1024; }
template <int OFF> __device__ __forceinline__ s16x4 tr_read(int vb) { s16x4 r; asm volatile("ds_read_b64_tr_b16 %0, %1 offset:%2" : "=&v"(r) : "v"(vb), "i"(OFF) : "memory"); return r; }
template <int D0> __device__ __forceinline__ void pv_one(f32x16& od, int vb, bf16x8 pa0, bf16x8 pa1, bf16x8 pa2, bf16x8 pa3) {
    const s16x4 l0 = tr_read<v_rd_off(D0, 0, 0)>(vb), h0 = tr_read<v_rd_off(D0, 0, 1)>(vb), l1 = tr_read<v_rd_off(D0, 1, 0)>(vb), h1 = tr_read<v_rd_off(D0, 1, 1)>(vb);
    const s16x4 l2 = tr_read<v_rd_off(D0, 2, 0)>(vb), h2 = tr_read<v_rd_off(D0, 2, 1)>(vb), l3 = tr_read<v_rd_off(D0, 3, 0)>(vb), h3 = tr_read<v_rd_off(D0, 3, 1)>(vb);
    asm volatile("s_waitcnt lgkmcnt(0)" ::: "memory"); SBAR();
#define PK(L, H) (bf16x8){L[0], L[1], L[2], L[3], H[0], H[1], H[2], H[3]}
    od = __builtin_amdgcn_mfma_f32_32x32x16_bf16(pa0, PK(l0, h0), od, 0, 0, 0);
    od = __builtin_amdgcn_mfma_f32_32x32x16_bf16(pa1, PK(l1, h1), od, 0, 0, 0);
    od = __builtin_amdgcn_mfma_f32_32x32x16_bf16(pa2, PK(l2, h2), od, 0, 0, 0);
    od = __builtin_amdgcn_mfma_f32_32x32x16_bf16(pa3, PK(l3, h3), od, 0, 0, 0);
#undef PK
}
__device__ __forceinline__ void pv_d0(f32x16* o, f32x16& osum, int vb, bf16x8 pa0, bf16x8 pa1, bf16x8 pa2, bf16x8 pa3) {
    pv_one<0>(o[0], vb, pa0, pa1, pa2, pa3); pv_one<1>(o[1], vb, pa0, pa1, pa2, pa3);
    const u32x4 ow = {0x3F803F80u, 0x3F803F80u, 0x3F803F80u, 0x3F803F80u}; const bf16x8 ones = *reinterpret_cast<const bf16x8*>(&ow);
    osum = __builtin_amdgcn_mfma_f32_32x32x16_bf16(pa0, ones, osum, 0, 0, 0);
    osum = __builtin_amdgcn_mfma_f32_32x32x16_bf16(pa1, ones, osum, 0, 0, 0);
    osum = __builtin_amdgcn_mfma_f32_32x32x16_bf16(pa2, ones, osum, 0, 0, 0);
    osum = __builtin_amdgcn_mfma_f32_32x32x16_bf16(pa3, ones, osum, 0, 0, 0);
}

__device__ __forceinline__ void pv_partial(f32x16* o, f32x16& osum, int vb, bf16x8 pa0, bf16x8 pa1, bf16x8 pa2, bf16x8 pa3,
                                           f32x16& p0, f32x16& p1, float& m_ref, unsigned& q6x, float& alpha, int hi) {
    pv_one<0>(o[0], vb, pa0, pa1, pa2, pa3);
    float pmax = p0[0];
#pragma unroll
    for (int r = 1; r < 16; ++r) pmax = fmaxf(pmax, p0[r]);
#pragma unroll
    for (int r = 0; r < 8; ++r) p0[r] = __builtin_amdgcn_exp2f(p0[r]);
    pv_one<1>(o[1], vb, pa0, pa1, pa2, pa3);
#pragma unroll
    for (int r = 8; r < 16; ++r) p0[r] = __builtin_amdgcn_exp2f(p0[r]);
#pragma unroll
    for (int r = 0; r < 16; ++r) pmax = fmaxf(pmax, p1[r]);
    { auto rr = __builtin_amdgcn_permlane32_swap(__float_as_uint(pmax), __float_as_uint(pmax), false, false); pmax = fmaxf(__uint_as_float(rr[0]), __uint_as_float(rr[1])); }
    const u32x4 ow = {0x3F803F80u, 0x3F803F80u, 0x3F803F80u, 0x3F803F80u}; const bf16x8 ones = *reinterpret_cast<const bf16x8*>(&ow);
    osum = __builtin_amdgcn_mfma_f32_32x32x16_bf16(pa0, ones, osum, 0, 0, 0);
    osum = __builtin_amdgcn_mfma_f32_32x32x16_bf16(pa1, ones, osum, 0, 0, 0);
    osum = __builtin_amdgcn_mfma_f32_32x32x16_bf16(pa2, ones, osum, 0, 0, 0);
    osum = __builtin_amdgcn_mfma_f32_32x32x16_bf16(pa3, ones, osum, 0, 0, 0);
    if (__builtin_expect(__all(pmax <= THRL), 1)) { alpha = 1.f; }
    else { const float dl = fmaxf(pmax, 0.f);
        const float mnew = __uint_as_float(cvt_pk_bf16(m_ref + dl, 0.f) << 16);
        const float delta = mnew - m_ref;
        alpha = __builtin_amdgcn_exp2f(-delta); m_ref = mnew;
#pragma unroll
        for (int r = 0; r < 16; ++r) { p0[r] *= alpha; p1[r] -= delta; }
        q6x = hi == 0 ? ((__float_as_uint(-mnew) >> 16) & 0xffffu) : 0u; }
}
__device__ __forceinline__ void attn_units(const bf16_t* __restrict__ Q, const bf16_t* __restrict__ Kc, const bf16_t* __restrict__ Vc, bf16_t* __restrict__ O, int u0, int ustep, int nunits, char* lds, LAS unsigned char* ldsl) {
    const int tid = threadIdx.x, wid = __builtin_amdgcn_readfirstlane(tid >> 6), lane = tid & 63, r32 = lane & 31, hi = lane >> 5;
    char* V_lds = lds; char* K_lds = lds + 2 * SHM_V;
    float* wsf = (float*)(lds + 2 * SHM_V + 2 * SHM_K) + wid * 64; float* al_l = wsf + 32;
    unsigned kofs[2], vofs;
#pragma unroll
    for (int i = 0; i < 2; ++i) { const int r = 4 * (2 * wid + i) + (lane >> 4), q = lane & 15; int c = q ^ (r & 7); c = c < 12 ? c : c - 4; kofs[i] = (unsigned)((r * DQK + c * 8) * 2); }
    { const int o = wid * 1024 + lane * 16, sI = o >> 9, wd = (o & 511) >> 1; const int kk = (sI >> 1) * 8 + (wd >> 5); const int k = (kk & ~0xC) | ((kk & 4) << 1) | ((kk & 8) >> 1);
      const int c = (sI & 1) * 32 + (wd & 31); vofs = (unsigned)((k * DV + c) * 2); }
    const int vb0 = (int)(uintptr_t)V_lds + v_rd_base(lane);
    bf16x8 qr[6];
#define DMA_K(Kp, t, b) do { const char* g_ = (const char*)(Kp) + (size_t)(t) * (KVBLK * DQK * 2); _Pragma("unroll") for (int i_ = 0; i_ < 2; ++i_) \
    __builtin_amdgcn_global_load_lds((const unsigned*)(g_ + kofs[i_]), (LAS unsigned*)(ldsl + 2 * SHM_V + (b) * SHM_K + (2 * wid + i_) * 1024), 16, 0, 0); } while (0)
#define DMA_V(Vp, t, b) do { const char* g_ = (const char*)(Vp) + (size_t)(t) * (KVBLK * DV * 2); \
    __builtin_amdgcn_global_load_lds((const unsigned*)(g_ + vofs), (LAS unsigned*)(ldsl + (b) * SHM_V + wid * 1024), 16, 0, 0); } while (0)
#define SWAIT() asm volatile("s_waitcnt vmcnt(0)" ::: "memory")
#define RESC(a) do { if (__any((a) < 1.f)) { if (hi == 0) al_l[r32] = (a); asm volatile("s_waitcnt lgkmcnt(0)" ::: "memory"); \
    _Pragma("unroll") for (int r = 0; r < 16; ++r) { const float f_ = al_l[crow(r, hi)]; o[0][r] *= f_; o[1][r] *= f_; osum[r] *= f_; } } } while (0)
#define UNIT_PTRS(u_, Kp, Vp, Qp) do { const int bh_ = (u_) >> 3, qb_ = (u_) & 7; Kp = Kc + (size_t)bh_ * SKV * DQK; Vp = Vc + (size_t)bh_ * SKV * DV; \
    Qp = Q + ((size_t)bh_ * TL + qb_ * 256 + wid * QBLK + r32) * DQK + hi * 8; } while (0)
#define QLOAD(Qp) do { _Pragma("unroll") for (int d0 = 0; d0 < 6; ++d0) qr[d0] = *reinterpret_cast<const bf16x8*>((Qp) + d0 * 16); } while (0)
    constexpr int NT = SKV / KVBLK;
    int u = u0; if (u >= nunits) return;
    const bf16_t* Kh; const bf16_t* Vh; const bf16_t* Qw;
    UNIT_PTRS(u, Kh, Vh, Qw);
    __syncthreads();
    DMA_K(Kh, 0, 0); DMA_V(Vh, 0, 0); DMA_K(Kh, 1, 1); QLOAD(Qw);
    for (;;) {
        float m_ref = 0.f; unsigned q6x = 0u; f32x16 o[2] = {}; f32x16 osum = {};
        f32x16 pA0, pA1, pB0, pB1; float alA, alB; bf16x8 pa0, pa1, pa2, pa3;
        bf16_t* Ow = O + ((size_t)((u >> 3) >> 4) * TL + (u & 7) * 256 + wid * QBLK) * D + ((u >> 3) & 15) * DV;
        SWAIT(); __syncthreads();
        qkt(pA0, pA1, K_lds, qr, q6x, r32, hi); partialSM(pA0, pA1, m_ref, q6x, alA, true, hi);
        __syncthreads();
        for (int j = 0; j + 2 < NT; j += 2) {
            DMA_K(Kh, j + 2, 0); DMA_V(Vh, j + 1, 1);
            SBAR(); qkt(pB0, pB1, K_lds + SHM_K, qr, q6x, r32, hi);
            finishSM(pA0, pA1, pa0, pa1, pa2, pa3); SBAR();
            pv_partial(o, osum, vb0, pa0, pa1, pa2, pa3, pB0, pB1, m_ref, q6x, alB, hi);
            RESC(alB); SWAIT(); __syncthreads();
            DMA_K(Kh, j + 3, 1); DMA_V(Vh, j + 2, 0);
            SBAR(); qkt(pA0, pA1, K_lds, qr, q6x, r32, hi);
            finishSM(pB0, pB1, pa0, pa1, pa2, pa3); SBAR();
            pv_partial(o, osum, vb0 + SHM_V, pa0, pa1, pa2, pa3, pA0, pA1, m_ref, q6x, alA, hi);
            RESC(alA); SWAIT(); __syncthreads();
        }
        const int un = u + ustep; const bool has_next = un < nunits;
        const bf16_t* Kn = Kh; const bf16_t* Vn = Vh; const bf16_t* Qn = Qw;
        if (has_next) UNIT_PTRS(un, Kn, Vn, Qn);
        if (has_next) DMA_K(Kn, 0, 0);
        DMA_V(Vh, NT - 1, 1);
        SBAR(); qkt(pB0, pB1, K_lds + SHM_K, qr, q6x, r32, hi);
        finishSM(pA0, pA1, pa0, pa1, pa2, pa3); SBAR();
        if (has_next) QLOAD(Qn);
        SBAR();
        pv_partial(o, osum, vb0, pa0, pa1, pa2, pa3, pB0, pB1, m_ref, q6x, alB, hi);
        RESC(alB); SWAIT(); __syncthreads();
        if (has_next) { DMA_K(Kn, 1, 1); DMA_V(Vn, 0, 0); }
        finishSM(pB0, pB1, pa0, pa1, pa2, pa3); SBAR();
        pv_d0(o, osum, vb0 + SHM_V, pa0, pa1, pa2, pa3);
        float rli[16];
#pragma unroll
        for (int r = 0; r < 16; ++r) rli[r] = __builtin_amdgcn_rcpf(osum[r]);
        { bf16_t* stg = (bf16_t*)(lds + 65536) + wid * 2048;
#pragma unroll
          for (int r = 0; r < 16; ++r) { const int orow = crow(r, hi);
#pragma unroll
              for (int d0 = 0; d0 < 2; ++d0) { const float val = o[d0][r] * rli[r]; stg[orow * 64 + d0 * 32 + r32] = (bf16_t)(cvt_pk_bf16(val, val) & 0xffffu); } }
          asm volatile("s_waitcnt lgkmcnt(0)" ::: "memory");
#pragma unroll
          for (int i = 0; i < 4; ++i) { const int row = i * 8 + (lane >> 3), ch = lane & 7; const u32x4 v = *(const u32x4*)(stg + row * 64 + ch * 8); *(u32x4*)(Ow + (size_t)row * D + ch * 8) = v; }
          asm volatile("s_waitcnt lgkmcnt(0)" ::: "memory"); }
        if (!has_next) break;
        u = un; Kh = Kn; Vh = Vn; Qw = Qn;
    }
    SWAIT();
#undef DMA_K
#undef DMA_V
#undef SWAIT
#undef RESC
#undef UNIT_PTRS
#undef QLOAD
}
#undef KSWZ
#undef SBAR
}

__device__ __forceinline__ void p_attention(Frame& F) {
    const int vcu = (F.G % 8 == 0) ? (F.bid % 8) * (F.G / 8) + F.bid / 8 : F.bid;
    att::attn_units(WSP(bf16_t, WS_Q), WSP(bf16_t, WS_K), WSP(bf16_t, WS_V), WSP(bf16_t, WS_O), vcu, F.G, NB * NH * 8, (char*)F.lds, F.lds);
    __syncthreads();
}

__device__ __forceinline__ void stage_gather_idx(Frame& F, const pg8::MoeOrder& S) {
    LAS unsigned* gi = (LAS unsigned*)(F.lds + pg8::STAGE_BYTES);
    const int* rowidx = WSP(int, WS_ROWIDX); pg8::Unit u;
    for (int i = 0; S.next(i, u); ++i) for (int r = F.tid; r < 256; r += 512) gi[i * 256 + r] = (unsigned)rowidx[u.arow + r] * (unsigned)(D * 2);
    __syncthreads();
}

constexpr int N_PHASES = 19;
__global__ void __launch_bounds__(NWAVES * 64, 2) mega_fwd(Args args) {
    extern __shared__ __attribute__((aligned(16))) unsigned char lds_raw[];
    Frame F; F.lds = (LAS unsigned char*)lds_raw; F.tid = threadIdx.x; F.lane = F.tid & 63; F.wave = __builtin_amdgcn_readfirstlane(F.tid >> 6);
    F.G = gridDim.x; F.bid = blockIdx.x; F.a = &args; F.ws = args.ws;
    cg::grid_group grid = cg::this_grid();
    const int lo = args.ph_lo, hi = args.ph_hi;
    volatile LAS unsigned* misc = (volatile LAS unsigned*)(F.lds + LDS_BYTES - 256);
    if (F.tid < 2) misc[F.tid] = 0u;
    __syncthreads();
    (void)xcd_barrier_post((unsigned*)args.ws, misc);
    if (lo < 0) grid.sync();
#ifdef ONLY_PHASE
#define IN(k) ((k) == ONLY_PHASE && lo <= (k) && (k) < hi)
#else
#define IN(k) (lo <= (k) && (k) < hi)
#endif
#define GRIDBAR() do { XcdBarrier xb_; xb_.bar = (unsigned*)args.ws; xb_.x = xb_xcc_id(); xb_.st = (volatile LAS unsigned*)(F.lds + LDS_BYTES - 256); xcd_barrier(xb_); } while (0)
#define PH(k, ...) if (IN(k)) { __VA_ARGS__ if ((DUP_MASK >> (k)) & 1u) { GRIDBAR(); __VA_ARGS__ } } SEAM(k);
#define SEAM(k) do { if (IN(k) && IN((k) + 1)) { XcdBarrier xb_; xb_.bar = (unsigned*)args.ws; xb_.x = xb_xcc_id(); xb_.st = (volatile LAS unsigned*)(F.lds + LDS_BYTES - 256); xcd_barrier(xb_); } } while (0)
    const Args& A = args;
    PH(0,  p0_prologue(F); )
    PH(1,  p_norm_in(F); )
    PH(2,
        pg8::DenseOrder S; S.init(MT, 2048, D, F.G, F.bid); pg8::EpiLruIn E{WSP(bf16_t, WS_G), WSP(bf16_t, WS_ZX)};
        pg8::gemm_phase<pg8::EpiLruIn, pg8::DenseOrder, false>(F.lds, WSP(bf16_t, WS_H), D, WSP(bf16_t, WS_WLIN), D, S, E, nullptr); )
    PH(3,  p_scan(F); )
    PH(4,
        pg8::DenseOrder S; S.init(MT, D, D, F.G, F.bid); pg8::EpiResid<false> E{A.in[I_X], A.in[I_CTX], WSP(bf16_t, WS_X), WSP(float, WS_MOD)};
        pg8::gemm_phase<pg8::EpiResid<false>, pg8::DenseOrder, false>(F.lds, WSP(bf16_t, WS_YG), D, WSP(bf16_t, WS_WLOUT), D, S, E, nullptr); )
    PH(5,  p_moe_norm(F, 0, MT); )
    PH(6,  p_topk(F, true); )
    PH(7,
        pg8::MoeOrder S; S.init(288, 8, 2048, F.G, F.bid); stage_gather_idx(F, S); pg8::EpiUp E{WSP(bf16_t, WS_HID)};
        pg8::gemm_phase<pg8::EpiUp, pg8::MoeOrder, true>(F.lds, WSP(bf16_t, WS_H), D, WSP(bf16_t, WS_WUP), D, S, E, (const LAS unsigned*)(F.lds + pg8::STAGE_BYTES)); )
    PH(8,
        pg8::MoeOrder S; S.init(288, 4, 1024, F.G, F.bid); pg8::EpiDown E{WSP(bf16_t, WS_Y), WSP(float, WS_GATEV)};
        pg8::gemm_phase<pg8::EpiDown, pg8::MoeOrder, false>(F.lds, WSP(bf16_t, WS_HID), D, WSP(bf16_t, WS_WDN), D, S, E, nullptr); )
    PH(9,  p_combine(F, 0, false); )
    PH(10,
        pg8::DenseOrder S; S.init(MT, ZW, D, F.G, F.bid); pg8::EpiZ E{WSP(bf16_t, WS_Z), WSP(float, WS_SSQ), WSP(float, WS_SSKV)};
        pg8::gemm_phase<pg8::EpiZ, pg8::DenseOrder, false>(F.lds, WSP(bf16_t, WS_H), D, WSP(bf16_t, WS_WMIN), D, S, E, nullptr); )
    PH(11,
        { LAS float* ropel = (LAS float*)(F.lds + pg8::STAGE_BYTES);
          for (int i = F.tid; i < 1024; i += 512) ropel[i] = WSP(float, WS_ROPE)[i];
          __syncthreads();
          pg8::DenseOrder S; S.init(MLAT, NH * DQK, QLORA, F.G, F.bid); pg8::EpiQ E{WSP(bf16_t, WS_Q), WSP(float, WS_SSQ), ropel};
          pg8::gemm_phase<pg8::EpiQ, pg8::DenseOrder, false>(F.lds, WSP(bf16_t, WS_Z), ZW, WSP(bf16_t, WS_WUQ), QLORA, S, E, nullptr); }
        { pg8::DenseOrder S; S.init(MT, NH * 128, KVLORA, F.G, F.bid); pg8::EpiKV E{WSP(bf16_t, WS_K), WSP(bf16_t, WS_V), WSP(float, WS_SSKV)};
          pg8::gemm_phase<pg8::EpiKV, pg8::DenseOrder, false>(F.lds, WSP(bf16_t, WS_Z) + QLORA, ZW, WSP(bf16_t, WS_WUKV), KVLORA, S, E, nullptr); }
        p_krope(F); )
    PH(12,  p_attention(F); )
    PH(13,
        pg8::DenseOrder S; S.init(MLAT, D, D, F.G, F.bid); pg8::EpiResid<true> E{nullptr, nullptr, WSP(bf16_t, WS_X), WSP(float, WS_MOD) + 17 * 6144};
        pg8::gemm_phase<pg8::EpiResid<true>, pg8::DenseOrder, false>(F.lds, WSP(bf16_t, WS_O), D, WSP(bf16_t, WS_WO), D, S, E, nullptr); )
    PH(14,  p_moe_norm(F, 1, MLAT); )
    PH(15,  p_topk(F, false); )
    PH(16,
        pg8::MoeOrder S; S.init(256, 8, 2048, F.G, F.bid); stage_gather_idx(F, S); pg8::EpiUp E{WSP(bf16_t, WS_HID)};
        pg8::gemm_phase<pg8::EpiUp, pg8::MoeOrder, true>(F.lds, WSP(bf16_t, WS_H), D, WSP(bf16_t, WS_WUP) + (size_t)NE * 2048 * 1024, D, S, E, (const LAS unsigned*)(F.lds + pg8::STAGE_BYTES)); )
    PH(17,
        pg8::MoeOrder S; S.init(256, 4, 1024, F.G, F.bid); pg8::EpiDown E{WSP(bf16_t, WS_Y), WSP(float, WS_GATEV)};
        pg8::gemm_phase<pg8::EpiDown, pg8::MoeOrder, false>(F.lds, WSP(bf16_t, WS_HID), D, WSP(bf16_t, WS_WDN) + (size_t)NE * 1024 * 1024, D, S, E, nullptr); )
    PH(18,  p_combine(F, 1, true); )
#undef IN
#undef SEAM
#undef PH
#undef GRIDBAR
}

extern "C" void kernel_launch(void* const* d_in, const int* in_sizes, int n_in, void* d_out, int out_size, void* d_ws, size_t ws_size, hipStream_t stream) {
    static int grid = 0;
    if (grid == 0) {
        if (n_in != 25 || in_sizes[0] != MLAT * D || out_size != MLAT * D || ws_size < WS_END) { fprintf(stderr, "kernel_launch: unexpected shapes (n_in %d, in0 %d, out %d, ws %zu)\n", n_in, n_in > 0 ? in_sizes[0] : -1, out_size, ws_size); grid = -1; return; }
        int dev = 0, cus = 0, per_cu = 0;
        if (hipGetDevice(&dev) != hipSuccess || hipDeviceGetAttribute(&cus, hipDeviceAttributeMultiprocessorCount, dev) != hipSuccess) { grid = -1; return; }
        if (hipFuncSetAttribute((const void*)mega_fwd, hipFuncAttributeMaxDynamicSharedMemorySize, LDS_BYTES) != hipSuccess) { fprintf(stderr, "kernel_launch: hipFuncSetAttribute failed\n"); grid = -1; return; }
        if (hipOccupancyMaxActiveBlocksPerMultiprocessor(&per_cu, (const void*)mega_fwd, NWAVES * 64, LDS_BYTES) != hipSuccess || per_cu < 1) { fprintf(stderr, "kernel_launch: occupancy query says %d\n", per_cu); (void)hipGetLastError(); per_cu = 1; }
        grid = cus * 1;
    }
    if (grid < 0) return;
    if (hipMemsetAsync(d_ws, 0, 16384, stream) != hipSuccess) { fprintf(stderr, "kernel_launch: memset of the barrier words failed\n"); return; }
    Args a{};
    for (int i = 0; i < 25; ++i) a.in[i] = (const float*)d_in[i];
    a.out = (float*)d_out; a.ws = (unsigned char*)d_ws;
#if MK_N_LAUNCHES == 1
    a.ph_lo = 0; a.ph_hi = N_PHASES;
    void* kargs[] = {&a};
    hipError_t e = hipLaunchCooperativeKernel((const void*)mega_fwd, dim3(grid), dim3(NWAVES * 64), kargs, LDS_BYTES, stream);
    if (e != hipSuccess) fprintf(stderr, "kernel_launch: cooperative launch failed: %s (grid %d)\n", hipGetErrorString(e), grid);
#else
    for (int p = 0; p < N_PHASES; ++p) { a.ph_lo = p; a.ph_hi = p + 1; void* kargs[] = {&a};
        hipError_t e = hipLaunchCooperativeKernel((const void*)mega_fwd, dim3(grid), dim3(NWAVES * 64), kargs, LDS_BYTES, stream);
        if (e != hipSuccess) { fprintf(stderr, "kernel_launch: launch %d failed: %s\n", p, hipGetErrorString(e)); break; } }
#endif
}
```

```cpp
#include <hip/hip_runtime.h>
#include <hip/hip_cooperative_groups.h>
#include <cstdio>
#include <cstdint>
namespace cg = cooperative_groups;

#ifndef DUP_MASK
#define DUP_MASK 0u
#endif
#ifndef MK_N_LAUNCHES
#define MK_N_LAUNCHES 1
#endif

#define LAS __attribute__((address_space(3)))
typedef unsigned short bf16_t;
typedef short bf16x8 __attribute__((ext_vector_type(8)));
typedef short s16x4 __attribute__((ext_vector_type(4)));
typedef float f32x2 __attribute__((ext_vector_type(2)));
typedef float f32x4 __attribute__((ext_vector_type(4)));
typedef float f32x16 __attribute__((ext_vector_type(16)));
typedef unsigned u32x2 __attribute__((ext_vector_type(2)));
typedef unsigned u32x4 __attribute__((ext_vector_type(4)));

constexpr int D = 1024, NB = 16, TL = 2048, TCX = 256, MLAT = NB * TL, MCTX = NB * TCX, MT = MLAT + MCTX;
constexpr int NE = 16, CAPL = 256, CAPC = 32, DEXP = 1024;
constexpr int MOE_LAT_ROWS = NB * NE * CAPL;
constexpr int MOE_ROWS0 = MOE_LAT_ROWS + NB * NE * CAPC;
constexpr int NH = 16, DQK = 96, DV = 64, QLORA = 384, KVLORA = 256, ZW = 768, SKV = TL + TCX;
constexpr float EPS = 1e-6f;
constexpr float QSCALE = 0.10206207261596575f * 1.4426950408889634f;

constexpr size_t MiB = 1u << 20;
constexpr size_t WS_MOD = 1 * MiB;
constexpr size_t WS_ROPE = 2 * MiB;
constexpr size_t WS_SSQ = 2 * MiB + 512 * 1024;
constexpr size_t WS_SSKV = WS_SSQ + 256 * 1024;
constexpr size_t WS_AFFL = 3 * MiB;
constexpr size_t WS_AFFC = 5 * MiB;
constexpr size_t WS_ROWIDX = 6 * MiB;
constexpr size_t WS_GATEV = 6 * MiB + 512 * 1024;
constexpr size_t WS_SEL = 7 * MiB;
constexpr size_t WS_WG = 10 * MiB;
constexpr size_t WS_WLIN = 16 * MiB;
constexpr size_t WS_WLOUT = 20 * MiB;
constexpr size_t WS_WMIN = 22 * MiB;
constexpr size_t WS_WUQ = 24 * MiB;
constexpr size_t WS_WUKV = 26 * MiB;
constexpr size_t WS_WO = 27 * MiB;
constexpr size_t WS_WUP = 32 * MiB;
constexpr size_t WS_WDN = 160 * MiB;
constexpr size_t WS_H = 224 * MiB;
constexpr size_t WS_G = 296 * MiB;
constexpr size_t WS_ZX = 368 * MiB;
constexpr size_t WS_YG = 440 * MiB;
constexpr size_t WS_Z = 296 * MiB;
constexpr size_t WS_Q = 352 * MiB;
constexpr size_t WS_X = 512 * MiB;
constexpr size_t WS_HID = 656 * MiB;
constexpr size_t WS_K = 656 * MiB;
constexpr size_t WS_Y = 800 * MiB;
constexpr size_t WS_V = 800 * MiB;
constexpr size_t WS_O = 872 * MiB;
constexpr size_t WS_END = 944 * MiB;

constexpr int LDS_BYTES = 147456;
constexpr int NWAVES = 8;

__device__ __forceinline__ unsigned cvt_pk_bf16(float lo, float hi) { unsigned r; asm volatile("v_cvt_pk_bf16_f32 %0, %1, %2" : "=v"(r) : "v"(lo), "v"(hi)); return r; }
__device__ __forceinline__ float bf2f(unsigned short h) { return __uint_as_float(((unsigned)h) << 16); }
__device__ __forceinline__ float wave_sum(float v) {
#pragma unroll
    for (int o = 1; o < 64; o <<= 1) v += __shfl_xor(v, o);
    return v;
}
__device__ __forceinline__ int wave_isum(int v) {
#pragma unroll
    for (int o = 1; o < 64; o <<= 1) v += __shfl_xor(v, o);
    return v;
}
__device__ __forceinline__ float sigmoidf_(float x) { return 1.0f / (1.0f + __expf(-x)); }
__device__ __forceinline__ float gelu_tanh(float x) {
    constexpr float A = 1.5957691216057308f * 1.4426950408889634f, B = A * 0.044715f;
    const float w = x * (A + B * (x * x));
    return x * __builtin_amdgcn_rcpf(1.0f + __builtin_amdgcn_exp2f(-w));
}

namespace pg8 {
constexpr int BM = 256, BK = 64, HALF = 128, HTB = HALF * BK * 2, STAGE_BYTES = 8 * HTB;
__device__ __forceinline__ int lds_byte(int r, int c) { const int st = (r >> 4) * 2 + (c >> 5), rr = r & 15, cc = c & 31, ob = rr * 64 + cc * 2; return st * 1024 + (ob ^ (((ob >> 9) & 1) << 5)); }
__device__ __forceinline__ void stage_rc(int b, int& R, int& C) { const int st = b / 1024, sb = b % 1024, swz = sb ^ (((sb >> 9) & 1) << 5); R = (st >> 1) * 16 + swz / 64; C = (st & 1) * 32 + (swz % 64) / 2; }
__device__ __forceinline__ int perm32(int rho) { const int n = rho >> 4, i = rho & 15; return 8 * (i >> 2) + 4 * n + (i & 3); }

struct Unit { int pm, pn, arow, boff; };

struct DenseOrder {
    int nM, nN, nwg, G, c, K;
    __device__ __forceinline__ void init(int M, int N, int K_, int G_, int c_) { nM = M / BM; nN = N / BM; nwg = nM * nN; G = G_; c = c_; K = K_; }
    __device__ __forceinline__ bool next(int i, Unit& u) const {
        const long L = (long)i * G + c; if (L >= nwg) return false;
        int wgid = (int)L; { const int q = nwg / 8, r = nwg % 8, xcd = wgid % 8, off = wgid / 8; wgid = (xcd < r ? xcd * (q + 1) : r * (q + 1) + (xcd - r) * q) + off; }
        const int nig = 8 * nN, gid = wgid / nig, fm = gid * 8, gsz = (nM - fm) < 8 ? (nM - fm) : 8;
        u.pm = fm + ((wgid % nig) % gsz); u.pn = (wgid % nig) / gsz; u.arow = u.pm * BM; u.boff = u.pn * BM * K; return true;
    }
};
struct MoeOrder {
    int nRT, nPN, G, vc, Nexp;
    __device__ __forceinline__ void init(int nRT_, int nPN_, int Nexp_, int G_, int c_) { nRT = nRT_; nPN = nPN_; Nexp = Nexp_; G = G_; vc = (G_ % 8 == 0) ? (c_ % 8) * (G_ / 8) + c_ / 8 : c_; }
    __device__ __forceinline__ bool next(int i, Unit& u) const {
        const long L = (long)i * G + vc; if (L >= (long)nRT * nPN) return false;
        const int rt = (int)(L / nPN), pn = (int)(L % nPN);
        const int e = rt < 256 ? (rt >> 4) : ((rt - 256) >> 1);
        u.pm = rt; u.pn = pn; u.arow = rt * BM; u.boff = (e * Nexp + pn * BM) * 1024; return true;
    }
};

template <class Epi, class Sched, bool GATHER>
__device__ __forceinline__ void gemm_phase(LAS unsigned char* lds, const bf16_t* A, int lda, const bf16_t* Bt, int K, const Sched& S, const Epi& E, const LAS unsigned* gidx) {
    const int tid = threadIdx.x, wid = __builtin_amdgcn_readfirstlane(tid >> 6), lane = tid & 63, wr = wid >> 2, wc = wid & 3, fr = lane & 15, fq = lane >> 4;
    const int nt = K / BK;
    int RA[2]; unsigned CA2[2], voffB[2];
#pragma unroll
    for (int i = 0; i < 2; ++i) { int R, C; stage_rc(tid * 16 + i * 8192, R, C); const int Rb = Epi::PERM ? ((R & ~31) + perm32(R & 31)) : R;
        RA[i] = R; CA2[i] = (unsigned)C * 2u; voffB[i] = (unsigned)(Rb * K + C) * 2u; }
    const size_t kstep = (size_t)(BK * 2);
    const size_t hstepB = (size_t)HALF * K * 2;
    const unsigned ldsw = (unsigned)wid * 1024u;
    const int aoff = lds_byte(wr * 64 + fr, fq * 8), boff = lds_byte(wc * 32 + fr, fq * 8);
    const char* Ab = (const char*)A; const char* Bb = (const char*)Bt;
#define PG8_SA(b, h) (((b) * 2 + (h)) * HTB)
#define PG8_SB(b, h) ((4 + (b) * 2 + (h)) * HTB)
#define PG8_STAGE(bufoff, gbase, voff) do { _Pragma("unroll") for (int _i = 0; _i < 2; ++_i) \
        __builtin_amdgcn_global_load_lds((const unsigned*)((const char*)(gbase) + (voff)[_i]), (LAS unsigned*)(lds + (bufoff) + ldsw + _i * 8192), 16, 0, 0); } while (0)
#define PG8_LDA(dst, b, h) do { _Pragma("unroll") for (int m = 0; m < 4; ++m) _Pragma("unroll") for (int k = 0; k < 2; ++k) dst[m][k] = *(const LAS bf16x8*)(lds + PG8_SA(b, h) + aoff + m * 2048 + k * 1024); } while (0)
#define PG8_LDB(dst, b, h) do { _Pragma("unroll") for (int n = 0; n < 2; ++n) _Pragma("unroll") for (int k = 0; k < 2; ++k) dst[n][k] = *(const LAS bf16x8*)(lds + PG8_SB(b, h) + boff + n * 2048 + k * 1024); } while (0)
#define PG8_MMA(ai, bj, At, Bt_) do { __builtin_amdgcn_s_setprio(1); _Pragma("unroll") for (int m = 0; m < 4; ++m) _Pragma("unroll") for (int n = 0; n < 2; ++n) _Pragma("unroll") for (int k = 0; k < 2; ++k) \
        acc[ai][bj][m][n] = __builtin_amdgcn_mfma_f32_16x16x32_bf16(Bt_[n][k], At[m][k], acc[ai][bj][m][n], 0, 0, 0); __builtin_amdgcn_s_setprio(0); } while (0)
#define PG8_WAIT_V(n) asm volatile("s_waitcnt vmcnt(" #n ")" ::: "memory")
#define PG8_WAIT_L(n) asm volatile("s_waitcnt lgkmcnt(" #n ")" ::: "memory")
#define PG8_BAR __builtin_amdgcn_s_barrier()
#define PG8_SCHED __builtin_amdgcn_sched_barrier(0)
#define PG8_SET_AOFF(ao, u, uidx) do { _Pragma("unroll") for (int _h = 0; _h < 2; ++_h) _Pragma("unroll") for (int _i = 0; _i < 2; ++_i) \
        ao[_h][_i] = (GATHER ? gidx[(uidx) * 256 + _h * 128 + RA[_i]] : (unsigned)(((u).arow + _h * 128 + RA[_i]) * lda) * 2u) + CA2[_i]; } while (0)
    Unit cur, nxt; int ui = 0;
    if (!S.next(0, cur)) return;
    f32x4 acc[2][2][4][2];
#pragma unroll
    for (int a = 0; a < 2; ++a)
#pragma unroll
        for (int b = 0; b < 2; ++b)
#pragma unroll
            for (int m = 0; m < 4; ++m)
#pragma unroll
                for (int n = 0; n < 2; ++n) acc[a][b][m][n] = (f32x4){0.f, 0.f, 0.f, 0.f};
    bf16x8 At[4][2], B0[2][2], B1[2][2];
    unsigned aoc[2][2], aon[2][2];
    PG8_SET_AOFF(aoc, cur, 0);
    const char* cB = Bb + (size_t)cur.boff * 2;
    PG8_STAGE(PG8_SB(0, 0), cB, voffB); PG8_STAGE(PG8_SB(0, 1), cB + hstepB, voffB); PG8_STAGE(PG8_SA(0, 0), Ab, aoc[0]); PG8_STAGE(PG8_SA(0, 1), Ab, aoc[1]);
    if (wr == 1) PG8_BAR;
    PG8_WAIT_V(2); PG8_BAR;
    PG8_STAGE(PG8_SB(1, 0), cB + kstep, voffB); PG8_STAGE(PG8_SA(1, 0), Ab + kstep, aoc[0]); PG8_STAGE(PG8_SB(1, 1), cB + hstepB + kstep, voffB);
    PG8_WAIT_V(6); PG8_BAR;
    for (;;) {
        const bool has_next = S.next(ui + 1, nxt);
        const char* nB = has_next ? Bb + (size_t)nxt.boff * 2 : cB;
        if (has_next) { PG8_SET_AOFF(aon, nxt, ui + 1); }
        else {
#pragma unroll
            for (int _h = 0; _h < 2; ++_h)
#pragma unroll
                for (int _i = 0; _i < 2; ++_i) aon[_h][_i] = aoc[_h][_i]; }
#pragma unroll 1
        for (int t = 0; t < nt; t += 2) {
            const bool last = (t == nt - 2);
            const char* a1 = Ab + (size_t)(t + 1) * kstep;
            const char* a2 = last ? Ab : Ab + (size_t)(t + 2) * kstep; const char* b2 = last ? nB : cB + (size_t)(t + 2) * kstep;
            const char* a3 = a2 + kstep; const char* b3 = b2 + kstep;
            unsigned a2o[2][2];
#pragma unroll
            for (int _h = 0; _h < 2; ++_h)
#pragma unroll
                for (int _i = 0; _i < 2; ++_i) a2o[_h][_i] = last ? aon[_h][_i] : aoc[_h][_i];
            PG8_LDB(B0, 0, 0); PG8_LDB(B1, 0, 1); PG8_SCHED; PG8_LDA(At, 0, 0); PG8_STAGE(PG8_SA(1, 1), a1, aoc[1]);
            PG8_WAIT_V(8); PG8_WAIT_L(0); PG8_BAR; PG8_MMA(0, 0, At, B0); PG8_MMA(0, 1, At, B1); PG8_BAR; PG8_SCHED;
            PG8_LDA(At, 0, 1); PG8_STAGE(PG8_SB(0, 0), b2, voffB); PG8_STAGE(PG8_SB(0, 1), b2 + hstepB, voffB); PG8_STAGE(PG8_SA(0, 0), a2, a2o[0]);
            PG8_WAIT_V(8); PG8_WAIT_L(0); PG8_BAR; PG8_MMA(1, 0, At, B0); PG8_MMA(1, 1, At, B1); PG8_BAR; PG8_SCHED;
            PG8_LDB(B0, 1, 0); PG8_LDB(B1, 1, 1); PG8_SCHED; PG8_LDA(At, 1, 0); PG8_STAGE(PG8_SA(0, 1), a2, a2o[1]);
            PG8_WAIT_V(8); PG8_WAIT_L(0); PG8_BAR; PG8_MMA(0, 0, At, B0); PG8_MMA(0, 1, At, B1); PG8_BAR; PG8_SCHED;
            PG8_LDA(At, 1, 1); PG8_STAGE(PG8_SB(1, 0), b3, voffB); PG8_STAGE(PG8_SB(1, 1), b3 + hstepB, voffB); PG8_STAGE(PG8_SA(1, 0), a3, a2o[0]);
            PG8_WAIT_V(8); PG8_WAIT_L(0); PG8_BAR; PG8_MMA(1, 0, At, B0); PG8_MMA(1, 1, At, B1); PG8_BAR; PG8_SCHED;
        }
        if (wr == 0) PG8_BAR;
        E(acc, cur, wr, wc, fr, fq);
        if (!has_next) break;
#pragma unroll
        for (int a = 0; a < 2; ++a)
#pragma unroll
            for (int b = 0; b < 2; ++b)
#pragma unroll
                for (int m = 0; m < 4; ++m)
#pragma unroll
                    for (int n = 0; n < 2; ++n) acc[a][b][m][n] = (f32x4){0.f, 0.f, 0.f, 0.f};
        cur = nxt; cB = nB; ++ui;
#pragma unroll
        for (int _h = 0; _h < 2; ++_h)
#pragma unroll
            for (int _i = 0; _i < 2; ++_i) aoc[_h][_i] = aon[_h][_i];
        if (wr == 1) PG8_BAR;
    }
    PG8_WAIT_V(0);
    PG8_BAR;
#undef PG8_SA
#undef PG8_SB
#undef PG8_STAGE
#undef PG8_LDA
#undef PG8_LDB
#undef PG8_MMA
#undef PG8_WAIT_V
#undef PG8_WAIT_L
#undef PG8_BAR
#undef PG8_SCHED
#undef PG8_SET_AOFF
}

#define EPI_ARGS const f32x4 (&acc)[2][2][4][2], const Unit& u, int wr, int wc, int fr, int fq
__device__ __forceinline__ u32x4 pack8(const f32x4& a, const f32x4& b) { u32x4 w; w.x = cvt_pk_bf16(a[0], a[1]); w.y = cvt_pk_bf16(a[2], a[3]); w.z = cvt_pk_bf16(b[0], b[1]); w.w = cvt_pk_bf16(b[2], b[3]); return w; }

__device__ __forceinline__ int coalesce_addr(int lane) { return (16 * (lane & 3) + (lane >> 2)) << 2; }
__device__ __forceinline__ u32x4 coalesce16(const u32x4& w, int paddr) {
    u32x4 r; r.x = (unsigned)__builtin_amdgcn_ds_bpermute(paddr, (int)w.x); r.y = (unsigned)__builtin_amdgcn_ds_bpermute(paddr, (int)w.y);
    r.z = (unsigned)__builtin_amdgcn_ds_bpermute(paddr, (int)w.z); r.w = (unsigned)__builtin_amdgcn_ds_bpermute(paddr, (int)w.w); return r;
}
struct EpiLruIn {
    static constexpr bool PERM = true;
    bf16_t* G; bf16_t* ZX;
    __device__ __forceinline__ void operator()(EPI_ARGS) const {
        const bool act = u.pn < 4; bf16_t* base = act ? G : ZX; const int colt = (u.pn & 3) * BM;
        const int lane = fq * 16 + fr, pa = coalesce_addr(lane), rl = lane >> 2, cl = lane & 3;
        const int rowdst = u.pm * BM + wr * 64 + rl, col0 = colt + wc * 32 + 8 * cl;
#pragma unroll
        for (int ai = 0; ai < 2; ++ai)
#pragma unroll
            for (int m = 0; m < 4; ++m) { bf16_t* rowp = base + (size_t)(rowdst + ai * HALF + m * 16) * D + col0;
#pragma unroll
                for (int bj = 0; bj < 2; ++bj) { f32x4 v0 = acc[ai][bj][m][0], v1 = acc[ai][bj][m][1];
                    if (act) {
#pragma unroll
                        for (int j = 0; j < 4; ++j) { v0[j] = gelu_tanh(v0[j]); v1[j] = gelu_tanh(v1[j]); } }
                    *(u32x4*)(rowp + bj * HALF) = coalesce16(pack8(v0, v1), pa); } }
    }
};
template <bool BASE_BF16> struct EpiResid {
    static constexpr bool PERM = true;
    const float* base_lat; const float* base_ctx; bf16_t* X; const float* modl;
    __device__ __forceinline__ void operator()(EPI_ARGS) const {
        const int rowt = u.pm * BM; const bool isl = rowt < MLAT;
        const float* bs = isl ? base_lat + (size_t)rowt * D : base_ctx + (size_t)(rowt - MLAT) * D;
        const int bidx = isl ? rowt / TL : 16;
        const float* gv = modl + bidx * 6144 + 2 * D;
        bf16_t* xo = X + (size_t)rowt * D;
        const int lane = fq * 16 + fr, pa = coalesce_addr(lane), rl = lane >> 2, cl = lane & 3;
        const int cols = u.pn * BM + wc * 32 + 8 * fq; int cold = u.pn * BM + wc * 32 + 8 * cl, r0 = wr * 64 + rl;
        asm volatile("" : "+v"(cold), "+v"(r0));
        f32x4 g[2][2];
#pragma unroll
        for (int bj = 0; bj < 2; ++bj)
#pragma unroll
            for (int n = 0; n < 2; ++n) g[bj][n] = *(const f32x4*)(gv + cols + bj * HALF + n * 4);
        constexpr int RDEPTH = 3;
        f32x4 bf[8][2][2]; u32x4 bw[8][2];
#define RESID_LOAD(s_) do { const size_t off_ = (size_t)(r0 + ((s_) >> 2) * HALF + ((s_) & 3) * 16) * D + cold; _Pragma("unroll") for (int bj = 0; bj < 2; ++bj) { \
            if (BASE_BF16) bw[s_][bj] = *(const u32x4*)(xo + off_ + bj * HALF); \
            else { bf[s_][bj][0] = *(const f32x4*)(bs + off_ + bj * HALF); bf[s_][bj][1] = *(const f32x4*)(bs + off_ + bj * HALF + 4); } } } while (0)
#pragma unroll
        for (int s = 0; s < RDEPTH; ++s) RESID_LOAD(s);
#pragma unroll
        for (int s = 0; s < 8; ++s) { const int ai = s >> 2, m = s & 3; const size_t off = (size_t)(r0 + ai * HALF + m * 16) * D + cold;
            if (s + RDEPTH < 8) RESID_LOAD(s + RDEPTH);
            asm volatile("" ::: "memory");
#pragma unroll
            for (int bj = 0; bj < 2; ++bj) { f32x4 b0, b1;
                if (BASE_BF16) { const u32x4 w = bw[s][bj];
                    b0 = (f32x4){__uint_as_float(w.x << 16), __uint_as_float(w.x & 0xffff0000u), __uint_as_float(w.y << 16), __uint_as_float(w.y & 0xffff0000u)};
                    b1 = (f32x4){__uint_as_float(w.z << 16), __uint_as_float(w.z & 0xffff0000u), __uint_as_float(w.w << 16), __uint_as_float(w.w & 0xffff0000u)}; }
                else { b0 = bf[s][bj][0]; b1 = bf[s][bj][1]; }
                const u32x4 d = coalesce16(pack8(g[bj][0] * acc[ai][bj][m][0], g[bj][1] * acc[ai][bj][m][1]), pa);
                const f32x4 d0 = (f32x4){__uint_as_float(d.x << 16), __uint_as_float(d.x & 0xffff0000u), __uint_as_float(d.y << 16), __uint_as_float(d.y & 0xffff0000u)};
                const f32x4 d1 = (f32x4){__uint_as_float(d.z << 16), __uint_as_float(d.z & 0xffff0000u), __uint_as_float(d.w << 16), __uint_as_float(d.w & 0xffff0000u)};
                *(u32x4*)(xo + off + bj * HALF) = pack8(b0 + d0, b1 + d1); }
            asm volatile("" ::: "memory"); }
#undef RESID_LOAD
    }
};
struct EpiZ {
    static constexpr bool PERM = true;
    bf16_t* Z; float* ssq; float* sskv; LAS float* red;
    __device__ __forceinline__ void operator()(EPI_ARGS) const {
        const int lane = fq * 16 + fr, pa = coalesce_addr(lane), rl = lane >> 2, cl = lane & 3;
        const int rowdst = u.pm * BM + wr * 64 + rl, col0 = u.pn * BM + wc * 32 + 8 * cl;
#pragma unroll
        for (int ai = 0; ai < 2; ++ai)
#pragma unroll
            for (int m = 0; m < 4; ++m) { bf16_t* rowp = Z + (size_t)(rowdst + ai * HALF + m * 16) * ZW + col0;
#pragma unroll
                for (int bj = 0; bj < 2; ++bj) { const f32x4 v0 = acc[ai][bj][m][0], v1 = acc[ai][bj][m][1];
                    *(u32x4*)(rowp + bj * HALF) = coalesce16(pack8(v0, v1), pa);
                    float s = (v0[0] * v0[0] + v0[1] * v0[1]) + (v0[2] * v0[2] + v0[3] * v0[3]) + (v1[0] * v1[0] + v1[1] * v1[1]) + (v1[2] * v1[2] + v1[3] * v1[3]);
                    s += __shfl_xor(s, 16); s += __shfl_xor(s, 32);
                    if (fq == 0) red[((wr * 16 + (ai * 4 + m) * 2 + bj) * 4 + wc) * 16 + fr] = s; } }
        asm volatile("s_waitcnt lgkmcnt(0)" ::: "memory"); __builtin_amdgcn_s_barrier(); asm volatile("" ::: "memory");
        { const int widx = wr * 4 + wc, idx = widx * 64 + lane;
          const int wr2 = idx >> 8, step = (idx >> 4) & 15, r16 = idx & 15; const int ai = step >> 3, m = (step >> 1) & 3, bj = step & 1;
          const LAS float* rp = red + ((wr2 * 16 + step) * 4) * 16 + r16;
          const float s = (rp[0] + rp[16]) + (rp[32] + rp[48]);
          const int hb = 2 * u.pn + bj;
          const int row = u.pm * BM + wr2 * 64 + ai * HALF + m * 16 + r16;
          if (hb < 5) atomicAdd((hb < 3 ? ssq : sskv) + row, s); }
    }
};
struct EpiQ {
    static constexpr bool PERM = true;
    bf16_t* Q; const float* ssq; const LAS float* ropel;
    __device__ __forceinline__ void operator()(EPI_ARGS) const {
        int row0 = u.pm * BM + wr * 64 + fr;
        asm volatile("" : "+v"(row0));
        float rsv[2][4];
#pragma unroll
        for (int ai = 0; ai < 2; ++ai)
#pragma unroll
            for (int m = 0; m < 4; ++m) rsv[ai][m] = ssq[row0 + ai * HALF + m * 16];
#pragma unroll
        for (int ai = 0; ai < 2; ++ai)
#pragma unroll
            for (int m = 0; m < 4; ++m) rsv[ai][m] = rsqrtf(rsv[ai][m] * (1.0f / QLORA) + EPS) * QSCALE;
        const int lane = fq * 16 + fr, pa = coalesce_addr(lane);
#pragma unroll
        for (int bj = 0; bj < 2; ++bj) {
            const int c0 = u.pn * BM + bj * HALF + wc * 32 + 8 * fq; const int h = c0 / DQK, dd = c0 - h * DQK;
            const bool isrope = dd >= 64; const int axis = (dd - 64) >> 4;
            const int cd = u.pn * BM + bj * HALF + wc * 32 + 8 * (lane & 3); const int hd = cd / DQK, ddd = cd - hd * DQK;
            bf16_t* qbase = Q + (size_t)hd * TL * DQK + ddd;
#pragma unroll
            for (int ai = 0; ai < 2; ++ai)
#pragma unroll
                for (int m = 0; m < 4; ++m) { const int row = row0 + ai * HALF + m * 16; const int t = row & (TL - 1);
                    const float rs = rsv[ai][m];
                    f32x4 v0 = acc[ai][bj][m][0] * rs, v1 = acc[ai][bj][m][1] * rs;
                    if (isrope) {
                        const int pos = axis == 0 ? (t >> 6) : (t & 63);
                        const LAS f32x4* cs = (const LAS f32x4*)(ropel + pos * 16);
                        const f32x4 t0 = cs[0], t1 = cs[1], t2 = cs[2], t3 = cs[3];
                        const float cosv[8] = {t0[0], t0[2], t1[0], t1[2], t2[0], t2[2], t3[0], t3[2]}, sinv[8] = {t0[1], t0[3], t1[1], t1[3], t2[1], t2[3], t3[1], t3[3]};
                        const bool second = fq & 1;
#pragma unroll
                        for (int j = 0; j < 4; ++j) { const float p0 = __shfl_xor(v0[j], 16), p1 = __shfl_xor(v1[j], 16);
                            v0[j] = second ? (p0 * sinv[j] + v0[j] * cosv[j]) : (v0[j] * cosv[j] - p0 * sinv[j]);
                            v1[j] = second ? (p1 * sinv[4 + j] + v1[j] * cosv[4 + j]) : (v1[j] * cosv[4 + j] - p1 * sinv[4 + j]); } }
                    { const int rowd = u.pm * BM + wr * 64 + ai * HALF + m * 16 + (lane >> 2); const int bd = rowd / TL, td = rowd - bd * TL;
                      *(u32x4*)(qbase + ((size_t)(bd * NH) * TL + td) * DQK) = coalesce16(pack8(v0, v1), pa); }
                    asm volatile("" ::: "memory"); }
        }
    }
};
struct EpiKV {
    static constexpr bool PERM = true;
    bf16_t* Kc; bf16_t* Vc; const float* sskv;
    __device__ __forceinline__ void operator()(EPI_ARGS) const {
        const int rowt = u.pm * BM; const bool isl = rowt < MLAT;
        const int b = isl ? rowt / TL : (rowt - MLAT) / TCX; const int key0 = isl ? rowt - b * TL : TL + (rowt - MLAT - b * TCX);
        const int lane = fq * 16 + fr, pa = coalesce_addr(lane), rl = lane >> 2, cl = lane & 3;
        const int rsrc = wr * 64 + fr, rdst = wr * 64 + rl; const bool isv = wc >= 2; const int cc = (wc & 1) * 32 + 8 * cl;
#pragma unroll
        for (int ai = 0; ai < 2; ++ai)
#pragma unroll
            for (int m = 0; m < 4; ++m) { const float rs = rsqrtf(sskv[rowt + rsrc + ai * HALF + m * 16] * (1.0f / KVLORA) + EPS); const int rd = rdst + ai * HALF + m * 16;
#pragma unroll
                for (int bj = 0; bj < 2; ++bj) { const int h = 2 * u.pn + bj; const size_t kr = (size_t)(b * NH + h) * SKV + key0 + rd;
                    bf16_t* dst = isv ? Vc + kr * DV + cc : Kc + kr * DQK + cc;
                    *(u32x4*)dst = coalesce16(pack8(acc[ai][bj][m][0] * rs, acc[ai][bj][m][1] * rs), pa); } }
    }
};
struct EpiUp {
    static constexpr bool PERM = true;
    bf16_t* HID;
    __device__ __forceinline__ void operator()(EPI_ARGS) const {
        const int lane = fq * 16 + fr, pa = coalesce_addr(lane), rl = lane >> 2, cl = lane & 3;
        const int rowdst = u.pm * BM + wr * 64 + rl, col0 = u.pn * HALF + wc * 32 + 8 * cl;
#pragma unroll
        for (int ai = 0; ai < 2; ++ai)
#pragma unroll
            for (int m = 0; m < 4; ++m) { f32x4 o0, o1;
#pragma unroll
                for (int j = 0; j < 4; ++j) { const float g0 = acc[ai][0][m][0][j], g1 = acc[ai][0][m][1][j];
                    o0[j] = g0 * __builtin_amdgcn_rcpf(1.0f + __builtin_amdgcn_exp2f(-g0)) * acc[ai][1][m][0][j]; o1[j] = g1 * __builtin_amdgcn_rcpf(1.0f + __builtin_amdgcn_exp2f(-g1)) * acc[ai][1][m][1][j]; }
                *(u32x4*)(HID + (size_t)(rowdst + ai * HALF + m * 16) * DEXP + col0) = coalesce16(pack8(o0, o1), pa); }
    }
};
struct EpiDown {
    static constexpr bool PERM = true;
    bf16_t* Y; const float* gatev;
    __device__ __forceinline__ void operator()(EPI_ARGS) const {
        const int lane = fq * 16 + fr, pa = coalesce_addr(lane), rl = lane >> 2, cl = lane & 3;
        const int rowsrc = u.pm * BM + wr * 64 + fr, rowdst = u.pm * BM + wr * 64 + rl, col0 = u.pn * BM + wc * 32 + 8 * cl;
#pragma unroll
        for (int ai = 0; ai < 2; ++ai)
#pragma unroll
            for (int m = 0; m < 4; ++m) { const float gsc = gatev[rowsrc + ai * HALF + m * 16]; bf16_t* rowp = Y + (size_t)(rowdst + ai * HALF + m * 16) * D + col0;
#pragma unroll
                for (int bj = 0; bj < 2; ++bj) *(u32x4*)(rowp + bj * HALF) = coalesce16(pack8(acc[ai][bj][m][0] * gsc, acc[ai][bj][m][1] * gsc), pa); }
    }
};
}


#define XB_TMO      128
#define XB_XCNT(j)  (256  + 64 * (j))
#define XB_XSUB(j)  (1280 + 64 * (j))
#define XB_XGEN(j)  (2304 + 64 * (j))
#define XB_TOP      3328
#define XB_TOPGEN   3392
#define XCD_BAR_WORDS 3456
#define XB_SPIN_CAP (1u << 20)
__device__ __forceinline__ unsigned xb_ld(unsigned* p)              { return __hip_atomic_load(p, __ATOMIC_RELAXED, __HIP_MEMORY_SCOPE_AGENT); }
__device__ __forceinline__ unsigned xb_add(unsigned* p, unsigned v) { return __hip_atomic_fetch_add(p, v, __ATOMIC_RELAXED, __HIP_MEMORY_SCOPE_AGENT); }
__device__ __forceinline__ unsigned xb_xcc_id() { return (unsigned)__builtin_amdgcn_s_getreg((3 << 11) | 20) & 0xFu; }
#define XB_SPIN(cond, bar) do { unsigned _sp = 0; while (cond) { __builtin_amdgcn_s_sleep(1); \
    if ((++_sp & 255u) == 0u) { if (xb_ld(&(bar)[XB_TMO])) break; if (_sp > XB_SPIN_CAP) { atomicAdd(&(bar)[XB_TMO], 1u); break; } } } } while (0)
struct XcdBarrier { unsigned* bar; unsigned x; volatile LAS unsigned* st; };
__device__ __forceinline__ XcdBarrier xcd_barrier_post(unsigned* bar, volatile LAS unsigned* st) {
    XcdBarrier b; b.bar = bar; b.x = xb_xcc_id(); b.st = st;
    if (threadIdx.x == 0) (void)xb_add(&bar[XB_XCNT(b.x)], 1u);
    return b;
}
__device__ __forceinline__ void xcd_barrier_complete(unsigned* bar, unsigned x, unsigned& nloc, unsigned& nx) {
    const unsigned G = gridDim.x * gridDim.y * gridDim.z;
    unsigned sum, cnt, mine, sp = 0u;
    for (;;) {
        sum = 0u; cnt = 0u; mine = 0u;
#pragma unroll
        for (unsigned j = 0; j < 16; ++j) { const unsigned c = xb_ld(&bar[XB_XCNT(j)]); sum += c; cnt += (c > 0u) ? 1u : 0u; mine = (j == x) ? c : mine; }
        if (sum == G) break;
        __builtin_amdgcn_s_sleep(1);
        if ((++sp & 255u) == 0u) { if (xb_ld(&bar[XB_TMO])) break; if (sp > XB_SPIN_CAP) { atomicAdd(&bar[XB_TMO], 1u); break; } }
    }
    nloc = mine > 0u ? mine : 1u; nx = cnt > 0u ? cnt : 1u;
}
__device__ __forceinline__ void xcd_barrier(const XcdBarrier& b) {
    asm volatile("s_waitcnt vmcnt(0)" ::: "memory");
    __syncthreads();
    if (threadIdx.x == 0) {
        unsigned* bar = b.bar;
        __builtin_amdgcn_s_waitcnt(0);
        unsigned nloc = b.st[0], nx = b.st[1];
        if (nloc == 0u) { xcd_barrier_complete(bar, b.x, nloc, nx); b.st[0] = nloc; b.st[1] = nx; }
        const unsigned old = xb_add(&bar[XB_XSUB(b.x)], 1u);
        const unsigned gen = old / nloc;
        if (old + 1u == (gen + 1u) * nloc) {
            __builtin_amdgcn_fence(__ATOMIC_RELEASE, "agent");
            asm volatile("s_waitcnt vmcnt(0)" ::: "memory");
            const unsigned og = xb_add(&bar[XB_TOP], 1u);
            const unsigned tg = og / nx;
            if (og + 1u == (tg + 1u) * nx) xb_add(&bar[XB_TOPGEN], 1u);
            else XB_SPIN(xb_ld(&bar[XB_TOPGEN]) == tg, bar);
            __builtin_amdgcn_fence(__ATOMIC_ACQUIRE, "agent");
            xb_add(&bar[XB_XGEN(b.x)], 1u);
            asm volatile("s_waitcnt vmcnt(0)" ::: "memory");
        } else {
            XB_SPIN(xb_ld(&bar[XB_XGEN(b.x)]) == gen, bar);
            __builtin_amdgcn_fence(__ATOMIC_ACQUIRE, "agent");
            asm volatile("s_waitcnt vmcnt(0)" ::: "memory");
        }
    }
    __syncthreads();
}

struct Args { const float* in[25]; float* out; unsigned char* ws; int ph_lo, ph_hi; };
enum { I_X = 0, I_C, I_CTX, I_CCTX, I_ADAW, I_ADAB, I_NMIX, I_NFFN, I_NFIN, I_LWIN, I_LCW, I_LCB, I_LGW, I_LGB, I_LLAM, I_LWOUT, I_MWIN, I_MQN, I_MKVN, I_MWUQ, I_MWUKV, I_MWO, I_ROUTER, I_WUP, I_WDN };

struct Frame {
    LAS unsigned char* lds;
    int tid, lane, wave, G, bid;
    const Args* a;
    unsigned char* ws;
};
#define WSP(T, off) ((T*)(F.ws + (off)))

struct TItem { const float* W; bf16_t* WT; const float* ks; int ldw, nvalid, K, k0, n0, drow0; float scale; };
__device__ __forceinline__ TItem titem_decode(const Args& A, unsigned char* ws, int it) {
    constexpr int J0 = 32 * 16 * 32, J1 = 32 * 16 * 16, J2 = 16 * 32, J3 = 16 * 16, J4 = 16 * 12, J5 = 6 * 24, J6 = 4 * 32, J7 = 16 * 16;
    TItem t; t.ks = nullptr; t.scale = 1.0f; int r = it;
    if (r < J0) { const int mat = r / 512, q = r % 512, kb = q / 32, nb = q % 32; const int n0 = nb * 64; const int j = n0 & 1023;
        t.W = A.in[I_WUP] + (size_t)mat * 1024 * 2048; t.ldw = 2048; t.nvalid = 2048; t.WT = (bf16_t*)(ws + WS_WUP) + (size_t)mat * 2048 * 1024; t.K = 1024; t.k0 = kb * 64; t.n0 = n0; t.drow0 = (j >> 7) * 256 + (n0 >= 1024 ? 128 : 0) + (j & 127); t.scale = n0 >= 1024 ? 0.6931471805599453f : 1.4426950408889634f; return t; } r -= J0;
    if (r < J1) { const int mat = r / 256, q = r % 256, kb = q / 16, nb = q % 16;
        t.W = A.in[I_WDN] + (size_t)mat * 1024 * 1024; t.ldw = 1024; t.nvalid = 1024; t.WT = (bf16_t*)(ws + WS_WDN) + (size_t)mat * 1024 * 1024; t.K = 1024; t.k0 = kb * 64; t.n0 = nb * 64; t.drow0 = nb * 64; return t; } r -= J1;
    if (r < J2) { const int kb = r / 32, nb = r % 32; t.W = A.in[I_LWIN]; t.ldw = 2048; t.nvalid = 2048; t.WT = (bf16_t*)(ws + WS_WLIN); t.K = 1024; t.k0 = kb * 64; t.n0 = nb * 64; t.drow0 = nb * 64; return t; } r -= J2;
    if (r < J3) { const int kb = r / 16, nb = r % 16; t.W = A.in[I_LWOUT]; t.ldw = 1024; t.nvalid = 1024; t.WT = (bf16_t*)(ws + WS_WLOUT); t.K = 1024; t.k0 = kb * 64; t.n0 = nb * 64; t.drow0 = nb * 64; return t; } r -= J3;
    if (r < J4) { const int kb = r / 12, nb = r % 12; t.W = A.in[I_MWIN]; t.ldw = 672; t.nvalid = 672; t.WT = (bf16_t*)(ws + WS_WMIN); t.K = 1024; t.k0 = kb * 64; t.n0 = nb * 64; t.drow0 = nb * 64; return t; } r -= J4;
    if (r < J5) { const int kb = r / 24, nb = r % 24; t.W = A.in[I_MWUQ]; t.ldw = 1536; t.nvalid = 1536; t.WT = (bf16_t*)(ws + WS_WUQ); t.K = 384; t.k0 = kb * 64; t.n0 = nb * 64; t.drow0 = nb * 64; t.ks = A.in[I_MQN]; return t; } r -= J5;
    if (r < J6) { const int kb = r / 32, nb = r % 32; t.W = A.in[I_MWUKV]; t.ldw = 2048; t.nvalid = 2048; t.WT = (bf16_t*)(ws + WS_WUKV); t.K = 256; t.k0 = kb * 64; t.n0 = nb * 64; t.drow0 = nb * 64; t.ks = A.in[I_MKVN]; return t; } r -= J6;
    if (r < J7) { const int kb = r / 16, nb = r % 16; t.W = A.in[I_MWO]; t.ldw = 1024; t.nvalid = 1024; t.WT = (bf16_t*)(ws + WS_WO); t.K = 1024; t.k0 = kb * 64; t.n0 = nb * 64; t.drow0 = nb * 64; return t; } r -= J7;
    { const int mat = r / 4, q = r % 4, kb = q / 2, nb = q % 2; const int d = mat >> 4, g = (mat >> 3) & 1, n = mat & 7;
        t.W = A.in[I_LGW] + (size_t)mat * 128 * 128; t.ldw = 128; t.nvalid = 128; t.WT = (bf16_t*)(ws + WS_WG) + (size_t)((d * 8 + n) * 2 + g) * 128 * 128; t.K = 128; t.k0 = kb * 64; t.n0 = nb * 64; t.drow0 = nb * 64; return t; }
}
__device__ __forceinline__ void titem_load(const TItem& t, f32x4 (&v)[16], int lane) {
    const int col = t.n0 + 4 * (lane & 15); const bool ok = col < t.nvalid; const float* p = t.W + (size_t)(t.k0 + (lane >> 4)) * t.ldw + col;
#pragma unroll
    for (int i = 0; i < 16; ++i) v[i] = ok ? *(const f32x4*)(p + (size_t)(4 * i) * t.ldw) : (f32x4){0.f, 0.f, 0.f, 0.f};
}
__device__ __forceinline__ void titem_process(const TItem& t, f32x4 (&v)[16], LAS float* scr, int lane) {
    const int rq = lane >> 4, c4 = 4 * (lane & 15);
#pragma unroll
    for (int i = 0; i < 16; ++i) { f32x4 x = v[i] * t.scale; if (t.ks) x = x * t.ks[t.k0 + 4 * i + rq]; LAS float* d = scr + (4 * i + rq) * 65 + c4; d[0] = x[0]; d[1] = x[1]; d[2] = x[2]; d[3] = x[3]; }
    asm volatile("s_waitcnt lgkmcnt(0)" ::: "memory");
    const int c = lane & 7;
#pragma unroll
    for (int j = 0; j < 8; ++j) { const int n = (lane >> 3) + 8 * j; const LAS float* s = scr + (8 * c) * 65 + n;
        u32x4 o; o.x = cvt_pk_bf16(s[0 * 65], s[1 * 65]); o.y = cvt_pk_bf16(s[2 * 65], s[3 * 65]); o.z = cvt_pk_bf16(s[4 * 65], s[5 * 65]); o.w = cvt_pk_bf16(s[6 * 65], s[7 * 65]);
        *(u32x4*)(t.WT + (size_t)(t.drow0 + n) * t.K + t.k0 + 8 * c) = o; }
    asm volatile("s_waitcnt lgkmcnt(0)" ::: "memory");
}

__device__ __forceinline__ void p0_prologue(Frame& F) {
    const Args& A = *F.a;
    {
        LAS float* sc = (LAS float*)F.lds;
        LAS float* red = (LAS float*)(F.lds + 17 * 1024 * 4);
        bool loaded = false;
        for (int task = F.bid; task < 192; task += F.G) {
            if (!loaded) {
                f32x4 cv[9];
#pragma unroll
                for (int qi = 0; qi < 9; ++qi) { const int g = F.tid + 512 * qi; cv[qi] = g < 4096 ? ((const f32x4*)A.in[I_C])[g] : (g < 4352 ? ((const f32x4*)A.in[I_CCTX])[g - 4096] : (f32x4){0.f, 0.f, 0.f, 0.f}); }
#pragma unroll
                for (int qi = 0; qi < 9; ++qi) { const int g = F.tid + 512 * qi; if (g < 4352) { f32x4 r;
#pragma unroll
                    for (int j = 0; j < 4; ++j) r[j] = cv[qi][j] / (1.0f + __expf(-cv[qi][j]));
                    *(LAS f32x4*)(sc + 4 * g) = r; } }
                loaded = true; __syncthreads(); }
            const int l = task / 96, n0 = (task % 96) * 64; const float* W = A.in[I_ADAW] + (size_t)l * D * 6144;
            float acc[17];
#pragma unroll
            for (int r = 0; r < 17; ++r) acc[r] = 0.f;
            const int k0 = F.wave * 128;
            for (int kb = 0; kb < 128; kb += 32) { float wv[32];
#pragma unroll
                for (int kk = 0; kk < 32; ++kk) wv[kk] = W[(size_t)(k0 + kb + kk) * 6144 + n0 + F.lane];
#pragma unroll
                for (int kk = 0; kk < 32; ++kk) {
#pragma unroll
                    for (int r = 0; r < 17; ++r) acc[r] += sc[r * 1024 + k0 + kb + kk] * wv[kk]; } }
#pragma unroll
            for (int r = 0; r < 17; ++r) red[(F.wave * 17 + r) * 64 + F.lane] = acc[r];
            __syncthreads();
            for (int o = F.tid; o < 17 * 64; o += 512) { const int r = o >> 6, ln = o & 63; float s = A.in[I_ADAB][l * 6144 + n0 + ln];
#pragma unroll
                for (int w = 0; w < 8; ++w) s += red[(w * 17 + r) * 64 + ln];
                WSP(float, WS_MOD)[(size_t)(l * 17 + r) * 6144 + n0 + ln] = s; }
            __syncthreads();
        }
        __syncthreads();
    }
    if (F.bid == F.G - 1) { for (int i = F.tid; i < 512; i += 512) { const int pos = i >> 3, f = i & 7; const float fr = powf(10000.0f, -(float)f / 8.0f); const float ang = (float)pos * fr;
            WSP(float, WS_ROPE)[2 * i] = cosf(ang); WSP(float, WS_ROPE)[2 * i + 1] = sinf(ang); } }
    for (int i = F.bid * 512 + F.tid; i < MT; i += F.G * 512) { WSP(float, WS_SSQ)[i] = 0.f; WSP(float, WS_SSKV)[i] = 0.f; }
#ifdef DUP_P0B
    for (int rep_ = 0; rep_ < 2; ++rep_) {
#else
    {
#endif
    LAS float* scr = (LAS float*)(F.lds + F.wave * 16640);
    const int gw = F.bid * NWAVES + F.wave, NGW = F.G * NWAVES;
    constexpr int NITEMS = 32 * 16 * 32 + 32 * 16 * 16 + 16 * 32 + 16 * 16 + 16 * 12 + 6 * 24 + 4 * 32 + 16 * 16 + 32 * 4;
    if (gw < NITEMS) {
        f32x4 va[16], vb[16];
        TItem ta = titem_decode(A, F.ws, gw); titem_load(ta, va, F.lane);
        for (int it = gw; it < NITEMS; it += 2 * NGW) {
            const bool hb = it + NGW < NITEMS; TItem tb = ta;
            if (hb) { tb = titem_decode(A, F.ws, it + NGW); titem_load(tb, vb, F.lane); }
            titem_process(ta, va, scr, F.lane);
            if (!hb) break;
            const bool ha = it + 2 * NGW < NITEMS;
            if (ha) { ta = titem_decode(A, F.ws, it + 2 * NGW); titem_load(ta, va, F.lane); }
            titem_process(tb, vb, scr, F.lane);
            if (!ha) break;
        }
    }
    }
}

__device__ __forceinline__ void row_load(const float* xrow, int lane, f32x4 (&v)[4]) {
    const f32x4* xr = (const f32x4*)xrow + lane;
#pragma unroll
    for (int j = 0; j < 4; ++j) v[j] = xr[64 * j];
}
__device__ __forceinline__ void row_load_bf16(const bf16_t* xrow, int lane, f32x4 (&v)[4]) {
    const u32x2* xr = (const u32x2*)xrow + lane;
#pragma unroll
    for (int j = 0; j < 4; ++j) { const u32x2 w = xr[64 * j]; v[j] = (f32x4){__uint_as_float(w.x << 16), __uint_as_float(w.x & 0xffff0000u), __uint_as_float(w.y << 16), __uint_as_float(w.y & 0xffff0000u)}; }
}
__device__ __forceinline__ float row_rs(const f32x4 (&v)[4]) {
    float s = 0.f;
#pragma unroll
    for (int j = 0; j < 4; ++j) s += (v[j][0] * v[j][0] + v[j][1] * v[j][1]) + (v[j][2] * v[j][2] + v[j][3] * v[j][3]);
    return rsqrtf(wave_sum(s) * (1.0f / D) + EPS);
}
__device__ __forceinline__ void row_modulate(f32x4 (&v)[4], float rs, const float* gamma, const float* shift, const float* scale, int lane) {
#pragma unroll
    for (int j = 0; j < 4; ++j) { const f32x4 g = ((const f32x4*)gamma)[lane + 64 * j], sh = ((const f32x4*)shift)[lane + 64 * j], sc = ((const f32x4*)scale)[lane + 64 * j];
        v[j] = v[j] * rs * g * (sc + 1.0f) + sh; }
}
__device__ __forceinline__ void row_store_bf16(const f32x4 (&v)[4], bf16_t* orow, int lane) {
    u32x2* o8 = (u32x2*)orow + lane;
#pragma unroll
    for (int j = 0; j < 4; ++j) { u32x2 w; w.x = cvt_pk_bf16(v[j][0], v[j][1]); w.y = cvt_pk_bf16(v[j][2], v[j][3]); o8[64 * j] = w; }
}
__device__ __forceinline__ int row_bidx(int row) { return row < MLAT ? row / TL : 16; }

__device__ __forceinline__ void p_norm_in(Frame& F) {
    const Args& A = *F.a; const int gw = F.bid * NWAVES + F.wave, NGW = F.G * NWAVES;
    const float* mod = WSP(float, WS_MOD);
    for (int row = gw; row < MT; row += NGW) {
        const float* src = row < MLAT ? A.in[I_X] + (size_t)row * D : A.in[I_CTX] + (size_t)(row - MLAT) * D;
        f32x4 v[4]; row_load(src, F.lane, v); const float rs = row_rs(v);
        const float* m = mod + (size_t)row_bidx(row) * 6144;
        row_modulate(v, rs, A.in[I_NMIX], m, m + D, F.lane);
        row_store_bf16(v, WSP(bf16_t, WS_H) + (size_t)row * D, F.lane);
    }
}

__device__ __forceinline__ void p_moe_norm(Frame& F, int layer, int nrows) {
    const Args& A = *F.a; const int gw = F.bid * NWAVES + F.wave, NGW = F.G * NWAVES;
    LAS float* Rl = (LAS float*)F.lds;
    const float* router = A.in[I_ROUTER] + (size_t)layer * D * NE;
    int tid_ = F.tid; asm volatile("" : "+v"(tid_));
    { f32x4 rv[8];
#pragma unroll
      for (int q = 0; q < 8; ++q) rv[q] = ((const f32x4*)router)[tid_ + q * 512];
#pragma unroll
      for (int q = 0; q < 8; ++q) { const int g = tid_ + q * 512, k = g >> 2, c = g & 3; const int j = k >> 8, l = (k & 255) >> 2, i = k & 3;
          *(LAS f32x4*)(Rl + (((j * 4 + i) * 4 + c) * 64 + l) * 4) = rv[q]; } }
    __syncthreads();
    const float* mod = WSP(float, WS_MOD) + (size_t)layer * 17 * 6144;
    const float* gamma = A.in[I_NFFN] + layer * D;
    const bf16_t* X = WSP(bf16_t, WS_X);
    for (int rg = gw; rg < nrows / 2; rg += NGW) {
        float y[2][16];
#pragma unroll
        for (int r = 0; r < 2; ++r) { const int row = rg * 2 + r;
            f32x4 v[4]; row_load_bf16(X + (size_t)row * D, F.lane, v); const float rs = row_rs(v);
            const float* m = mod + (size_t)row_bidx(row) * 6144;
            row_modulate(v, rs, gamma, m + 3 * D, m + 4 * D, F.lane);
            row_store_bf16(v, WSP(bf16_t, WS_H) + (size_t)row * D, F.lane);
#pragma unroll
            for (int j = 0; j < 4; ++j)
#pragma unroll
                for (int i = 0; i < 4; ++i) y[r][j * 4 + i] = v[j][i];
            asm volatile("" ::: "memory"); }
        float acc[32];
#pragma unroll
        for (int q = 0; q < 32; ++q) acc[q] = 0.f;
#pragma unroll
        for (int ji = 0; ji < 16; ++ji)
#pragma unroll
            for (int c = 0; c < 4; ++c) { const f32x4 w = *(const LAS f32x4*)(Rl + ((ji * 4 + c) * 64 + F.lane) * 4);
#pragma unroll
                for (int r = 0; r < 2; ++r)
#pragma unroll
                    for (int q = 0; q < 4; ++q) acc[r * 16 + c * 4 + q] += y[r][ji] * w[q]; }
#pragma unroll
        for (int s = 0; s < 5; ++s) { const int half = 16 >> s; const bool up = (F.lane >> (4 - s)) & 1;
#pragma unroll
            for (int i = 0; i < half; ++i) { const float mine = up ? acc[i + half] : acc[i]; const float other = up ? acc[i] : acc[i + half];
                acc[i] = mine + __shfl_xor(other, half); } }
        float lg = acc[0] + __shfl_xor(acc[0], 32);
        float mx = lg;
#pragma unroll
        for (int o = 1; o < 16; o <<= 1) mx = fmaxf(mx, __shfl_xor(mx, o));
        const float ex = __expf(lg - mx); float sm = ex;
#pragma unroll
        for (int o = 1; o < 16; o <<= 1) sm += __shfl_xor(sm, o);
        const float aff = ex / sm;
        const int row = rg * 2 + ((F.lane >> 4) & 1), e = F.lane & 15;
        if (F.lane < 32) {
            if (row < MLAT) { const int b = row / TL, t = row - b * TL; WSP(float, WS_AFFL)[(size_t)(b * NE + e) * TL + t] = aff; }
            else { const int b = (row - MLAT) / TCX, t = (row - MLAT) - b * TCX; WSP(float, WS_AFFC)[(size_t)(b * NE + e) * TCX + t] = aff; } }
    }
}

template <int NPL, int CAP>
__device__ __forceinline__ void topk_unit(Frame& F, const float* aff  , int tokrow0, int moerow0, int e) {
    unsigned v[NPL];
    const unsigned* p = (const unsigned*)aff + F.lane * NPL;
#pragma unroll
    for (int i = 0; i < NPL; i += 4) { const u32x4 q = *(const u32x4*)(p + i); v[i] = q.x; v[i + 1] = q.y; v[i + 2] = q.z; v[i + 3] = q.w; }
    unsigned prefix = 0u;
    for (int bit = 30; bit >= 0; --bit) { const unsigned cand = prefix | (1u << bit); int cnt = 0;
#pragma unroll
        for (int i = 0; i < NPL; ++i) cnt += (v[i] >= cand) ? 1 : 0;
        cnt = wave_isum(cnt); if (cnt >= CAP) prefix = cand; }
    int cg_ = 0, ce = 0;
#pragma unroll
    for (int i = 0; i < NPL; ++i) { cg_ += (v[i] > prefix) ? 1 : 0; ce += (v[i] == prefix) ? 1 : 0; }
    const int need = CAP - wave_isum(cg_);
    int eq_before = ce;
#pragma unroll
    for (int o = 1; o < 64; o <<= 1) { const int x = __shfl_up(eq_before, o); if (F.lane >= o) eq_before += x; }
    eq_before -= ce;
    int nsel = 0, eqi = eq_before; unsigned long long selmask = 0ull;
#pragma unroll
    for (int i = 0; i < NPL; ++i) { bool s = v[i] > prefix; if (v[i] == prefix) { s = eqi < need; ++eqi; } if (s) { selmask |= (1ull << i); ++nsel; } }
    int slot = nsel;
#pragma unroll
    for (int o = 1; o < 64; o <<= 1) { const int x = __shfl_up(slot, o); if (F.lane >= o) slot += x; }
    slot -= nsel;
    int* rowidx = WSP(int, WS_ROWIDX); float* gatev = WSP(float, WS_GATEV); int* sel = WSP(int, WS_SEL);
#pragma unroll
    for (int i = 0; i < NPL; ++i) { const int trow = tokrow0 + F.lane * NPL + i; const bool s = (selmask >> i) & 1ull;
        if (s) { const int mr = moerow0 + slot; rowidx[mr] = trow; gatev[mr] = __uint_as_float(v[i]); sel[(size_t)trow * NE + e] = mr; ++slot; }
        else sel[(size_t)trow * NE + e] = -1; }
}
__device__ __forceinline__ void p_topk(Frame& F, bool with_ctx) {
    const int gw = F.bid * NWAVES + F.wave, NGW = F.G * NWAVES;
    const int nunits = with_ctx ? 512 : 256;
    for (int u = gw; u < nunits; u += NGW) {
        if (u < 256) { const int b = u >> 4, e = u & 15; topk_unit<32, CAPL>(F, WSP(float, WS_AFFL) + (size_t)(b * NE + e) * TL, b * TL, (e * NB + b) * CAPL, e); }
        else { const int uu = u - 256, b = uu >> 4, e = uu & 15; topk_unit<4, CAPC>(F, WSP(float, WS_AFFC) + (size_t)(b * NE + e) * TCX, MLAT + b * TCX, MOE_LAT_ROWS + (e * NB + b) * CAPC, e); }
    }
}

__device__ __forceinline__ void p_combine(Frame& F, int layer, bool final_) {
    const Args& A = *F.a; const int gw = F.bid * NWAVES + F.wave, NGW = F.G * NWAVES;
    const int nrows = final_ ? MLAT : MT;
    const float* mod = WSP(float, WS_MOD);
    const int* sel = WSP(int, WS_SEL); const bf16_t* Y = WSP(bf16_t, WS_Y); bf16_t* X = WSP(bf16_t, WS_X);
    u32x2 xw[2][4]; int myr[2] = {-1, -1};
#pragma unroll
    for (int p = 0; p < 2; ++p)
#pragma unroll
        for (int j = 0; j < 4; ++j) xw[p][j] = (u32x2){0u, 0u};
#define CMB_PRE(r0_) do { _Pragma("unroll") for (int p = 0; p < 2; ++p) { const int r_ = (r0_) + p * NGW; if (r_ < nrows) { const u32x2* xr = (const u32x2*)(X + (size_t)r_ * D) + F.lane; \
        _Pragma("unroll") for (int j = 0; j < 4; ++j) xw[p][j] = xr[64 * j]; myr[p] = sel[(size_t)r_ * NE + (F.lane & 15)]; } else myr[p] = -1; } } while (0)
    CMB_PRE(gw);
    for (int row = gw; row < nrows; row += 2 * NGW) {
        f32x4 v[2][4], s[2][4]; int myc[2]; unsigned long long mask[2];
#pragma unroll
        for (int p = 0; p < 2; ++p) { myc[p] = myr[p];
#pragma unroll
            for (int j = 0; j < 4; ++j) { v[p][j] = (f32x4){__uint_as_float(xw[p][j].x << 16), __uint_as_float(xw[p][j].x & 0xffff0000u), __uint_as_float(xw[p][j].y << 16), __uint_as_float(xw[p][j].y & 0xffff0000u)};
                s[p][j] = (f32x4){0.f, 0.f, 0.f, 0.f}; } }
        CMB_PRE(row + 2 * NGW);
#pragma unroll
        for (int p = 0; p < 2; ++p) mask[p] = __ballot(myc[p] >= 0) & 0xffffull;
        while (mask[0] | mask[1]) {
            int mr[2][4]; u32x2 w[2][4][4];
#pragma unroll
            for (int p = 0; p < 2; ++p)
#pragma unroll
                for (int q = 0; q < 4; ++q) { if (mask[p]) { const int e = __builtin_ctzll(mask[p]); mask[p] &= mask[p] - 1; mr[p][q] = __builtin_amdgcn_readlane(myc[p], e); } else mr[p][q] = -1; }
#pragma unroll
            for (int p = 0; p < 2; ++p)
#pragma unroll
                for (int q = 0; q < 4; ++q) { if (mr[p][q] >= 0) { const u32x2* yr = (const u32x2*)(Y + (size_t)mr[p][q] * D) + F.lane;
#pragma unroll
                    for (int j = 0; j < 4; ++j) w[p][q][j] = yr[64 * j]; } else {
#pragma unroll
                    for (int j = 0; j < 4; ++j) w[p][q][j] = (u32x2){0u, 0u}; } }
#pragma unroll
            for (int p = 0; p < 2; ++p)
#pragma unroll
                for (int q = 0; q < 4; ++q)
#pragma unroll
                    for (int j = 0; j < 4; ++j) { s[p][j][0] += __uint_as_float(w[p][q][j].x << 16); s[p][j][1] += __uint_as_float(w[p][q][j].x & 0xffff0000u);
                        s[p][j][2] += __uint_as_float(w[p][q][j].y << 16); s[p][j][3] += __uint_as_float(w[p][q][j].y & 0xffff0000u); }
        }
#pragma unroll
        for (int p = 0; p < 2; ++p) { const int r = row + p * NGW;
            if (r < nrows) {
                const float* m0 = mod + (size_t)(layer * 17 + row_bidx(r)) * 6144;
#pragma unroll
                for (int j = 0; j < 4; ++j) { const f32x4 g2 = ((const f32x4*)(m0 + 5 * D))[F.lane + 64 * j]; v[p][j] = v[p][j] + g2 * s[p][j]; }
                if (!final_) {
                    row_store_bf16(v[p], X + (size_t)r * D, F.lane);
                    const float rs = row_rs(v[p]); const float* m1 = mod + (size_t)(17 + row_bidx(r)) * 6144;
                    row_modulate(v[p], rs, A.in[I_NMIX] + D, m1, m1 + D, F.lane);
                    row_store_bf16(v[p], WSP(bf16_t, WS_H) + (size_t)r * D, F.lane);
                } else {
                    const float rs = row_rs(v[p]); f32x4* o = (f32x4*)(A.out + (size_t)r * D) + F.lane;
#pragma unroll
                    for (int j = 0; j < 4; ++j) { const f32x4 g = ((const f32x4*)A.in[I_NFIN])[F.lane + 64 * j]; o[64 * j] = v[p][j] * rs * g; }
                } } }
    }
#undef CMB_PRE
}

__device__ __forceinline__ void p_scan(Frame& F) {
    const Args& A = *F.a;
    const int tid = F.tid, dir = tid >> 8, lt = tid & 255, wv = (tid >> 6) & 3, lane = F.lane, cl = lane & 15, q = lane >> 4;
    constexpr int RS = 68;
    LAS unsigned char* base = F.lds + dir * 51200;
    LAS unsigned char* At = base;
    LAS float* UX = (LAS float*)(base + 16384);
    LAS float* AY = (LAS float*)(base + 16384 + 17408);
    LAS float* CW = (LAS float*)(F.lds + 102400);
    const bf16_t* ZX = WSP(bf16_t, WS_ZX); const bf16_t* Gb = WSP(bf16_t, WS_G); bf16_t* YG = WSP(bf16_t, WS_YG);
    constexpr float L2E = 1.4426950408889634f;
    for (int u = F.bid; u < 256; u += F.G) {
        const int b = u >> 4, n = (u & 15) >> 1, half = u & 1; const int cb = n * 128 + half * 64;
        __syncthreads();
        for (int i = tid; i < 640; i += 512) CW[i] = i < 512 ? A.in[I_LCW][(i >> 7) * D + n * 128 + (i & 127)] : A.in[I_LCB][n * 128 + (i - 512)];
        bf16x8 bw[2][4];
        { const bf16_t* wg = WSP(bf16_t, WS_WG) + (size_t)((dir * 8 + n) * 2) * 128 * 128;
#pragma unroll
          for (int g = 0; g < 2; ++g)
#pragma unroll
            for (int ks = 0; ks < 4; ++ks) bw[g][ks] = *(const bf16x8*)(wg + (size_t)g * 128 * 128 + (half * 64 + 16 * wv + cl) * 128 + ks * 32 + q * 8); }
        const int chl = 16 * wv + cl;
        const float bias0 = A.in[I_LGB][(dir * 2 + 0) * D + cb + chl] * (-L2E), bias1 = A.in[I_LGB][(dir * 2 + 1) * D + cb + chl] * (-L2E);
        float sp8l; { const float lam = A.in[I_LLAM][dir * D + cb + chl]; sp8l = 8.0f * log1pf(__expf(-lam)) * L2E; }
        float hcar = 0.f;
        __syncthreads();
        const int o = lt & 15, tq = lt >> 4;
        float w[4][8], bsv[8];
#pragma unroll
        for (int k = 0; k < 4; ++k) { const f32x4 w0 = *(const LAS f32x4*)(CW + k * 128 + 8 * o), w1 = *(const LAS f32x4*)(CW + k * 128 + 8 * o + 4);
#pragma unroll
            for (int j = 0; j < 4; ++j) { w[k][j] = w0[j]; w[k][4 + j] = w1[j]; } }
        { const f32x4 b0 = *(const LAS f32x4*)(CW + 512 + 8 * o), b1 = *(const LAS f32x4*)(CW + 512 + 8 * o + 4);
#pragma unroll
          for (int j = 0; j < 4; ++j) { bsv[j] = b0[j]; bsv[4 + j] = b1[j]; } }
        const int sh16 = (q >= 1 ? lane - 16 : lane) << 2, sh32 = (q >= 2 ? lane - 32 : lane) << 2, shtot = (cl + 48) << 2;
        u32x4 z[7];
#define SCAN_GEOM(it_, c_, t0_, L_, rowbase_, first_) const bool isctx_##it_ = (it_) < 4; const int ci_##it_ = isctx_##it_ ? (it_) : (it_) - 4, nch_##it_ = isctx_##it_ ? 4 : 32; \
        const int c_ = dir == 0 ? ci_##it_ : nch_##it_ - 1 - ci_##it_; const int t0_ = c_ * 64, L_ = isctx_##it_ ? TCX : TL; const int rowbase_ = isctx_##it_ ? MLAT + b * TCX : b * TL; \
        const bool first_ = dir == 0 ? (c_ < nch_##it_ / 2) : (c_ >= nch_##it_ / 2);
#define SCAN_ZLOAD(t0_, L_, rowbase_) do { _Pragma("unroll") for (int r = 0; r < 7; ++r) { const int t = (t0_) + 4 * tq - 2 + r; \
        z[r] = (t >= 0 && t < (L_)) ? *(const u32x4*)(ZX + (size_t)((rowbase_) + t) * D + n * 128 + 8 * o) : (u32x4){0u, 0u, 0u, 0u}; } } while (0)
        { SCAN_GEOM(0, c0, t00, L0, rb0, f0) (void)f0; SCAN_ZLOAD(t00, L0, rb0); }
        for (int it = 0; it < 36; ++it) {
            SCAN_GEOM(it, c, t0, L, rowbase, first)
            {
#pragma unroll
              for (int tt = 0; tt < 4; ++tt) { float xc[8];
#pragma unroll
                  for (int j = 0; j < 8; ++j) xc[j] = bsv[j];
#pragma unroll
                  for (int k = 0; k < 4; ++k) { const u32x4 zz = z[tt + k]; const unsigned zw[4] = {zz.x, zz.y, zz.z, zz.w};
#pragma unroll
                      for (int j = 0; j < 4; ++j) { xc[2 * j] += w[k][2 * j] * __uint_as_float(zw[j] << 16); xc[2 * j + 1] += w[k][2 * j + 1] * __uint_as_float(zw[j] & 0xffff0000u); } }
                  const int tl = 4 * tq + tt, rr = dir == 0 ? tl : 63 - tl;
                  u32x4 pk; pk.x = cvt_pk_bf16(xc[0], xc[1]); pk.y = cvt_pk_bf16(xc[2], xc[3]); pk.z = cvt_pk_bf16(xc[4], xc[5]); pk.w = cvt_pk_bf16(xc[6], xc[7]);
                  *(LAS u32x4*)(At + rr * 256 + ((16 * o) ^ ((rr & 7) << 4))) = pk;
                  if ((o >> 3) == half) { LAS f32x4* ux = (LAS f32x4*)(UX + rr * RS + 8 * (o & 7)); ux[0] = (f32x4){xc[0], xc[1], xc[2], xc[3]}; ux[1] = (f32x4){xc[4], xc[5], xc[6], xc[7]}; } } }
            if (it + 1 < 36) { const int itn = it + 1; SCAN_GEOM(itn, cn, t0n, Ln, rbn, fn) (void)fn; (void)cn; SCAN_ZLOAD(t0n, Ln, rbn); }
            __syncthreads();
            u32x4 ps[2]; u32x4 pg[2];
#pragma unroll
            for (int qq = 0; qq < 2; ++qq) { const int item = lt + 256 * qq, tl = item >> 3, oc = item & 7; const size_t off = (size_t)(rowbase + t0 + tl) * D + cb + 8 * oc;
                if (!first) { ps[qq] = *(const u32x4*)(YG + off); pg[qq] = *(const u32x4*)(Gb + off); }
                else { ps[qq] = (u32x4){0u, 0u, 0u, 0u}; pg[qq] = ps[qq]; } }
            { f32x4 ga[2][4];
#pragma unroll
              for (int g = 0; g < 2; ++g)
#pragma unroll
                for (int mf = 0; mf < 4; ++mf) ga[g][mf] = (f32x4){0.f, 0.f, 0.f, 0.f};
#pragma unroll
              for (int mf = 0; mf < 4; ++mf)
#pragma unroll
                for (int ks = 0; ks < 4; ++ks) { const int row = 16 * mf + cl; const int colb = ks * 64 + q * 16;
                    const bf16x8 af = *(const LAS bf16x8*)(At + row * 256 + (colb ^ ((row & 7) << 4)));
                    ga[0][mf] = __builtin_amdgcn_mfma_f32_16x16x32_bf16(af, bw[0][ks], ga[0][mf], 0, 0, 0);
                    ga[1][mf] = __builtin_amdgcn_mfma_f32_16x16x32_bf16(af, bw[1][ks], ga[1][mf], 0, 0, 0); }
#pragma unroll
              for (int mf = 0; mf < 4; ++mf) {
#pragma unroll
                for (int rg = 0; rg < 4; ++rg) { const int row = 16 * mf + 4 * q + rg;
                    const float r = __builtin_amdgcn_rcpf(1.0f + __builtin_amdgcn_exp2f(ga[0][mf][rg] * (-L2E) + bias0)), ig = __builtin_amdgcn_rcpf(1.0f + __builtin_amdgcn_exp2f(ga[1][mf][rg] * (-L2E) + bias1));
                    const float av = __builtin_amdgcn_exp2f(-sp8l * r); const float mlt = __builtin_amdgcn_sqrtf(1.0f - av * av);
                    ga[0][mf][rg] = av; ga[1][mf][rg] = mlt * ig * UX[row * RS + chl]; }
#pragma unroll
                for (int rg = 1; rg < 4; ++rg) { ga[1][mf][rg] = ga[0][mf][rg] * ga[1][mf][rg - 1] + ga[1][mf][rg]; ga[0][mf][rg] = ga[0][mf][rg - 1] * ga[0][mf][rg]; } }
              float s = hcar;
#pragma unroll
              for (int mf = 0; mf < 4; ++mf) { float Ai = ga[0][mf][3], Hi = ga[1][mf][3];
#define BPERM(a_, v_) __int_as_float(__builtin_amdgcn_ds_bpermute((a_), __float_as_int(v_)))
                  { const float Ap = BPERM(sh16, Ai), Hp = BPERM(sh16, Hi); if (q >= 1) { Hi = Ai * Hp + Hi; Ai = Ai * Ap; } }
                  { const float Ap = BPERM(sh32, Ai), Hp = BPERM(sh32, Hi); if (q >= 2) { Hi = Ai * Hp + Hi; Ai = Ai * Ap; } }
                  const float ea = BPERM(sh16, Ai), eh = BPERM(sh16, Hi); const float Aex = q >= 1 ? ea : 1.0f, Hex = q >= 1 ? eh : 0.0f;
                  const float Ab = BPERM(shtot, Ai), Hb = BPERM(shtot, Hi);
#undef BPERM
                  const float hin = Aex * s + Hex;
#pragma unroll
                  for (int rg = 0; rg < 4; ++rg) AY[(16 * mf + 4 * q + rg) * RS + chl] = ga[0][mf][rg] * hin + ga[1][mf][rg];
                  s = Ab * s + Hb; }
              hcar = s; }
            __syncthreads();
#pragma unroll
            for (int qq = 0; qq < 2; ++qq) { const int item = lt + 256 * qq, tl = item >> 3, oc = item & 7, rr = dir == 0 ? tl : 63 - tl; const size_t off = (size_t)(rowbase + t0 + tl) * D + cb + 8 * oc;
                const f32x4 y0 = *(const LAS f32x4*)(AY + rr * RS + 8 * oc), y1 = *(const LAS f32x4*)(AY + rr * RS + 8 * oc + 4);
                if (first) { *(u32x4*)(YG + off) = pg8::pack8(y0, y1); }
                else { const u32x4 pw = ps[qq]; const u32x4 gg = pg[qq];
                    const f32x4 p0 = {__uint_as_float(pw.x << 16), __uint_as_float(pw.x & 0xffff0000u), __uint_as_float(pw.y << 16), __uint_as_float(pw.y & 0xffff0000u)};
                    const f32x4 p1 = {__uint_as_float(pw.z << 16), __uint_as_float(pw.z & 0xffff0000u), __uint_as_float(pw.w << 16), __uint_as_float(pw.w & 0xffff0000u)};
                    f32x4 o0, o1; o0[0] = (p0[0] + y0[0]) * __uint_as_float(gg.x << 16); o0[1] = (p0[1] + y0[1]) * __uint_as_float(gg.x & 0xffff0000u); o0[2] = (p0[2] + y0[2]) * __uint_as_float(gg.y << 16); o0[3] = (p0[3] + y0[3]) * __uint_as_float(gg.y & 0xffff0000u);
                    o1[0] = (p1[0] + y1[0]) * __uint_as_float(gg.z << 16); o1[1] = (p1[1] + y1[1]) * __uint_as_float(gg.z & 0xffff0000u); o1[2] = (p1[2] + y1[2]) * __uint_as_float(gg.w << 16); o1[3] = (p1[3] + y1[3]) * __uint_as_float(gg.w & 0xffff0000u);
                    *(u32x4*)(YG + off) = pg8::pack8(o0, o1); } }
        }
#undef SCAN_GEOM
#undef SCAN_ZLOAD
    }
    __syncthreads();
}

__device__ __forceinline__ void p_krope(Frame& F) {
    const bf16_t* Z = WSP(bf16_t, WS_Z); bf16_t* Kc = WSP(bf16_t, WS_K); const float* rope = WSP(float, WS_ROPE);
    for (int it = F.bid * 512 + F.tid; it < MT * NH; it += F.G * 512) {
        const int row = it >> 4, h = it & 15; const bool isl = row < MLAT;
        const int b = isl ? row / TL : (row - MLAT) / TCX; const int t = isl ? row - b * TL : (row - MLAT) - b * TCX; const int key = isl ? t : TL + t;
        const u32x4* zp = (const u32x4*)(Z + (size_t)row * ZW + 640);
        float x[32];
#pragma unroll
        for (int q = 0; q < 4; ++q) { const u32x4 w = zp[q]; const unsigned ww[4] = {w.x, w.y, w.z, w.w};
#pragma unroll
            for (int i = 0; i < 4; ++i) { x[8 * q + 2 * i] = __uint_as_float(ww[i] << 16); x[8 * q + 2 * i + 1] = __uint_as_float(ww[i] & 0xffff0000u); } }
        if (isl) {
#pragma unroll
            for (int ax = 0; ax < 2; ++ax) { const int pos = ax == 0 ? (t >> 6) : (t & 63);
#pragma unroll
                for (int f = 0; f < 8; ++f) { const float cs = rope[(pos * 8 + f) * 2], sn = rope[(pos * 8 + f) * 2 + 1]; const float x1 = x[ax * 16 + f], x2 = x[ax * 16 + 8 + f];
                    x[ax * 16 + f] = x1 * cs - x2 * sn; x[ax * 16 + 8 + f] = x1 * sn + x2 * cs; } } }
        u32x4* kp = (u32x4*)(Kc + ((size_t)(b * NH + h) * SKV + key) * DQK + 64);
#pragma unroll
        for (int q = 0; q < 4; ++q) { u32x4 w; w.x = cvt_pk_bf16(x[8 * q], x[8 * q + 1]); w.y = cvt_pk_bf16(x[8 * q + 2], x[8 * q + 3]); w.z = cvt_pk_bf16(x[8 * q + 4], x[8 * q + 5]); w.w = cvt_pk_bf16(x[8 * q + 6], x[8 * q + 7]); kp[q] = w; }
    }
}

namespace att {
constexpr int KVBLK = 64, QBLK = 32;
constexpr int SHM_K = KVBLK * 256, SHM_V = KVBLK * DV * 2;
constexpr float THRL = 8.0f;
#define KSWZ(row, colB) ((row) * 256 + ((colB) ^ (((row) & 7) << 4)))
#define SBAR() __builtin_amdgcn_sched_barrier(0)
__device__ __forceinline__ int crow(int r, int hi) { return (r & 3) + 8 * (r >> 2) + 4 * hi; }
__device__ __forceinline__ void partialSM(f32x16& p0, f32x16& p1, float& m_ref, unsigned& q6x, float& alpha, bool first, int hi) {
    float pmax = p0[0];
#pragma unroll
    for (int r = 1; r < 16; ++r) pmax = fmaxf(pmax, p0[r]);
#pragma unroll
    for (int r = 0; r < 16; ++r) pmax = fmaxf(pmax, p1[r]);
    { auto rr = __builtin_amdgcn_permlane32_swap(__float_as_uint(pmax), __float_as_uint(pmax), false, false); pmax = fmaxf(__uint_as_float(rr[0]), __uint_as_float(rr[1])); }
    if (__builtin_expect(!first && __all(pmax <= THRL), 1)) { alpha = 1.f; }
    else { const float dl = first ? pmax : fmaxf(pmax, 0.f);
        const float mnew = __uint_as_float(cvt_pk_bf16(m_ref + dl, 0.f) << 16);
        const float delta = mnew - m_ref;
#pragma unroll
        for (int r = 0; r < 16; ++r) { p0[r] -= delta; p1[r] -= delta; }
        alpha = first ? 1.f : __builtin_amdgcn_exp2f(-delta); m_ref = mnew;
        q6x = hi == 0 ? ((__float_as_uint(-mnew) >> 16) & 0xffffu) : 0u; }
#pragma unroll
    for (int r = 0; r < 16; ++r) p0[r] = __builtin_amdgcn_exp2f(p0[r]);
}
__device__ __forceinline__ void finishSM(f32x16& p0, f32x16& p1, bf16x8& pa0, bf16x8& pa1, bf16x8& pa2, bf16x8& pa3) {
#pragma unroll
    for (int r = 0; r < 16; ++r) p1[r] = __builtin_amdgcn_exp2f(p1[r]);
#define PK4(P, BASE, OUT) do { unsigned a0 = cvt_pk_bf16(P[BASE + 0], P[BASE + 1]), a1 = cvt_pk_bf16(P[BASE + 2], P[BASE + 3]);   \
    unsigned b0 = cvt_pk_bf16(P[BASE + 4], P[BASE + 5]), b1 = cvt_pk_bf16(P[BASE + 6], P[BASE + 7]);                              \
    auto r0 = __builtin_amdgcn_permlane32_swap(a0, b0, false, false); auto r1 = __builtin_amdgcn_permlane32_swap(a1, b1, false, false); \
    u32x4 w = {r0[0], r1[0], r0[1], r1[1]}; OUT = *reinterpret_cast<bf16x8*>(&w); } while (0)
    PK4(p0, 0, pa0); PK4(p0, 8, pa1); PK4(p1, 0, pa2); PK4(p1, 8, pa3);
#undef PK4
}
__device__ __forceinline__ void qkt(f32x16& p0, f32x16& p1, const char* Ks, const bf16x8* qr, unsigned q6x, int r32, int hi) {
    p0 = f32x16{}; p1 = f32x16{};
#pragma unroll
    for (int d0 = 0; d0 < 6; ++d0) { const int cb = (d0 * 16 + hi * 8) * 2;
        const bf16x8 b0 = *reinterpret_cast<const bf16x8*>(Ks + KSWZ(r32, cb));
        const bf16x8 b1 = *reinterpret_cast<const bf16x8*>(Ks + KSWZ(32 + r32, cb));
        p0 = __builtin_amdgcn_mfma_f32_32x32x16_bf16(b0, qr[d0], p0, 0, 0, 0);
        p1 = __builtin_amdgcn_mfma_f32_32x32x16_bf16(b1, qr[d0], p1, 0, 0, 0); }
    { const u32x4 kw = {hi == 0 ? 0x00003F80u : 0u, 0u, 0u, 0u}, qw = {q6x, 0u, 0u, 0u};
      const bf16x8 k6 = *reinterpret_cast<const bf16x8*>(&kw), q6 = *reinterpret_cast<const bf16x8*>(&qw);
      p0 = __builtin_amdgcn_mfma_f32_32x32x16_bf16(k6, q6, p0, 0, 0, 0);
      p1 = __builtin_amdgcn_mfma_f32_32x32x16_bf16(k6, q6, p1, 0, 0, 0); }
}
__device__ __forceinline__ int v_st(int k, int c) { const int kk = (k & ~0xC) | ((k & 4) << 1) | ((k & 8) >> 1); return ((kk >> 3) * 2 + (c >> 5)) * 512 + ((kk & 7) * 32 + (c & 31)) * 2; }
__device__ __forceinline__ int v_rd_base(int lane) { return ((lane & 3) << 3) | (((lane >> 2) & 3) << 6) | (((lane >> 4) & 1) << 5) | (((lane >> 5) & 1) << 8); }
constexpr int v_rd_off(int d0, int ks, int half) { return d0 * 512 + ks * 2048 + half * 1024; }
template <int OFF> __device__ __forceinline__ s16x4 tr_read(int vb) { s16x4 r; asm volatile("ds_read_b64_tr_b16 %0, %1 offset:%2" : "=&v"(r) : "v"(vb), "i"(OFF) : "memory"); return r; }
template <int D0> __device__ __forceinline__ void pv_one(f32x16& od, int vb, bf16x8 pa0, bf16x8 pa1, bf16x8 pa2, bf16x8 pa3) {
    const s16x4 l0 = tr_read<v_rd_off(D0, 0, 0)>(vb), h0 = tr_read<v_rd_off(D0, 0, 1)>(vb), l1 = tr_read<v_rd_off(D0, 1, 0)>(vb), h1 = tr_read<v_rd_off(D0, 1, 1)>(vb);
    const s16x4 l2 = tr_read<v_rd_off(D0, 2, 0)>(vb), h2 = tr_read<v_rd_off(D0, 2, 1)>(vb), l3 = tr_read<v_rd_off(D0, 3, 0)>(vb), h3 = tr_read<v_rd_off(D0, 3, 1)>(vb);
    asm volatile("s_waitcnt lgkmcnt(0)" ::: "memory"); SBAR();
#define PK(L, H) (bf16x8){L[0], L[1], L[2], L[3], H[0], H[1], H[2], H[3]}
    od = __builtin_amdgcn_mfma_f32_32x32x16_bf16(pa0, PK(l0, h0), od, 0, 0, 0);
    od = __builtin_amdgcn_mfma_f32_32x32x16_bf16(pa1, PK(l1, h1), od, 0, 0, 0);
    od = __builtin_amdgcn_mfma_f32_32x32x16_bf16(pa2, PK(l2, h2), od, 0, 0, 0);
    od = __builtin_amdgcn_mfma_f32_32x32x16_bf16(pa3, PK(l3, h3), od, 0, 0, 0);
#undef PK
}
__device__ __forceinline__ void pv_d0(f32x16* o, f32x16& osum, int vb, bf16x8 pa0, bf16x8 pa1, bf16x8 pa2, bf16x8 pa3) {
    pv_one<0>(o[0], vb, pa0, pa1, pa2, pa3); pv_one<1>(o[1], vb, pa0, pa1, pa2, pa3);
    const u32x4 ow = {0x3F803F80u, 0x3F803F80u, 0x3F803F80u, 0x3F803F80u}; const bf16x8 ones = *reinterpret_cast<const bf16x8*>(&ow);
    osum = __builtin_amdgcn_mfma_f32_32x32x16_bf16(pa0, ones, osum, 0, 0, 0);
    osum = __builtin_amdgcn_mfma_f32_32x32x16_bf16(pa1, ones, osum, 0, 0, 0);
    osum = __builtin_amdgcn_mfma_f32_32x32x16_bf16(pa2, ones, osum, 0, 0, 0);
    osum = __builtin_amdgcn_mfma_f32_32x32x16_bf16(pa3, ones, osum, 0, 0, 0);
}

__device__ __forceinline__ void pv_partial(f32x16* o, f32x16& osum, int vb, bf16x8 pa0, bf16x8 pa1, bf16x8 pa2, bf16x8 pa3,
                                           f32x16& p0, f32x16& p1, float& m_ref, unsigned& q6x, float& alpha, int hi) {
    pv_one<0>(o[0], vb, pa0, pa1, pa2, pa3);
    float pmax = p0[0];
#pragma unroll
    for (int r = 1; r < 16; ++r) pmax = fmaxf(pmax, p0[r]);
#pragma unroll
    for (int r = 0; r < 8; ++r) p0[r] = __builtin_amdgcn_exp2f(p0[r]);
    pv_one<1>(o[1], vb, pa0, pa1, pa2, pa3);
#pragma unroll
    for (int r = 8; r < 16; ++r) p0[r] = __builtin_amdgcn_exp2f(p0[r]);
#pragma unroll
    for (int r = 0; r < 16; ++r) pmax = fmaxf(pmax, p1[r]);
    { auto rr = __builtin_amdgcn_permlane32_swap(__float_as_uint(pmax), __float_as_uint(pmax), false, false); pmax = fmaxf(__uint_as_float(rr[0]), __uint_as_float(rr[1])); }
    const u32x4 ow = {0x3F803F80u, 0x3F803F80u, 0x3F803F80u, 0x3F803F80u}; const bf16x8 ones = *reinterpret_cast<const bf16x8*>(&ow);
    osum = __builtin_amdgcn_mfma_f32_32x32x16_bf16(pa0, ones, osum, 0, 0, 0);
    osum = __builtin_amdgcn_mfma_f32_32x32x16_bf16(pa1, ones, osum, 0, 0, 0);
    osum = __builtin_amdgcn_mfma_f32_32x32x16_bf16(pa2, ones, osum, 0, 0, 0);
    osum = __builtin_amdgcn_mfma_f32_32x32x16_bf16(pa3, ones, osum, 0, 0, 0);
    if (__builtin_expect(__all(pmax <= THRL), 1)) { alpha = 1.f; }
    else { const float dl = fmaxf(pmax, 0.f);
        const float mnew = __uint_as_float(cvt_pk_bf16(m_ref + dl, 0.f) << 16);
        const float delta = mnew - m_ref;
        alpha = __builtin_amdgcn_exp2f(-delta); m_ref = mnew;
#pragma unroll
        for (int r = 0; r < 16; ++r) { p0[r] *= alpha; p1[r] -= delta; }
        q6x = hi == 0 ? ((__float_as_uint(-mnew) >> 16) & 0xffffu) : 0u; }
}
__device__ __forceinline__ void attn_units(const bf16_t* __restrict__ Q, const bf16_t* __restrict__ Kc, const bf16_t* __restrict__ Vc, bf16_t* __restrict__ O, int u0, int ustep, int nunits, char* lds, LAS unsigned char* ldsl) {
    const int tid = threadIdx.x, wid = __builtin_amdgcn_readfirstlane(tid >> 6), lane = tid & 63, r32 = lane & 31, hi = lane >> 5;
    char* V_lds = lds; char* K_lds = lds + 2 * SHM_V;
    float* wsf = (float*)(lds + 2 * SHM_V + 2 * SHM_K) + wid * 64; float* al_l = wsf + 32;
    unsigned kofs[2], vofs;
#pragma unroll
    for (int i = 0; i < 2; ++i) { const int r = 4 * (2 * wid + i) + (lane >> 4), q = lane & 15; int c = q ^ (r & 7); c = c < 12 ? c : c - 4; kofs[i] = (unsigned)((r * DQK + c * 8) * 2); }
    { const int o = wid * 1024 + lane * 16, sI = o >> 9, wd = (o & 511) >> 1; const int kk = (sI >> 1) * 8 + (wd >> 5); const int k = (kk & ~0xC) | ((kk & 4) << 1) | ((kk & 8) >> 1);
      const int c = (sI & 1) * 32 + (wd & 31); vofs = (unsigned)((k * DV + c) * 2); }
    const int vb0 = (int)(uintptr_t)V_lds + v_rd_base(lane);
    bf16x8 qr[6];
#define DMA_K(Kp, t, b) do { const char* g_ = (const char*)(Kp) + (size_t)(t) * (KVBLK * DQK * 2); _Pragma("unroll") for (int i_ = 0; i_ < 2; ++i_) \
    __builtin_amdgcn_global_load_lds((const unsigned*)(g_ + kofs[i_]), (LAS unsigned*)(ldsl + 2 * SHM_V + (b) * SHM_K + (2 * wid + i_) * 1024), 16, 0, 0); } while (0)
#define DMA_V(Vp, t, b) do { const char* g_ = (const char*)(Vp) + (size_t)(t) * (KVBLK * DV * 2); \
    __builtin_amdgcn_global_load_lds((const unsigned*)(g_ + vofs), (LAS unsigned*)(ldsl + (b) * SHM_V + wid * 1024), 16, 0, 0); } while (0)
#define SWAIT() asm volatile("s_waitcnt vmcnt(0)" ::: "memory")
#define RESC(a) do { if (__any((a) < 1.f)) { if (hi == 0) al_l[r32] = (a); asm volatile("s_waitcnt lgkmcnt(0)" ::: "memory"); \
    _Pragma("unroll") for (int r = 0; r < 16; ++r) { const float f_ = al_l[crow(r, hi)]; o[0][r] *= f_; o[1][r] *= f_; osum[r] *= f_; } } } while (0)
#define UNIT_PTRS(u_, Kp, Vp, Qp) do { const int bh_ = (u_) >> 3, qb_ = (u_) & 7; Kp = Kc + (size_t)bh_ * SKV * DQK; Vp = Vc + (size_t)bh_ * SKV * DV; \
    Qp = Q + ((size_t)bh_ * TL + qb_ * 256 + wid * QBLK + r32) * DQK + hi * 8; } while (0)
#define QLOAD(Qp) do { _Pragma("unroll") for (int d0 = 0; d0 < 6; ++d0) qr[d0] = *reinterpret_cast<const bf16x8*>((Qp) + d0 * 16); } while (0)
    constexpr int NT = SKV / KVBLK;
    int u = u0; if (u >= nunits) return;
    const bf16_t* Kh; const bf16_t* Vh; const bf16_t* Qw;
    UNIT_PTRS(u, Kh, Vh, Qw);
    __syncthreads();
    DMA_K(Kh, 0, 0); DMA_V(Vh, 0, 0); DMA_K(Kh, 1, 1); QLOAD(Qw);
    for (;;) {
        float m_ref = 0.f; unsigned q6x = 0u; f32x16 o[2] = {}; f32x16 osum = {};
        f32x16 pA0, pA1, pB0, pB1; float alA, alB; bf16x8 pa0, pa1, pa2, pa3;
        bf16_t* Ow = O + ((size_t)((u >> 3) >> 4) * TL + (u & 7) * 256 + wid * QBLK) * D + ((u >> 3) & 15) * DV;
        SWAIT(); __syncthreads();
        qkt(pA0, pA1, K_lds, qr, q6x, r32, hi); partialSM(pA0, pA1, m_ref, q6x, alA, true, hi);
        __syncthreads();
        for (int j = 0; j + 2 < NT; j += 2) {
            DMA_K(Kh, j + 2, 0); DMA_V(Vh, j + 1, 1);
            SBAR(); qkt(pB0, pB1, K_lds + SHM_K, qr, q6x, r32, hi);
            finishSM(pA0, pA1, pa0, pa1, pa2, pa3); SBAR();
            pv_partial(o, osum, vb0, pa0, pa1, pa2, pa3, pB0, pB1, m_ref, q6x, alB, hi);
            RESC(alB); SWAIT(); __syncthreads();
            DMA_K(Kh, j + 3, 1); DMA_V(Vh, j + 2, 0);
            SBAR(); qkt(pA0, pA1, K_lds, qr, q6x, r32, hi);
            finishSM(pB0, pB1, pa0, pa1, pa2, pa3); SBAR();
            pv_partial(o, osum, vb0 + SHM_V, pa0, pa1, pa2, pa3, pA0, pA1, m_ref, q6x, alA, hi);
            RESC(alA); SWAIT(); __syncthreads();
        }
        const int un = u + ustep; const bool has_next = un < nunits;
        const bf16_t* Kn = Kh; const bf16_t* Vn = Vh; const bf16_t* Qn = Qw;
        if (has_next) UNIT_PTRS(un, Kn, Vn, Qn);
        if (has_next) DMA_K(Kn, 0, 0);
        DMA_V(Vh, NT - 1, 1);
        SBAR(); qkt(pB0, pB1, K_lds + SHM_K, qr, q6x, r32, hi);
        finishSM(pA0, pA1, pa0, pa1, pa2, pa3); SBAR();
        if (has_next) QLOAD(Qn);
        SBAR();
        pv_partial(o, osum, vb0, pa0, pa1, pa2, pa3, pB0, pB1, m_ref, q6x, alB, hi);
        RESC(alB); SWAIT(); __syncthreads();
        if (has_next) { DMA_K(Kn, 1, 1); DMA_V(Vn, 0, 0); }
        finishSM(pB0, pB1, pa0, pa1, pa2, pa3); SBAR();
        pv_d0(o, osum, vb0 + SHM_V, pa0, pa1, pa2, pa3);
        float rli[16];
#pragma unroll
        for (int r = 0; r < 16; ++r) rli[r] = __builtin_amdgcn_rcpf(osum[r]);
        { bf16_t* stg = (bf16_t*)(lds + 65536) + wid * 2048;
#pragma unroll
          for (int r = 0; r < 16; ++r) { const int orow = crow(r, hi);
#pragma unroll
              for (int d0 = 0; d0 < 2; ++d0) { const float val = o[d0][r] * rli[r]; stg[orow * 64 + d0 * 32 + r32] = (bf16_t)(cvt_pk_bf16(val, val) & 0xffffu); } }
          asm volatile("s_waitcnt lgkmcnt(0)" ::: "memory");
#pragma unroll
          for (int i = 0; i < 4; ++i) { const int row = i * 8 + (lane >> 3), ch = lane & 7; const u32x4 v = *(const u32x4*)(stg + row * 64 + ch * 8); *(u32x4*)(Ow + (size_t)row * D + ch * 8) = v; }
          asm volatile("s_waitcnt lgkmcnt(0)" ::: "memory"); }
        if (!has_next) break;
        u = un; Kh = Kn; Vh = Vn; Qw = Qn;
    }
    SWAIT();
#undef DMA_K
#undef DMA_V
#undef SWAIT
#undef RESC
#undef UNIT_PTRS
#undef QLOAD
}
#undef KSWZ
#undef SBAR
}

__device__ __forceinline__ void p_attention(Frame& F) {
    const int vcu = (F.G % 8 == 0) ? (F.bid % 8) * (F.G / 8) + F.bid / 8 : F.bid;
    att::attn_units(WSP(bf16_t, WS_Q), WSP(bf16_t, WS_K), WSP(bf16_t, WS_V), WSP(bf16_t, WS_O), vcu, F.G, NB * NH * 8, (char*)F.lds, F.lds);
    __syncthreads();
}

__device__ __forceinline__ void stage_gather_idx(Frame& F, const pg8::MoeOrder& S) {
    LAS unsigned* gi = (LAS unsigned*)(F.lds + pg8::STAGE_BYTES);
    const int* rowidx = WSP(int, WS_ROWIDX); pg8::Unit u;
    for (int i = 0; S.next(i, u); ++i) for (int r = F.tid; r < 256; r += 512) gi[i * 256 + r] = (unsigned)rowidx[u.arow + r] * (unsigned)(D * 2);
    __syncthreads();
}

constexpr int N_PHASES = 19;
__global__ void __launch_bounds__(NWAVES * 64, 2) mega_fwd(Args args) {
    extern __shared__ __attribute__((aligned(16))) unsigned char lds_raw[];
    Frame F; F.lds = (LAS unsigned char*)lds_raw; F.tid = threadIdx.x; F.lane = F.tid & 63; F.wave = __builtin_amdgcn_readfirstlane(F.tid >> 6);
    F.G = gridDim.x; F.bid = blockIdx.x; F.a = &args; F.ws = args.ws;
    cg::grid_group grid = cg::this_grid();
    const int lo = args.ph_lo, hi = args.ph_hi;
    volatile LAS unsigned* misc = (volatile LAS unsigned*)(F.lds + LDS_BYTES - 256);
    if (F.tid < 2) misc[F.tid] = 0u;
    __syncthreads();
    (void)xcd_barrier_post((unsigned*)args.ws, misc);
    if (lo < 0) grid.sync();
#ifdef ONLY_PHASE
#define IN(k) ((k) == ONLY_PHASE && lo <= (k) && (k) < hi)
#else
#define IN(k) (lo <= (k) && (k) < hi)
#endif
#define GRIDBAR() do { XcdBarrier xb_; xb_.bar = (unsigned*)args.ws; xb_.x = xb_xcc_id(); xb_.st = (volatile LAS unsigned*)(F.lds + LDS_BYTES - 256); xcd_barrier(xb_); } while (0)
#define PH(k, ...) if (IN(k)) { __VA_ARGS__ if ((DUP_MASK >> (k)) & 1u) { GRIDBAR(); __VA_ARGS__ } } SEAM(k);
#define SEAM(k) do { if (IN(k) && IN((k) + 1)) { XcdBarrier xb_; xb_.bar = (unsigned*)args.ws; xb_.x = xb_xcc_id(); xb_.st = (volatile LAS unsigned*)(F.lds + LDS_BYTES - 256); xcd_barrier(xb_); } } while (0)
    const Args& A = args;
    PH(0,  p0_prologue(F); )
    PH(1,  p_norm_in(F); )
    PH(2,
        pg8::DenseOrder S; S.init(MT, 2048, D, F.G, F.bid); pg8::EpiLruIn E{WSP(bf16_t, WS_G), WSP(bf16_t, WS_ZX)};
        pg8::gemm_phase<pg8::EpiLruIn, pg8::DenseOrder, false>(F.lds, WSP(bf16_t, WS_H), D, WSP(bf16_t, WS_WLIN), D, S, E, nullptr); )
    PH(3,  p_scan(F); )
    PH(4,
        pg8::DenseOrder S; S.init(MT, D, D, F.G, F.bid); pg8::EpiResid<false> E{A.in[I_X], A.in[I_CTX], WSP(bf16_t, WS_X), WSP(float, WS_MOD)};
        pg8::gemm_phase<pg8::EpiResid<false>, pg8::DenseOrder, false>(F.lds, WSP(bf16_t, WS_YG), D, WSP(bf16_t, WS_WLOUT), D, S, E, nullptr); )
    PH(5,  p_moe_norm(F, 0, MT); )
    PH(6,  p_topk(F, true); )
    PH(7,
        pg8::MoeOrder S; S.init(288, 8, 2048, F.G, F.bid); stage_gather_idx(F, S); pg8::EpiUp E{WSP(bf16_t, WS_HID)};
        pg8::gemm_phase<pg8::EpiUp, pg8::MoeOrder, true>(F.lds, WSP(bf16_t, WS_H), D, WSP(bf16_t, WS_WUP), D, S, E, (const LAS unsigned*)(F.lds + pg8::STAGE_BYTES)); )
    PH(8,
        pg8::MoeOrder S; S.init(288, 4, 1024, F.G, F.bid); pg8::EpiDown E{WSP(bf16_t, WS_Y), WSP(float, WS_GATEV)};
        pg8::gemm_phase<pg8::EpiDown, pg8::MoeOrder, false>(F.lds, WSP(bf16_t, WS_HID), D, WSP(bf16_t, WS_WDN), D, S, E, nullptr); )
    PH(9,  p_combine(F, 0, false); )
    PH(10,
        pg8::DenseOrder S; S.init(MT, ZW, D, F.G, F.bid); pg8::EpiZ E{WSP(bf16_t, WS_Z), WSP(float, WS_SSQ), WSP(float, WS_SSKV), (LAS float*)(F.lds + pg8::STAGE_BYTES)};
        pg8::gemm_phase<pg8::EpiZ, pg8::DenseOrder, false>(F.lds, WSP(bf16_t, WS_H), D, WSP(bf16_t, WS_WMIN), D, S, E, nullptr); )
    PH(11,
        { LAS float* ropel = (LAS float*)(F.lds + pg8::STAGE_BYTES);
          for (int i = F.tid; i < 1024; i += 512) ropel[i] = WSP(float, WS_ROPE)[i];
          __syncthreads();
          pg8::DenseOrder S; S.init(MLAT, NH * DQK, QLORA, F.G, F.bid); pg8::EpiQ E{WSP(bf16_t, WS_Q), WSP(float, WS_SSQ), ropel};
          pg8::gemm_phase<pg8::EpiQ, pg8::DenseOrder, false>(F.lds, WSP(bf16_t, WS_Z), ZW, WSP(bf16_t, WS_WUQ), QLORA, S, E, nullptr); }
        { pg8::DenseOrder S; S.init(MT, NH * 128, KVLORA, F.G, F.bid); pg8::EpiKV E{WSP(bf16_t, WS_K), WSP(bf16_t, WS_V), WSP(float, WS_SSKV)};
          pg8::gemm_phase<pg8::EpiKV, pg8::DenseOrder, false>(F.lds, WSP(bf16_t, WS_Z) + QLORA, ZW, WSP(bf16_t, WS_WUKV), KVLORA, S, E, nullptr); }
        p_krope(F); )
    PH(12,  p_attention(F); )
    PH(13,
        pg8::DenseOrder S; S.init(MLAT, D, D, F.G, F.bid); pg8::EpiResid<true> E{nullptr, nullptr, WSP(bf16_t, WS_X), WSP(float, WS_MOD) + 17 * 6144};
        pg8::gemm_phase<pg8::EpiResid<true>, pg8::DenseOrder, false>(F.lds, WSP(bf16_t, WS_O), D, WSP(bf16_t, WS_WO), D, S, E, nullptr); )
    PH(14,  p_moe_norm(F, 1, MLAT); )
    PH(15,  p_topk(F, false); )
    PH(16,
        pg8::MoeOrder S; S.init(256, 8, 2048, F.G, F.bid); stage_gather_idx(F, S); pg8::EpiUp E{WSP(bf16_t, WS_HID)};
        pg8::gemm_phase<pg8::EpiUp, pg8::MoeOrder, true>(F.lds, WSP(bf16_t, WS_H), D, WSP(bf16_t, WS_WUP) + (size_t)NE * 2048 * 1024, D, S, E, (const LAS unsigned*)(F.lds + pg8::STAGE_BYTES)); )
    PH(17,
        pg8::MoeOrder S; S.init(256, 4, 1024, F.G, F.bid); pg8::EpiDown E{WSP(bf16_t, WS_Y), WSP(float, WS_GATEV)};
        pg8::gemm_phase<pg8::EpiDown, pg8::MoeOrder, false>(F.lds, WSP(bf16_t, WS_HID), D, WSP(bf16_t, WS_WDN) + (size_t)NE * 1024 * 1024, D, S, E, nullptr); )
    PH(18,  p_combine(F, 1, true); )
#undef IN
#undef SEAM
#undef PH
#undef GRIDBAR
}

extern "C" void kernel_launch(void* const* d_in, const int* in_sizes, int n_in, void* d_out, int out_size, void* d_ws, size_t ws_size, hipStream_t stream) {
    static int grid = 0;
    if (grid == 0) {
        if (n_in != 25 || in_sizes[0] != MLAT * D || out_size != MLAT * D || ws_size < WS_END) { fprintf(stderr, "kernel_launch: unexpected shapes (n_in %d, in0 %d, out %d, ws %zu)\n", n_in, n_in > 0 ? in_sizes[0] : -1, out_size, ws_size); grid = -1; return; }
        int dev = 0, cus = 0, per_cu = 0;
        if (hipGetDevice(&dev) != hipSuccess || hipDeviceGetAttribute(&cus, hipDeviceAttributeMultiprocessorCount, dev) != hipSuccess) { grid = -1; return; }
        if (hipFuncSetAttribute((const void*)mega_fwd, hipFuncAttributeMaxDynamicSharedMemorySize, LDS_BYTES) != hipSuccess) { fprintf(stderr, "kernel_launch: hipFuncSetAttribute failed\n"); grid = -1; return; }
        if (hipOccupancyMaxActiveBlocksPerMultiprocessor(&per_cu, (const void*)mega_fwd, NWAVES * 64, LDS_BYTES) != hipSuccess || per_cu < 1) { fprintf(stderr, "kernel_launch: occupancy query says %d\n", per_cu); (void)hipGetLastError(); per_cu = 1; }
        grid = cus * 1;
    }
    if (grid < 0) return;
    if (hipMemsetAsync(d_ws, 0, 16384, stream) != hipSuccess) { fprintf(stderr, "kernel_launch: memset of the barrier words failed\n"); return; }
    Args a{};
    for (int i = 0; i < 25; ++i) a.in[i] = (const float*)d_in[i];
    a.out = (float*)d_out; a.ws = (unsigned char*)d_ws;
#if MK_N_LAUNCHES == 1
    a.ph_lo = 0; a.ph_hi = N_PHASES;
    void* kargs[] = {&a};
    hipError_t e = hipLaunchCooperativeKernel((const void*)mega_fwd, dim3(grid), dim3(NWAVES * 64), kargs, LDS_BYTES, stream);
    if (e != hipSuccess) fprintf(stderr, "kernel_launch: cooperative launch failed: %s (grid %d)\n", hipGetErrorString(e), grid);
#else
    for (int p = 0; p < N_PHASES; ++p) { a.ph_lo = p; a.ph_hi = p + 1; void* kargs[] = {&a};
        hipError_t e = hipLaunchCooperativeKernel((const void*)mega_fwd, dim3(grid), dim3(NWAVES * 64), kargs, LDS_BYTES, stream);
        if (e != hipSuccess) { fprintf(stderr, "kernel_launch: launch %d failed: %s\n", p, hipGetErrorString(e)); break; } }
#endif
}
```

```cpp
#include <hip/hip_runtime.h>
#include <hip/hip_cooperative_groups.h>
#include <cstdio>
#include <cstdint>
namespace cg = cooperative_groups;

#ifndef DUP_MASK
#define DUP_MASK 0u
#endif
#ifndef MK_N_LAUNCHES
#define MK_N_LAUNCHES 1
#endif

#define LAS __attribute__((address_space(3)))
typedef unsigned short bf16_t;
typedef short bf16x8 __attribute__((ext_vector_type(8)));
typedef short s16x4 __attribute__((ext_vector_type(4)));
typedef float f32x2 __attribute__((ext_vector_type(2)));
typedef float f32x4 __attribute__((ext_vector_type(4)));
typedef float f32x16 __attribute__((ext_vector_type(16)));
typedef unsigned u32x2 __attribute__((ext_vector_type(2)));
typedef unsigned u32x4 __attribute__((ext_vector_type(4)));

constexpr int D = 1024, NB = 16, TL = 2048, TCX = 256, MLAT = NB * TL, MCTX = NB * TCX, MT = MLAT + MCTX;
constexpr int NE = 16, CAPL = 256, CAPC = 32, DEXP = 1024;
constexpr int MOE_LAT_ROWS = NB * NE * CAPL;
constexpr int MOE_ROWS0 = MOE_LAT_ROWS + NB * NE * CAPC;
constexpr int NH = 16, DQK = 96, DV = 64, QLORA = 384, KVLORA = 256, ZW = 768, SKV = TL + TCX;
constexpr float EPS = 1e-6f;
constexpr float QSCALE = 0.10206207261596575f * 1.4426950408889634f;

constexpr size_t MiB = 1u << 20;
constexpr size_t WS_MOD = 1 * MiB;
constexpr size_t WS_ROPE = 2 * MiB;
constexpr size_t WS_SSQ = 2 * MiB + 512 * 1024;
constexpr size_t WS_SSKV = WS_SSQ + 256 * 1024;
constexpr size_t WS_AFFL = 3 * MiB;
constexpr size_t WS_AFFC = 5 * MiB;
constexpr size_t WS_ROWIDX = 6 * MiB;
constexpr size_t WS_GATEV = 6 * MiB + 512 * 1024;
constexpr size_t WS_SEL = 7 * MiB;
constexpr size_t WS_WG = 10 * MiB;
constexpr size_t WS_WLIN = 16 * MiB;
constexpr size_t WS_WLOUT = 20 * MiB;
constexpr size_t WS_WMIN = 22 * MiB;
constexpr size_t WS_WUQ = 24 * MiB;
constexpr size_t WS_WUKV = 26 * MiB;
constexpr size_t WS_WO = 27 * MiB;
constexpr size_t WS_WUP = 32 * MiB;
constexpr size_t WS_WDN = 160 * MiB;
constexpr size_t WS_H = 224 * MiB;
constexpr size_t WS_G = 296 * MiB;
constexpr size_t WS_ZX = 368 * MiB;
constexpr size_t WS_YG = 440 * MiB;
constexpr size_t WS_Z = 296 * MiB;
constexpr size_t WS_Q = 352 * MiB;
constexpr size_t WS_X = 512 * MiB;
constexpr size_t WS_HID = 656 * MiB;
constexpr size_t WS_K = 656 * MiB;
constexpr size_t WS_Y = 800 * MiB;
constexpr size_t WS_V = 800 * MiB;
constexpr size_t WS_O = 872 * MiB;
constexpr size_t WS_END = 944 * MiB;

constexpr int LDS_BYTES = 147456;
constexpr int NWAVES = 8;

__device__ __forceinline__ unsigned cvt_pk_bf16(float lo, float hi) { unsigned r; asm volatile("v_cvt_pk_bf16_f32 %0, %1, %2" : "=v"(r) : "v"(lo), "v"(hi)); return r; }
__device__ __forceinline__ float bf2f(unsigned short h) { return __uint_as_float(((unsigned)h) << 16); }
__device__ __forceinline__ float wave_sum(float v) {
#pragma unroll
    for (int o = 1; o < 64; o <<= 1) v += __shfl_xor(v, o);
    return v;
}
__device__ __forceinline__ int wave_iscan_dpp(int v) {
    v += __builtin_amdgcn_update_dpp(0, v, 0x111, 0xf, 0xf, true);
    v += __builtin_amdgcn_update_dpp(0, v, 0x112, 0xf, 0xf, true);
    v += __builtin_amdgcn_update_dpp(0, v, 0x114, 0xf, 0xf, true);
    v += __builtin_amdgcn_update_dpp(0, v, 0x118, 0xf, 0xf, true);
    v += __builtin_amdgcn_update_dpp(0, v, 0x142, 0xa, 0xf, true);
    v += __builtin_amdgcn_update_dpp(0, v, 0x143, 0xc, 0xf, true);
    return v;
}
__device__ __forceinline__ int wave_isum_dpp(int v) {
    v += __builtin_amdgcn_update_dpp(0, v, 0x111, 0xf, 0xf, true);
    v += __builtin_amdgcn_update_dpp(0, v, 0x112, 0xf, 0xf, true);
    v += __builtin_amdgcn_update_dpp(0, v, 0x114, 0xf, 0xf, true);
    v += __builtin_amdgcn_update_dpp(0, v, 0x118, 0xf, 0xf, true);
    v += __builtin_amdgcn_update_dpp(0, v, 0x142, 0xa, 0xf, true);
    v += __builtin_amdgcn_update_dpp(0, v, 0x143, 0xc, 0xf, true);
    return __builtin_amdgcn_readlane(v, 63);
}
__device__ __forceinline__ int wave_isum(int v) {
#pragma unroll
    for (int o = 1; o < 64; o <<= 1) v += __shfl_xor(v, o);
    return v;
}
__device__ __forceinline__ float sigmoidf_(float x) { return 1.0f / (1.0f + __expf(-x)); }
__device__ __forceinline__ float gelu_tanh(float x) {
    constexpr float A = 1.5957691216057308f * 1.4426950408889634f, B = A * 0.044715f;
    const float w = x * (A + B * (x * x));
    return x * __builtin_amdgcn_rcpf(1.0f + __builtin_amdgcn_exp2f(-w));
}

namespace pg8 {
constexpr int BM = 256, BK = 64, HALF = 128, HTB = HALF * BK * 2, STAGE_BYTES = 8 * HTB;
__device__ __forceinline__ int lds_byte(int r, int c) { const int st = (r >> 4) * 2 + (c >> 5), rr = r & 15, cc = c & 31, ob = rr * 64 + cc * 2; return st * 1024 + (ob ^ (((ob >> 9) & 1) << 5)); }
__device__ __forceinline__ void stage_rc(int b, int& R, int& C) { const int st = b / 1024, sb = b % 1024, swz = sb ^ (((sb >> 9) & 1) << 5); R = (st >> 1) * 16 + swz / 64; C = (st & 1) * 32 + (swz % 64) / 2; }
__device__ __forceinline__ int perm32(int rho) { const int n = rho >> 4, i = rho & 15; return 8 * (i >> 2) + 4 * n + (i & 3); }

struct Unit { int pm, pn, arow, boff, idx; };

struct DenseOrder {
    int nM, nN, nwg, G, c, K;
    __device__ __forceinline__ void init(int M, int N, int K_, int G_, int c_) { nM = M / BM; nN = N / BM; nwg = nM * nN; G = G_; c = c_; K = K_; }
    __device__ __forceinline__ bool next(int i, Unit& u) const {
        const long L = (long)i * G + c; if (L >= nwg) return false;
        int wgid = (int)L; { const int q = nwg / 8, r = nwg % 8, xcd = wgid % 8, off = wgid / 8; wgid = (xcd < r ? xcd * (q + 1) : r * (q + 1) + (xcd - r) * q) + off; }
        const int nig = 8 * nN, gid = wgid / nig, fm = gid * 8, gsz = (nM - fm) < 8 ? (nM - fm) : 8;
        u.pm = fm + ((wgid % nig) % gsz); u.pn = (wgid % nig) / gsz; u.arow = u.pm * BM; u.boff = u.pn * BM * K; u.idx = i; return true;
    }
};
struct MoeOrder {
    int nRT, nPN, G, vc, Nexp;
    __device__ __forceinline__ void init(int nRT_, int nPN_, int Nexp_, int G_, int c_) { nRT = nRT_; nPN = nPN_; Nexp = Nexp_; G = G_; vc = (G_ % 8 == 0) ? (c_ % 8) * (G_ / 8) + c_ / 8 : c_; }
    __device__ __forceinline__ bool next(int i, Unit& u) const {
        const long L = (long)i * G + vc; if (L >= (long)nRT * nPN) return false;
        const int rt = (int)(L / nPN), pn = (int)(L % nPN);
        const int e = rt < 256 ? (rt >> 4) : ((rt - 256) >> 1);
        u.pm = rt; u.pn = pn; u.arow = rt * BM; u.boff = (e * Nexp + pn * BM) * 1024; u.idx = i; return true;
    }
};

template <class Epi, class Sched, bool GATHER>
__device__ __forceinline__ void gemm_phase(LAS unsigned char* lds, const bf16_t* A, int lda, const bf16_t* Bt, int K, const Sched& S, const Epi& E, const LAS unsigned* gidx) {
    const int tid = threadIdx.x, wid = __builtin_amdgcn_readfirstlane(tid >> 6), lane = tid & 63, wr = wid >> 2, wc = wid & 3, fr = lane & 15, fq = lane >> 4;
    const int nt = K / BK;
    int RA[2]; unsigned CA2[2], voffB[2];
#pragma unroll
    for (int i = 0; i < 2; ++i) { int R, C; stage_rc(tid * 16 + i * 8192, R, C); const int Rb = Epi::PERM ? ((R & ~31) + perm32(R & 31)) : R;
        RA[i] = R; CA2[i] = (unsigned)C * 2u; voffB[i] = (unsigned)(Rb * K + C) * 2u; }
    const size_t kstep = (size_t)(BK * 2);
    const size_t hstepB = (size_t)HALF * K * 2;
    const unsigned ldsw = (unsigned)wid * 1024u;
    const int aoff = lds_byte(wr * 64 + fr, fq * 8), boff = lds_byte(wc * 32 + fr, fq * 8);
    const char* Ab = (const char*)A; const char* Bb = (const char*)Bt;
#define PG8_SA(b, h) (((b) * 2 + (h)) * HTB)
#define PG8_SB(b, h) ((4 + (b) * 2 + (h)) * HTB)
#define PG8_STAGE(bufoff, gbase, voff) do { _Pragma("unroll") for (int _i = 0; _i < 2; ++_i) \
        __builtin_amdgcn_global_load_lds((const unsigned*)((const char*)(gbase) + (voff)[_i]), (LAS unsigned*)(lds + (bufoff) + ldsw + _i * 8192), 16, 0, 0); } while (0)
#define PG8_LDA(dst, b, h) do { _Pragma("unroll") for (int m = 0; m < 4; ++m) _Pragma("unroll") for (int k = 0; k < 2; ++k) dst[m][k] = *(const LAS bf16x8*)(lds + PG8_SA(b, h) + aoff + m * 2048 + k * 1024); } while (0)
#define PG8_LDB(dst, b, h) do { _Pragma("unroll") for (int n = 0; n < 2; ++n) _Pragma("unroll") for (int k = 0; k < 2; ++k) dst[n][k] = *(const LAS bf16x8*)(lds + PG8_SB(b, h) + boff + n * 2048 + k * 1024); } while (0)
#define PG8_MMA(ai, bj, At, Bt_) do { __builtin_amdgcn_s_setprio(1); _Pragma("unroll") for (int m = 0; m < 4; ++m) _Pragma("unroll") for (int n = 0; n < 2; ++n) _Pragma("unroll") for (int k = 0; k < 2; ++k) \
        acc[ai][bj][m][n] = __builtin_amdgcn_mfma_f32_16x16x32_bf16(Bt_[n][k], At[m][k], acc[ai][bj][m][n], 0, 0, 0); __builtin_amdgcn_s_setprio(0); } while (0)
#define PG8_WAIT_V(n) asm volatile("s_waitcnt vmcnt(" #n ")" ::: "memory")
#define PG8_WAIT_L(n) asm volatile("s_waitcnt lgkmcnt(" #n ")" ::: "memory")
#define PG8_BAR __builtin_amdgcn_s_barrier()
#define PG8_SCHED __builtin_amdgcn_sched_barrier(0)
#define PG8_SET_AOFF(ao, u, uidx) do { _Pragma("unroll") for (int _h = 0; _h < 2; ++_h) _Pragma("unroll") for (int _i = 0; _i < 2; ++_i) \
        ao[_h][_i] = (GATHER ? gidx[(uidx) * 256 + _h * 128 + RA[_i]] : (unsigned)(((u).arow + _h * 128 + RA[_i]) * lda) * 2u) + CA2[_i]; } while (0)
    Unit cur, nxt; int ui = 0;
    if (!S.next(0, cur)) return;
    f32x4 acc[2][2][4][2];
#pragma unroll
    for (int a = 0; a < 2; ++a)
#pragma unroll
        for (int b = 0; b < 2; ++b)
#pragma unroll
            for (int m = 0; m < 4; ++m)
#pragma unroll
                for (int n = 0; n < 2; ++n) acc[a][b][m][n] = (f32x4){0.f, 0.f, 0.f, 0.f};
    bf16x8 At[4][2], B0[2][2], B1[2][2];
    unsigned aoc[2][2], aon[2][2];
    PG8_SET_AOFF(aoc, cur, 0);
    const char* cB = Bb + (size_t)cur.boff * 2;
    PG8_STAGE(PG8_SB(0, 0), cB, voffB); PG8_STAGE(PG8_SB(0, 1), cB + hstepB, voffB); PG8_STAGE(PG8_SA(0, 0), Ab, aoc[0]); PG8_STAGE(PG8_SA(0, 1), Ab, aoc[1]);
    if (wr == 1) PG8_BAR;
    PG8_WAIT_V(2); PG8_BAR;
    PG8_STAGE(PG8_SB(1, 0), cB + kstep, voffB); PG8_STAGE(PG8_SA(1, 0), Ab + kstep, aoc[0]); PG8_STAGE(PG8_SB(1, 1), cB + hstepB + kstep, voffB);
    PG8_WAIT_V(6); PG8_BAR;
    for (;;) {
        const bool has_next = S.next(ui + 1, nxt);
        const char* nB = has_next ? Bb + (size_t)nxt.boff * 2 : cB;
        if (has_next) { PG8_SET_AOFF(aon, nxt, ui + 1); }
        else {
#pragma unroll
            for (int _h = 0; _h < 2; ++_h)
#pragma unroll
                for (int _i = 0; _i < 2; ++_i) aon[_h][_i] = aoc[_h][_i]; }
#pragma unroll 1
        for (int t = 0; t < nt; t += 2) {
            const bool last = (t == nt - 2);
            const char* a1 = Ab + (size_t)(t + 1) * kstep;
            const char* a2 = last ? Ab : Ab + (size_t)(t + 2) * kstep; const char* b2 = last ? nB : cB + (size_t)(t + 2) * kstep;
            const char* a3 = a2 + kstep; const char* b3 = b2 + kstep;
            unsigned a2o[2][2];
#pragma unroll
            for (int _h = 0; _h < 2; ++_h)
#pragma unroll
                for (int _i = 0; _i < 2; ++_i) a2o[_h][_i] = last ? aon[_h][_i] : aoc[_h][_i];
            PG8_LDB(B0, 0, 0); PG8_LDB(B1, 0, 1); PG8_SCHED; PG8_LDA(At, 0, 0); PG8_STAGE(PG8_SA(1, 1), a1, aoc[1]);
            PG8_WAIT_V(8); PG8_WAIT_L(0); PG8_BAR; PG8_MMA(0, 0, At, B0); PG8_MMA(0, 1, At, B1); PG8_BAR; PG8_SCHED;
            PG8_LDA(At, 0, 1); PG8_STAGE(PG8_SB(0, 0), b2, voffB); PG8_STAGE(PG8_SB(0, 1), b2 + hstepB, voffB); PG8_STAGE(PG8_SA(0, 0), a2, a2o[0]);
            PG8_WAIT_V(8); PG8_WAIT_L(0); PG8_BAR; PG8_MMA(1, 0, At, B0); PG8_MMA(1, 1, At, B1); PG8_BAR; PG8_SCHED;
            PG8_LDB(B0, 1, 0); PG8_LDB(B1, 1, 1); PG8_SCHED; PG8_LDA(At, 1, 0); PG8_STAGE(PG8_SA(0, 1), a2, a2o[1]);
            PG8_WAIT_V(8); PG8_WAIT_L(0); PG8_BAR; PG8_MMA(0, 0, At, B0); PG8_MMA(0, 1, At, B1); PG8_BAR; PG8_SCHED;
            PG8_LDA(At, 1, 1); PG8_STAGE(PG8_SB(1, 0), b3, voffB); PG8_STAGE(PG8_SB(1, 1), b3 + hstepB, voffB); PG8_STAGE(PG8_SA(1, 0), a3, a2o[0]);
            PG8_WAIT_V(8); PG8_WAIT_L(0); PG8_BAR; PG8_MMA(1, 0, At, B0); PG8_MMA(1, 1, At, B1); PG8_BAR; PG8_SCHED;
        }
        if (wr == 0) PG8_BAR;
        E(acc, cur, wr, wc, fr, fq);
        if (!has_next) break;
#pragma unroll
        for (int a = 0; a < 2; ++a)
#pragma unroll
            for (int b = 0; b < 2; ++b)
#pragma unroll
                for (int m = 0; m < 4; ++m)
#pragma unroll
                    for (int n = 0; n < 2; ++n) acc[a][b][m][n] = (f32x4){0.f, 0.f, 0.f, 0.f};
        cur = nxt; cB = nB; ++ui;
#pragma unroll
        for (int _h = 0; _h < 2; ++_h)
#pragma unroll
            for (int _i = 0; _i < 2; ++_i) aoc[_h][_i] = aon[_h][_i];
        if (wr == 1) PG8_BAR;
    }
    PG8_WAIT_V(0);
    PG8_BAR;
#undef PG8_SA
#undef PG8_SB
#undef PG8_STAGE
#undef PG8_LDA
#undef PG8_LDB
#undef PG8_MMA
#undef PG8_WAIT_V
#undef PG8_WAIT_L
#undef PG8_BAR
#undef PG8_SCHED
#undef PG8_SET_AOFF
}

#define EPI_ARGS const f32x4 (&acc)[2][2][4][2], const Unit& u, int wr, int wc, int fr, int fq
__device__ __forceinline__ u32x4 pack8(const f32x4& a, const f32x4& b) { u32x4 w; w.x = cvt_pk_bf16(a[0], a[1]); w.y = cvt_pk_bf16(a[2], a[3]); w.z = cvt_pk_bf16(b[0], b[1]); w.w = cvt_pk_bf16(b[2], b[3]); return w; }

__device__ __forceinline__ int coalesce_addr(int lane) { return (16 * (lane & 3) + (lane >> 2)) << 2; }
__device__ __forceinline__ u32x4 coalesce16(const u32x4& w, int paddr) {
    u32x4 r; r.x = (unsigned)__builtin_amdgcn_ds_bpermute(paddr, (int)w.x); r.y = (unsigned)__builtin_amdgcn_ds_bpermute(paddr, (int)w.y);
    r.z = (unsigned)__builtin_amdgcn_ds_bpermute(paddr, (int)w.z); r.w = (unsigned)__builtin_amdgcn_ds_bpermute(paddr, (int)w.w); return r;
}
struct EpiLruIn {
    static constexpr bool PERM = true;
    bf16_t* G; bf16_t* ZX;
    __device__ __forceinline__ void operator()(EPI_ARGS) const {
        const bool act = u.pn < 4; bf16_t* base = act ? G : ZX; const int colt = (u.pn & 3) * BM;
        const int lane = fq * 16 + fr, pa = coalesce_addr(lane), rl = lane >> 2, cl = lane & 3;
        const int rowdst = u.pm * BM + wr * 64 + rl, col0 = colt + wc * 32 + 8 * cl;
#pragma unroll
        for (int ai = 0; ai < 2; ++ai)
#pragma unroll
            for (int m = 0; m < 4; ++m) { bf16_t* rowp = base + (size_t)(rowdst + ai * HALF + m * 16) * D + col0;
#pragma unroll
                for (int bj = 0; bj < 2; ++bj) { f32x4 v0 = acc[ai][bj][m][0], v1 = acc[ai][bj][m][1];
                    if (act) {
#pragma unroll
                        for (int j = 0; j < 4; ++j) { v0[j] = gelu_tanh(v0[j]); v1[j] = gelu_tanh(v1[j]); } }
                    *(u32x4*)(rowp + bj * HALF) = coalesce16(pack8(v0, v1), pa); } }
    }
};
template <bool BASE_BF16> struct EpiResid {
    static constexpr bool PERM = true;
    const float* base_lat; const float* base_ctx; bf16_t* X; const float* modl;
    __device__ __forceinline__ void operator()(EPI_ARGS) const {
        const int rowt = u.pm * BM; const bool isl = rowt < MLAT;
        const float* bs = isl ? base_lat + (size_t)rowt * D : base_ctx + (size_t)(rowt - MLAT) * D;
        const int bidx = isl ? rowt / TL : 16;
        const float* gv = modl + bidx * 6144 + 2 * D;
        bf16_t* xo = X + (size_t)rowt * D;
        const int lane = fq * 16 + fr, pa = coalesce_addr(lane), rl = lane >> 2, cl = lane & 3;
        const int cols = u.pn * BM + wc * 32 + 8 * fq; int cold = u.pn * BM + wc * 32 + 8 * cl, r0 = wr * 64 + rl;
        asm volatile("" : "+v"(cold), "+v"(r0));
        f32x4 g[2][2];
#pragma unroll
        for (int bj = 0; bj < 2; ++bj)
#pragma unroll
            for (int n = 0; n < 2; ++n) g[bj][n] = *(const f32x4*)(gv + cols + bj * HALF + n * 4);
        constexpr int RDEPTH = 3;
        f32x4 bf[8][2][2]; u32x4 bw[8][2];
#define RESID_LOAD(s_) do { const size_t off_ = (size_t)(r0 + ((s_) >> 2) * HALF + ((s_) & 3) * 16) * D + cold; _Pragma("unroll") for (int bj = 0; bj < 2; ++bj) { \
            if (BASE_BF16) bw[s_][bj] = *(const u32x4*)(xo + off_ + bj * HALF); \
            else { bf[s_][bj][0] = *(const f32x4*)(bs + off_ + bj * HALF); bf[s_][bj][1] = *(const f32x4*)(bs + off_ + bj * HALF + 4); } } } while (0)
#pragma unroll
        for (int s = 0; s < RDEPTH; ++s) RESID_LOAD(s);
#pragma unroll
        for (int s = 0; s < 8; ++s) { const int ai = s >> 2, m = s & 3; const size_t off = (size_t)(r0 + ai * HALF + m * 16) * D + cold;
            if (s + RDEPTH < 8) RESID_LOAD(s + RDEPTH);
            asm volatile("" ::: "memory");
#pragma unroll
            for (int bj = 0; bj < 2; ++bj) { f32x4 b0, b1;
                if (BASE_BF16) { const u32x4 w = bw[s][bj];
                    b0 = (f32x4){__uint_as_float(w.x << 16), __uint_as_float(w.x & 0xffff0000u), __uint_as_float(w.y << 16), __uint_as_float(w.y & 0xffff0000u)};
                    b1 = (f32x4){__uint_as_float(w.z << 16), __uint_as_float(w.z & 0xffff0000u), __uint_as_float(w.w << 16), __uint_as_float(w.w & 0xffff0000u)}; }
                else { b0 = bf[s][bj][0]; b1 = bf[s][bj][1]; }
                const u32x4 d = coalesce16(pack8(g[bj][0] * acc[ai][bj][m][0], g[bj][1] * acc[ai][bj][m][1]), pa);
                const f32x4 d0 = (f32x4){__uint_as_float(d.x << 16), __uint_as_float(d.x & 0xffff0000u), __uint_as_float(d.y << 16), __uint_as_float(d.y & 0xffff0000u)};
                const f32x4 d1 = (f32x4){__uint_as_float(d.z << 16), __uint_as_float(d.z & 0xffff0000u), __uint_as_float(d.w << 16), __uint_as_float(d.w & 0xffff0000u)};
                *(u32x4*)(xo + off + bj * HALF) = pack8(b0 + d0, b1 + d1); }
            asm volatile("" ::: "memory"); }
#undef RESID_LOAD
    }
};
struct EpiZ {
    static constexpr bool PERM = true;
    bf16_t* Z; float* ssq; float* sskv; LAS float* red;
    __device__ __forceinline__ void operator()(EPI_ARGS) const {
        const int lane = fq * 16 + fr, pa = coalesce_addr(lane), rl = lane >> 2, cl = lane & 3;
        const int rowdst = u.pm * BM + wr * 64 + rl, col0 = u.pn * BM + wc * 32 + 8 * cl;
#pragma unroll
        for (int ai = 0; ai < 2; ++ai)
#pragma unroll
            for (int m = 0; m < 4; ++m) { bf16_t* rowp = Z + (size_t)(rowdst + ai * HALF + m * 16) * ZW + col0;
#pragma unroll
                for (int bj = 0; bj < 2; ++bj) { const f32x4 v0 = acc[ai][bj][m][0], v1 = acc[ai][bj][m][1];
                    *(u32x4*)(rowp + bj * HALF) = coalesce16(pack8(v0, v1), pa);
                    float s = (v0[0] * v0[0] + v0[1] * v0[1]) + (v0[2] * v0[2] + v0[3] * v0[3]) + (v1[0] * v1[0] + v1[1] * v1[1]) + (v1[2] * v1[2] + v1[3] * v1[3]);
                    s += __shfl_xor(s, 16); s += __shfl_xor(s, 32);
                    if (fq == 0) red[((wr * 16 + (ai * 4 + m) * 2 + bj) * 4 + wc) * 16 + fr] = s; } }
        asm volatile("s_waitcnt lgkmcnt(0)" ::: "memory"); __builtin_amdgcn_s_barrier(); asm volatile("" ::: "memory");
        { const int widx = wr * 4 + wc, idx = widx * 64 + lane;
          const int wr2 = idx >> 8, step = (idx >> 4) & 15, r16 = idx & 15; const int ai = step >> 3, m = (step >> 1) & 3, bj = step & 1;
          const LAS float* rp = red + ((wr2 * 16 + step) * 4) * 16 + r16;
          const float s = (rp[0] + rp[16]) + (rp[32] + rp[48]);
          const int hb = 2 * u.pn + bj;
          const int row = u.pm * BM + wr2 * 64 + ai * HALF + m * 16 + r16;
          if (hb < 5) atomicAdd((hb < 3 ? ssq : sskv) + row, s); }
    }
};
struct EpiQ {
    static constexpr bool PERM = true;
    bf16_t* Q; const LAS float* rsl; const LAS float* ropel;
    __device__ __forceinline__ void operator()(EPI_ARGS) const {
        int row0 = u.pm * BM + wr * 64 + fr;
        asm volatile("" : "+v"(row0));
        float rsv[2][4];
#pragma unroll
        for (int ai = 0; ai < 2; ++ai)
#pragma unroll
            for (int m = 0; m < 4; ++m) rsv[ai][m] = rsl[u.idx * 256 + wr * 64 + fr + ai * HALF + m * 16];
        const int lane = fq * 16 + fr, pa = coalesce_addr(lane);
#pragma unroll
        for (int bj = 0; bj < 2; ++bj) {
            const int c0 = u.pn * BM + bj * HALF + wc * 32 + 8 * fq; const int h = c0 / DQK, dd = c0 - h * DQK;
            const bool isrope = dd >= 64; const int axis = (dd - 64) >> 4;
            const int cd = u.pn * BM + bj * HALF + wc * 32 + 8 * (lane & 3); const int hd = cd / DQK, ddd = cd - hd * DQK;
            bf16_t* qbase = Q + (size_t)hd * TL * DQK + ddd;
#pragma unroll
            for (int ai = 0; ai < 2; ++ai)
#pragma unroll
                for (int m = 0; m < 4; ++m) { const int row = row0 + ai * HALF + m * 16; const int t = row & (TL - 1);
                    const float rs = rsv[ai][m];
                    f32x4 v0 = acc[ai][bj][m][0] * rs, v1 = acc[ai][bj][m][1] * rs;
                    if (isrope) {
                        const int pos = axis == 0 ? (t >> 6) : (t & 63);
                        const LAS f32x4* cs = (const LAS f32x4*)(ropel + pos * 16);
                        const f32x4 t0 = cs[0], t1 = cs[1], t2 = cs[2], t3 = cs[3];
                        const float cosv[8] = {t0[0], t0[2], t1[0], t1[2], t2[0], t2[2], t3[0], t3[2]}, sinv[8] = {t0[1], t0[3], t1[1], t1[3], t2[1], t2[3], t3[1], t3[3]};
                        const bool second = fq & 1;
#pragma unroll
                        for (int j = 0; j < 4; ++j) { const float p0 = __shfl_xor(v0[j], 16), p1 = __shfl_xor(v1[j], 16);
                            v0[j] = second ? (p0 * sinv[j] + v0[j] * cosv[j]) : (v0[j] * cosv[j] - p0 * sinv[j]);
                            v1[j] = second ? (p1 * sinv[4 + j] + v1[j] * cosv[4 + j]) : (v1[j] * cosv[4 + j] - p1 * sinv[4 + j]); } }
                    { const int rowd = u.pm * BM + wr * 64 + ai * HALF + m * 16 + (lane >> 2); const int bd = rowd / TL, td = rowd - bd * TL;
                      *(u32x4*)(qbase + ((size_t)(bd * NH) * TL + td) * DQK) = coalesce16(pack8(v0, v1), pa); }
                    asm volatile("" ::: "memory"); }
        }
    }
};
struct EpiKV {
    static constexpr bool PERM = true;
    bf16_t* Kc; bf16_t* Vc; const LAS float* rsl;
    __device__ __forceinline__ void operator()(EPI_ARGS) const {
        const int rowt = u.pm * BM; const bool isl = rowt < MLAT;
        const int b = isl ? rowt / TL : (rowt - MLAT) / TCX; const int key0 = isl ? rowt - b * TL : TL + (rowt - MLAT - b * TCX);
        const int lane = fq * 16 + fr, pa = coalesce_addr(lane), rl = lane >> 2, cl = lane & 3;
        const int rsrc = wr * 64 + fr, rdst = wr * 64 + rl; const bool isv = wc >= 2; const int cc = (wc & 1) * 32 + 8 * cl;
#pragma unroll
        for (int ai = 0; ai < 2; ++ai)
#pragma unroll
            for (int m = 0; m < 4; ++m) { const float rs = rsl[u.idx * 256 + rsrc + ai * HALF + m * 16]; const int rd = rdst + ai * HALF + m * 16;
#pragma unroll
                for (int bj = 0; bj < 2; ++bj) { const int h = 2 * u.pn + bj; const size_t kr = (size_t)(b * NH + h) * SKV + key0 + rd;
                    bf16_t* dst = isv ? Vc + kr * DV + cc : Kc + kr * DQK + cc;
                    *(u32x4*)dst = coalesce16(pack8(acc[ai][bj][m][0] * rs, acc[ai][bj][m][1] * rs), pa); } }
    }
};
struct EpiUp {
    static constexpr bool PERM = true;
    bf16_t* HID;
    __device__ __forceinline__ void operator()(EPI_ARGS) const {
        const int lane = fq * 16 + fr, pa = coalesce_addr(lane), rl = lane >> 2, cl = lane & 3;
        const int rowdst = u.pm * BM + wr * 64 + rl, col0 = u.pn * HALF + wc * 32 + 8 * cl;
#pragma unroll
        for (int ai = 0; ai < 2; ++ai)
#pragma unroll
            for (int m = 0; m < 4; ++m) { f32x4 o0, o1;
#pragma unroll
                for (int j = 0; j < 4; ++j) { const float g0 = acc[ai][0][m][0][j], g1 = acc[ai][0][m][1][j];
                    o0[j] = g0 * __builtin_amdgcn_rcpf(1.0f + __builtin_amdgcn_exp2f(-g0)) * acc[ai][1][m][0][j]; o1[j] = g1 * __builtin_amdgcn_rcpf(1.0f + __builtin_amdgcn_exp2f(-g1)) * acc[ai][1][m][1][j]; }
                *(u32x4*)(HID + (size_t)(rowdst + ai * HALF + m * 16) * DEXP + col0) = coalesce16(pack8(o0, o1), pa); }
    }
};
struct EpiDown {
    static constexpr bool PERM = true;
    bf16_t* Y; const float* gatev;
    __device__ __forceinline__ void operator()(EPI_ARGS) const {
        const int lane = fq * 16 + fr, pa = coalesce_addr(lane), rl = lane >> 2, cl = lane & 3;
        const int rowdst = u.pm * BM + wr * 64 + rl, col0 = u.pn * BM + wc * 32 + 8 * cl;
#pragma unroll
        for (int ai = 0; ai < 2; ++ai)
#pragma unroll
            for (int m = 0; m < 4; ++m) { bf16_t* rowp = Y + (size_t)(rowdst + ai * HALF + m * 16) * D + col0;
#pragma unroll
                for (int bj = 0; bj < 2; ++bj) *(u32x4*)(rowp + bj * HALF) = coalesce16(pack8(acc[ai][bj][m][0], acc[ai][bj][m][1]), pa); }
    }
};
}


#define XB_TMO      128
#define XB_XCNT(j)  (256  + 64 * (j))
#define XB_XSUB(j)  (1280 + 64 * (j))
#define XB_XGEN(j)  (2304 + 64 * (j))
#define XB_TOP      3328
#define XB_TOPGEN   3392
#define XCD_BAR_WORDS 3456
#define XB_SPIN_CAP (1u << 20)
__device__ __forceinline__ unsigned xb_ld(unsigned* p)              { return __hip_atomic_load(p, __ATOMIC_RELAXED, __HIP_MEMORY_SCOPE_AGENT); }
__device__ __forceinline__ unsigned xb_add(unsigned* p, unsigned v) { return __hip_atomic_fetch_add(p, v, __ATOMIC_RELAXED, __HIP_MEMORY_SCOPE_AGENT); }
__device__ __forceinline__ unsigned xb_xcc_id() { return (unsigned)__builtin_amdgcn_s_getreg((3 << 11) | 20) & 0xFu; }
#define XB_SPIN(cond, bar) do { unsigned _sp = 0; while (cond) { __builtin_amdgcn_s_sleep(1); \
    if ((++_sp & 255u) == 0u) { if (xb_ld(&(bar)[XB_TMO])) break; if (_sp > XB_SPIN_CAP) { atomicAdd(&(bar)[XB_TMO], 1u); break; } } } } while (0)
struct XcdBarrier { unsigned* bar; unsigned x; volatile LAS unsigned* st; };
__device__ __forceinline__ XcdBarrier xcd_barrier_post(unsigned* bar, volatile LAS unsigned* st) {
    XcdBarrier b; b.bar = bar; b.x = xb_xcc_id(); b.st = st;
    if (threadIdx.x == 0) (void)xb_add(&bar[XB_XCNT(b.x)], 1u);
    return b;
}
__device__ __forceinline__ void xcd_barrier_complete(unsigned* bar, unsigned x, unsigned& nloc, unsigned& nx) {
    const unsigned G = gridDim.x * gridDim.y * gridDim.z;
    unsigned sum, cnt, mine, sp = 0u;
    for (;;) {
        sum = 0u; cnt = 0u; mine = 0u;
#pragma unroll
        for (unsigned j = 0; j < 16; ++j) { const unsigned c = xb_ld(&bar[XB_XCNT(j)]); sum += c; cnt += (c > 0u) ? 1u : 0u; mine = (j == x) ? c : mine; }
        if (sum == G) break;
        __builtin_amdgcn_s_sleep(1);
        if ((++sp & 255u) == 0u) { if (xb_ld(&bar[XB_TMO])) break; if (sp > XB_SPIN_CAP) { atomicAdd(&bar[XB_TMO], 1u); break; } }
    }
    nloc = mine > 0u ? mine : 1u; nx = cnt > 0u ? cnt : 1u;
}
__device__ __forceinline__ void xcd_barrier(const XcdBarrier& b) {
    asm volatile("s_waitcnt vmcnt(0)" ::: "memory");
    __syncthreads();
    if (threadIdx.x == 0) {
        unsigned* bar = b.bar;
        __builtin_amdgcn_s_waitcnt(0);
        unsigned nloc = b.st[0], nx = b.st[1];
        if (nloc == 0u) { xcd_barrier_complete(bar, b.x, nloc, nx); b.st[0] = nloc; b.st[1] = nx; }
        const unsigned old = xb_add(&bar[XB_XSUB(b.x)], 1u);
        const unsigned gen = old / nloc;
        if (old + 1u == (gen + 1u) * nloc) {
            __builtin_amdgcn_fence(__ATOMIC_RELEASE, "agent");
            asm volatile("s_waitcnt vmcnt(0)" ::: "memory");
            const unsigned og = xb_add(&bar[XB_TOP], 1u);
            const unsigned tg = og / nx;
            if (og + 1u == (tg + 1u) * nx) xb_add(&bar[XB_TOPGEN], 1u);
            else XB_SPIN(xb_ld(&bar[XB_TOPGEN]) == tg, bar);
            __builtin_amdgcn_fence(__ATOMIC_ACQUIRE, "agent");
            xb_add(&bar[XB_XGEN(b.x)], 1u);
            asm volatile("s_waitcnt vmcnt(0)" ::: "memory");
        } else {
            XB_SPIN(xb_ld(&bar[XB_XGEN(b.x)]) == gen, bar);
            __builtin_amdgcn_fence(__ATOMIC_ACQUIRE, "agent");
            asm volatile("s_waitcnt vmcnt(0)" ::: "memory");
        }
    }
    __syncthreads();
}

struct Args { const float* in[25]; float* out; unsigned char* ws; int ph_lo, ph_hi; };
enum { I_X = 0, I_C, I_CTX, I_CCTX, I_ADAW, I_ADAB, I_NMIX, I_NFFN, I_NFIN, I_LWIN, I_LCW, I_LCB, I_LGW, I_LGB, I_LLAM, I_LWOUT, I_MWIN, I_MQN, I_MKVN, I_MWUQ, I_MWUKV, I_MWO, I_ROUTER, I_WUP, I_WDN };

struct Frame {
    LAS unsigned char* lds;
    int tid, lane, wave, G, bid;
    const Args* a;
    unsigned char* ws;
};
#define WSP(T, off) ((T*)(F.ws + (off)))

struct TItem { const float* W; bf16_t* WT; const float* ks; int ldw, nvalid, K, k0, n0, drow0; float scale; };
__device__ __forceinline__ TItem titem_decode(const Args& A, unsigned char* ws, int it) {
    constexpr int J0 = 32 * 16 * 32, J1 = 32 * 16 * 16, J2 = 16 * 32, J3 = 16 * 16, J4 = 16 * 12, J5 = 6 * 24, J6 = 4 * 32, J7 = 16 * 16;
    TItem t; t.ks = nullptr; t.scale = 1.0f; int r = it;
    if (r < J0) { const int mat = r / 512, q = r % 512, kb = q / 32, nb = q % 32; const int n0 = nb * 64; const int j = n0 & 1023;
        t.W = A.in[I_WUP] + (size_t)mat * 1024 * 2048; t.ldw = 2048; t.nvalid = 2048; t.WT = (bf16_t*)(ws + WS_WUP) + (size_t)mat * 2048 * 1024; t.K = 1024; t.k0 = kb * 64; t.n0 = n0; t.drow0 = (j >> 7) * 256 + (n0 >= 1024 ? 128 : 0) + (j & 127); t.scale = n0 >= 1024 ? 0.6931471805599453f : 1.4426950408889634f; return t; } r -= J0;
    if (r < J1) { const int mat = r / 256, q = r % 256, kb = q / 16, nb = q % 16;
        t.W = A.in[I_WDN] + (size_t)mat * 1024 * 1024; t.ldw = 1024; t.nvalid = 1024; t.WT = (bf16_t*)(ws + WS_WDN) + (size_t)mat * 1024 * 1024; t.K = 1024; t.k0 = kb * 64; t.n0 = nb * 64; t.drow0 = nb * 64; return t; } r -= J1;
    if (r < J2) { const int kb = r / 32, nb = r % 32; t.W = A.in[I_LWIN]; t.ldw = 2048; t.nvalid = 2048; t.WT = (bf16_t*)(ws + WS_WLIN); t.K = 1024; t.k0 = kb * 64; t.n0 = nb * 64; t.drow0 = nb * 64; return t; } r -= J2;
    if (r < J3) { const int kb = r / 16, nb = r % 16; t.W = A.in[I_LWOUT]; t.ldw = 1024; t.nvalid = 1024; t.WT = (bf16_t*)(ws + WS_WLOUT); t.K = 1024; t.k0 = kb * 64; t.n0 = nb * 64; t.drow0 = nb * 64; return t; } r -= J3;
    if (r < J4) { const int kb = r / 12, nb = r % 12; t.W = A.in[I_MWIN]; t.ldw = 672; t.nvalid = 672; t.WT = (bf16_t*)(ws + WS_WMIN); t.K = 1024; t.k0 = kb * 64; t.n0 = nb * 64; t.drow0 = nb * 64; return t; } r -= J4;
    if (r < J5) { const int kb = r / 24, nb = r % 24; t.W = A.in[I_MWUQ]; t.ldw = 1536; t.nvalid = 1536; t.WT = (bf16_t*)(ws + WS_WUQ); t.K = 384; t.k0 = kb * 64; t.n0 = nb * 64; t.drow0 = nb * 64; t.ks = A.in[I_MQN]; return t; } r -= J5;
    if (r < J6) { const int kb = r / 32, nb = r % 32; t.W = A.in[I_MWUKV]; t.ldw = 2048; t.nvalid = 2048; t.WT = (bf16_t*)(ws + WS_WUKV); t.K = 256; t.k0 = kb * 64; t.n0 = nb * 64; t.drow0 = nb * 64; t.ks = A.in[I_MKVN]; return t; } r -= J6;
    if (r < J7) { const int kb = r / 16, nb = r % 16; t.W = A.in[I_MWO]; t.ldw = 1024; t.nvalid = 1024; t.WT = (bf16_t*)(ws + WS_WO); t.K = 1024; t.k0 = kb * 64; t.n0 = nb * 64; t.drow0 = nb * 64; return t; } r -= J7;
    { const int mat = r / 4, q = r % 4, kb = q / 2, nb = q % 2; const int d = mat >> 4, g = (mat >> 3) & 1, n = mat & 7;
        t.W = A.in[I_LGW] + (size_t)mat * 128 * 128; t.ldw = 128; t.nvalid = 128; t.WT = (bf16_t*)(ws + WS_WG) + (size_t)((d * 8 + n) * 2 + g) * 128 * 128; t.K = 128; t.k0 = kb * 64; t.n0 = nb * 64; t.drow0 = nb * 64; return t; }
}
__device__ __forceinline__ void titem_load(const TItem& t, f32x4 (&v)[16], int lane) {
    const int col = t.n0 + 4 * (lane & 15); const bool ok = col < t.nvalid; const float* p = t.W + (size_t)(t.k0 + (lane >> 4)) * t.ldw + col;
#pragma unroll
    for (int i = 0; i < 16; ++i) v[i] = ok ? *(const f32x4*)(p + (size_t)(4 * i) * t.ldw) : (f32x4){0.f, 0.f, 0.f, 0.f};
}
__device__ __forceinline__ void titem_process(const TItem& t, f32x4 (&v)[16], LAS float* scr, int lane) {
    const int rq = lane >> 4, c4 = 4 * (lane & 15);
#pragma unroll
    for (int i = 0; i < 16; ++i) { f32x4 x = v[i] * t.scale; if (t.ks) x = x * t.ks[t.k0 + 4 * i + rq]; LAS float* d = scr + (4 * i + rq) * 65 + c4; d[0] = x[0]; d[1] = x[1]; d[2] = x[2]; d[3] = x[3]; }
    asm volatile("s_waitcnt lgkmcnt(0)" ::: "memory");
    const int c = lane & 7;
#pragma unroll
    for (int j = 0; j < 8; ++j) { const int n = (lane >> 3) + 8 * j; const LAS float* s = scr + (8 * c) * 65 + n;
        u32x4 o; o.x = cvt_pk_bf16(s[0 * 65], s[1 * 65]); o.y = cvt_pk_bf16(s[2 * 65], s[3 * 65]); o.z = cvt_pk_bf16(s[4 * 65], s[5 * 65]); o.w = cvt_pk_bf16(s[6 * 65], s[7 * 65]);
        *(u32x4*)(t.WT + (size_t)(t.drow0 + n) * t.K + t.k0 + 8 * c) = o; }
    asm volatile("s_waitcnt lgkmcnt(0)" ::: "memory");
}

__device__ __forceinline__ void p0_prologue(Frame& F) {
    const Args& A = *F.a;
    {
        LAS float* sc = (LAS float*)F.lds;
        LAS float* red = (LAS float*)(F.lds + 17 * 1024 * 4);
        bool loaded = false;
        for (int task = F.bid; task < 192; task += F.G) {
            if (!loaded) {
                f32x4 cv[9];
#pragma unroll
                for (int qi = 0; qi < 9; ++qi) { const int g = F.tid + 512 * qi; cv[qi] = g < 4096 ? ((const f32x4*)A.in[I_C])[g] : (g < 4352 ? ((const f32x4*)A.in[I_CCTX])[g - 4096] : (f32x4){0.f, 0.f, 0.f, 0.f}); }
#pragma unroll
                for (int qi = 0; qi < 9; ++qi) { const int g = F.tid + 512 * qi; if (g < 4352) { f32x4 r;
#pragma unroll
                    for (int j = 0; j < 4; ++j) r[j] = cv[qi][j] / (1.0f + __expf(-cv[qi][j]));
                    *(LAS f32x4*)(sc + 4 * g) = r; } }
                loaded = true; __syncthreads(); }
            const int l = task / 96, n0 = (task % 96) * 64; const float* W = A.in[I_ADAW] + (size_t)l * D * 6144;
            f32x4 acc[17];
#pragma unroll
            for (int r = 0; r < 17; ++r) acc[r] = (f32x4){0.f, 0.f, 0.f, 0.f};
            const int kq = F.lane >> 4, c4 = F.lane & 15; const int k0 = F.wave * 128 + kq * 32;
            const float* Wl = W + (size_t)k0 * 6144 + n0 + 4 * c4;
#pragma unroll 1
            for (int kb = 0; kb < 32; kb += 8) { f32x4 wv[8];
#pragma unroll
                for (int kk = 0; kk < 8; ++kk) wv[kk] = *(const f32x4*)(Wl + (size_t)(kb + kk) * 6144);
                asm volatile("" ::: "memory");
#pragma unroll
                for (int k4 = 0; k4 < 2; ++k4) {
#pragma unroll
                    for (int r = 0; r < 17; ++r) { const f32x4 s4 = *(const LAS f32x4*)(sc + r * 1024 + k0 + kb + 4 * k4);
                        acc[r] += wv[4 * k4] * s4[0] + wv[4 * k4 + 1] * s4[1] + wv[4 * k4 + 2] * s4[2] + wv[4 * k4 + 3] * s4[3]; } } }
#pragma unroll
            for (int r = 0; r < 17; ++r) {
#pragma unroll
                for (int j = 0; j < 4; ++j) { float t = acc[r][j]; t += __shfl_xor(t, 16); t += __shfl_xor(t, 32); acc[r][j] = t; }
                if (kq == 0) *(LAS f32x4*)(red + (F.wave * 17 + r) * 64 + 4 * c4) = acc[r]; }
            __syncthreads();
            for (int o = F.tid; o < 17 * 64; o += 512) { const int r = o >> 6, ln = o & 63; float s = A.in[I_ADAB][l * 6144 + n0 + ln];
#pragma unroll
                for (int w = 0; w < 8; ++w) s += red[(w * 17 + r) * 64 + ln];
                WSP(float, WS_MOD)[(size_t)(l * 17 + r) * 6144 + n0 + ln] = s; }
            __syncthreads();
        }
        __syncthreads();
    }
    if (F.bid == F.G - 1) { for (int i = F.tid; i < 512; i += 512) { const int pos = i >> 3, f = i & 7; const float fr = powf(10000.0f, -(float)f / 8.0f); const float ang = (float)pos * fr;
            WSP(float, WS_ROPE)[2 * i] = cosf(ang); WSP(float, WS_ROPE)[2 * i + 1] = sinf(ang); } }
    for (int i = F.bid * 512 + F.tid; i < MT; i += F.G * 512) { WSP(float, WS_SSQ)[i] = 0.f; WSP(float, WS_SSKV)[i] = 0.f; }
#ifdef DUP_P0B
    for (int rep_ = 0; rep_ < 2; ++rep_) {
#else
    {
#endif
    LAS float* scr = (LAS float*)(F.lds + F.wave * 16640);
    const int gw = F.bid * NWAVES + F.wave, NGW = F.G * NWAVES;
    constexpr int NITEMS = 32 * 16 * 32 + 32 * 16 * 16 + 16 * 32 + 16 * 16 + 16 * 12 + 6 * 24 + 4 * 32 + 16 * 16 + 32 * 4;
    if (gw < NITEMS) {
        f32x4 va[16], vb[16];
        TItem ta = titem_decode(A, F.ws, gw); titem_load(ta, va, F.lane);
        for (int it = gw; it < NITEMS; it += 2 * NGW) {
            const bool hb = it + NGW < NITEMS; TItem tb = ta;
            if (hb) { tb = titem_decode(A, F.ws, it + NGW); titem_load(tb, vb, F.lane); }
            titem_process(ta, va, scr, F.lane);
            if (!hb) break;
            const bool ha = it + 2 * NGW < NITEMS;
            if (ha) { ta = titem_decode(A, F.ws, it + 2 * NGW); titem_load(ta, va, F.lane); }
            titem_process(tb, vb, scr, F.lane);
            if (!ha) break;
        }
    }
    }
}

__device__ __forceinline__ void row_load(const float* xrow, int lane, f32x4 (&v)[4]) {
    const f32x4* xr = (const f32x4*)xrow + lane;
#pragma unroll
    for (int j = 0; j < 4; ++j) v[j] = xr[64 * j];
}
__device__ __forceinline__ void row_load_bf16(const bf16_t* xrow, int lane, f32x4 (&v)[4]) {
    const u32x2* xr = (const u32x2*)xrow + lane;
#pragma unroll
    for (int j = 0; j < 4; ++j) { const u32x2 w = xr[64 * j]; v[j] = (f32x4){__uint_as_float(w.x << 16), __uint_as_float(w.x & 0xffff0000u), __uint_as_float(w.y << 16), __uint_as_float(w.y & 0xffff0000u)}; }
}
__device__ __forceinline__ float row_rs(const f32x4 (&v)[4]) {
    float s = 0.f;
#pragma unroll
    for (int j = 0; j < 4; ++j) s += (v[j][0] * v[j][0] + v[j][1] * v[j][1]) + (v[j][2] * v[j][2] + v[j][3] * v[j][3]);
    return rsqrtf(wave_sum(s) * (1.0f / D) + EPS);
}
__device__ __forceinline__ void row_modulate(f32x4 (&v)[4], float rs, const float* gamma, const float* shift, const float* scale, int lane) {
#pragma unroll
    for (int j = 0; j < 4; ++j) { const f32x4 g = ((const f32x4*)gamma)[lane + 64 * j], sh = ((const f32x4*)shift)[lane + 64 * j], sc = ((const f32x4*)scale)[lane + 64 * j];
        v[j] = v[j] * rs * g * (sc + 1.0f) + sh; }
}
__device__ __forceinline__ void row_store_bf16(const f32x4 (&v)[4], bf16_t* orow, int lane) {
    u32x2* o8 = (u32x2*)orow + lane;
#pragma unroll
    for (int j = 0; j < 4; ++j) { u32x2 w; w.x = cvt_pk_bf16(v[j][0], v[j][1]); w.y = cvt_pk_bf16(v[j][2], v[j][3]); o8[64 * j] = w; }
}
__device__ __forceinline__ int row_bidx(int row) { return row < MLAT ? row / TL : 16; }

__device__ __forceinline__ void p_norm_in(Frame& F) {
    const Args& A = *F.a; const int gw = F.bid * NWAVES + F.wave, NGW = F.G * NWAVES;
    const float* mod = WSP(float, WS_MOD);
    const bool bmaj = (F.G == 256);
    const int bq = gw >> 7, sub = gw & 127;
    const int ntr = bmaj ? 18 : (MT - gw + NGW - 1) / NGW;
#define NI_ROW(k_) (bmaj ? ((k_) < 16 ? bq * TL + sub + 128 * (k_) : MLAT + gw + ((k_) - 16) * NGW) : gw + (k_) * NGW)
    f32x4 am[4], bm[4], vn[4]; int curb = -1;
#define NI_PRE(k_) do { if ((k_) < ntr) { const int r_ = NI_ROW(k_); const float* src_ = r_ < MLAT ? A.in[I_X] + (size_t)r_ * D : A.in[I_CTX] + (size_t)(r_ - MLAT) * D; row_load(src_, F.lane, vn); } } while (0)
    NI_PRE(0);
    for (int kt = 0; kt < ntr; ++kt) {
        const int row = NI_ROW(kt);
        f32x4 v[4];
#pragma unroll
        for (int j = 0; j < 4; ++j) v[j] = vn[j];
        NI_PRE(kt + 1);
        const int bidx = row_bidx(row);
        if (bidx != curb) { curb = bidx; const float* m = mod + (size_t)bidx * 6144;
#pragma unroll
            for (int j = 0; j < 4; ++j) { const f32x4 g = ((const f32x4*)A.in[I_NMIX])[F.lane + 64 * j], sh = ((const f32x4*)m)[F.lane + 64 * j], sc = ((const f32x4*)(m + D))[F.lane + 64 * j];
                am[j] = g * (sc + 1.0f); bm[j] = sh; } }
        const float rs = row_rs(v);
#pragma unroll
        for (int j = 0; j < 4; ++j) v[j] = v[j] * rs * am[j] + bm[j];
        row_store_bf16(v, WSP(bf16_t, WS_H) + (size_t)row * D, F.lane);
    }
#undef NI_PRE
#undef NI_ROW
}

__device__ __forceinline__ void p_moe_norm(Frame& F, int layer, int nrows) {
    const Args& A = *F.a; const int gw = F.bid * NWAVES + F.wave, NGW = F.G * NWAVES;
    const float* mod = WSP(float, WS_MOD) + (size_t)layer * 17 * 6144;
    const float* gamma = A.in[I_NFFN] + layer * D;
    const bf16_t* X = WSP(bf16_t, WS_X);
    const bool bmaj = (F.G == 256);
    const int bq = gw >> 7, sub = gw & 127;
    const int ntr = bmaj ? (nrows > MLAT ? 9 : 8) : (nrows / 2 - gw + NGW - 1) / NGW;
#define MN_RG(k_) (bmaj ? ((k_) < 8 ? bq * 1024 + sub + 128 * (k_) : MLAT / 2 + gw) : gw + (k_) * NGW)
    f32x4 am[4], bm[4]; int curb = -1;
    u32x2 xw[2][4];
#define MN_PRE(k_) do { if ((k_) < ntr) { const int rg_ = MN_RG(k_); _Pragma("unroll") for (int r = 0; r < 2; ++r) { const u32x2* xr = (const u32x2*)(X + (size_t)(rg_ * 2 + r) * D) + F.lane; \
        _Pragma("unroll") for (int j = 0; j < 4; ++j) xw[r][j] = xr[64 * j]; } } } while (0)
    MN_PRE(0);
    LAS float* Rl = (LAS float*)F.lds;
    const float* router = A.in[I_ROUTER] + (size_t)layer * D * NE;
    int tid_ = F.tid; asm volatile("" : "+v"(tid_));
    { f32x4 rv[8];
#pragma unroll
      for (int q = 0; q < 8; ++q) rv[q] = ((const f32x4*)router)[tid_ + q * 512];
#pragma unroll
      for (int q = 0; q < 8; ++q) { const int g = tid_ + q * 512, k = g >> 2, c = g & 3; const int j = k >> 8, l = (k & 255) >> 2, i = k & 3;
          *(LAS f32x4*)(Rl + (((j * 4 + i) * 4 + c) * 64 + l) * 4) = rv[q]; } }
    __syncthreads();
    for (int kt = 0; kt < ntr; ++kt) {
        const int rg = MN_RG(kt);
        float y[2][16];
#pragma unroll
        for (int r = 0; r < 2; ++r) { const int row = rg * 2 + r;
            f32x4 v[4];
#pragma unroll
            for (int j = 0; j < 4; ++j) v[j] = (f32x4){__uint_as_float(xw[r][j].x << 16), __uint_as_float(xw[r][j].x & 0xffff0000u), __uint_as_float(xw[r][j].y << 16), __uint_as_float(xw[r][j].y & 0xffff0000u)};
            if (r == 1) MN_PRE(kt + 1);
            const int bidx = row_bidx(row);
            if (bidx != curb) { curb = bidx; const float* m = mod + (size_t)bidx * 6144;
#pragma unroll
                for (int j = 0; j < 4; ++j) { const f32x4 g = ((const f32x4*)gamma)[F.lane + 64 * j], sh = ((const f32x4*)(m + 3 * D))[F.lane + 64 * j], sc = ((const f32x4*)(m + 4 * D))[F.lane + 64 * j];
                    am[j] = g * (sc + 1.0f); bm[j] = sh; } }
            const float rs = row_rs(v);
#pragma unroll
            for (int j = 0; j < 4; ++j) v[j] = v[j] * rs * am[j] + bm[j];
            row_store_bf16(v, WSP(bf16_t, WS_H) + (size_t)row * D, F.lane);
#pragma unroll
            for (int j = 0; j < 4; ++j)
#pragma unroll
                for (int i = 0; i < 4; ++i) y[r][j * 4 + i] = v[j][i];
            asm volatile("" ::: "memory"); }
        float acc[32];
#pragma unroll
        for (int q = 0; q < 32; ++q) acc[q] = 0.f;
#pragma unroll
        for (int ji = 0; ji < 16; ++ji)
#pragma unroll
            for (int c = 0; c < 4; ++c) { const f32x4 w = *(const LAS f32x4*)(Rl + ((ji * 4 + c) * 64 + F.lane) * 4);
#pragma unroll
                for (int r = 0; r < 2; ++r)
#pragma unroll
                    for (int q = 0; q < 4; ++q) acc[r * 16 + c * 4 + q] += y[r][ji] * w[q]; }
#define XDPP(v_, ctrl_, bm_, old_) __builtin_amdgcn_update_dpp(old_, __float_as_int(v_), ctrl_, 0xf, bm_, false)
#pragma unroll
        for (int i = 0; i < 16; ++i) {
            const auto sw = __builtin_amdgcn_permlane16_swap(__float_as_uint(acc[i]), __float_as_uint(acc[i + 16]), false, false);
            acc[i] = __uint_as_float(sw[0]) + __uint_as_float(sw[1]); }
#pragma unroll
        for (int s = 1; s < 5; ++s) { const int half = 16 >> s; const bool up = (F.lane >> (4 - s)) & 1;
#pragma unroll
            for (int i = 0; i < half; ++i) { const float mine = up ? acc[i + half] : acc[i]; const float other = up ? acc[i] : acc[i + half];
                int t;
                if (half == 8) t = XDPP(other, 0x128, 0xf, 0);
                else if (half == 4) { t = XDPP(other, 0x104, 0x5, 0); t = XDPP(other, 0x114, 0xa, t); }
                else if (half == 2) t = XDPP(other, 0x4E, 0xf, 0);
                else t = XDPP(other, 0xB1, 0xf, 0);
                acc[i] = mine + __int_as_float(t); } }
#undef XDPP
        float lg; { const auto sw = __builtin_amdgcn_permlane32_swap(__float_as_uint(acc[0]), __float_as_uint(acc[0]), false, false); lg = __uint_as_float(sw[0]) + __uint_as_float(sw[1]); }
#define R16_DPP(v_, ctrl_) __int_as_float(__builtin_amdgcn_update_dpp(0, __float_as_int(v_), ctrl_, 0xf, 0xf, true))
        float mx = lg;
        mx = fmaxf(mx, R16_DPP(mx, 0xB1)); mx = fmaxf(mx, R16_DPP(mx, 0x4E)); mx = fmaxf(mx, R16_DPP(mx, 0x141)); mx = fmaxf(mx, R16_DPP(mx, 0x140));
        const float ex = __expf(lg - mx); float sm = ex;
        sm += R16_DPP(sm, 0xB1); sm += R16_DPP(sm, 0x4E); sm += R16_DPP(sm, 0x141); sm += R16_DPP(sm, 0x140);
#undef R16_DPP
        const float aff = ex / sm;
        const int row = rg * 2 + ((F.lane >> 4) & 1), e = F.lane & 15;
        if (F.lane < 32) {
            WSP(int, WS_SEL)[(size_t)row * NE + e] = -1;
            if (row < MLAT) { const int b = row / TL, t = row - b * TL; WSP(float, WS_AFFL)[(size_t)(b * NE + e) * TL + t] = aff; }
            else { const int b = (row - MLAT) / TCX, t = (row - MLAT) - b * TCX; WSP(float, WS_AFFC)[(size_t)(b * NE + e) * TCX + t] = aff; } }
    }
}

template <int NPL, int CAP>
__device__ __forceinline__ void topk_unit(Frame& F, const float* aff  , int tokrow0, int moerow0, int e) {
    unsigned v[NPL];
    const unsigned* p = (const unsigned*)aff + F.lane * NPL;
#pragma unroll
    for (int i = 0; i < NPL; i += 4) { const u32x4 q = *(const u32x4*)(p + i); v[i] = q.x; v[i + 1] = q.y; v[i + 2] = q.z; v[i + 3] = q.w; }
    unsigned prefix = 0u;
    for (int bit = 30; bit >= 0; --bit) { const unsigned cand = prefix | (1u << bit); int c4[4] = {0, 0, 0, 0};
#pragma unroll
        for (int i = 0; i < NPL; ++i) c4[i & 3] += (v[i] >= cand) ? 1 : 0;
        const int cnt = wave_isum_dpp((c4[0] + c4[1]) + (c4[2] + c4[3])); if (cnt >= CAP) prefix = cand; }
    int cg_ = 0, ce = 0;
#pragma unroll
    for (int i = 0; i < NPL; ++i) { cg_ += (v[i] > prefix) ? 1 : 0; ce += (v[i] == prefix) ? 1 : 0; }
    const int need = CAP - wave_isum_dpp(cg_);
    int eq_before = ce;
    eq_before = wave_iscan_dpp(eq_before);
    eq_before -= ce;
    int nsel = 0, eqi = eq_before; unsigned long long selmask = 0ull;
#pragma unroll
    for (int i = 0; i < NPL; ++i) { bool s = v[i] > prefix; if (v[i] == prefix) { s = eqi < need; ++eqi; } if (s) { selmask |= (1ull << i); ++nsel; } }
    int slot = nsel;
    slot = wave_iscan_dpp(slot);
    slot -= nsel;
    int* rowidx = WSP(int, WS_ROWIDX); float* gatev = WSP(float, WS_GATEV); int* sel = WSP(int, WS_SEL);
#pragma unroll
    for (int i = 0; i < NPL; ++i) { const int trow = tokrow0 + F.lane * NPL + i; const bool s = (selmask >> i) & 1ull;
        if (s) { const int mr = moerow0 + slot; rowidx[mr] = trow; gatev[mr] = __uint_as_float(v[i]); sel[(size_t)trow * NE + e] = mr; ++slot; } }
}
__device__ __forceinline__ void p_topk(Frame& F, bool with_ctx) {
    const int nunits = with_ctx ? 512 : 256;
    for (int u = F.wave * F.G + F.bid; u < nunits; u += NWAVES * F.G) {
        if (u < 256) { const int b = u >> 4, e = u & 15; topk_unit<32, CAPL>(F, WSP(float, WS_AFFL) + (size_t)(b * NE + e) * TL, b * TL, (e * NB + b) * CAPL, e); }
        else { const int uu = u - 256, b = uu >> 4, e = uu & 15; topk_unit<4, CAPC>(F, WSP(float, WS_AFFC) + (size_t)(b * NE + e) * TCX, MLAT + b * TCX, MOE_LAT_ROWS + (e * NB + b) * CAPC, e); }
    }
}

__device__ __forceinline__ void p_combine(Frame& F, int layer, bool final_) {
    const Args& A = *F.a; const int gw = F.bid * NWAVES + F.wave, NGW = F.G * NWAVES;
    const int nrows = final_ ? MLAT : MT;
    const float* mod = WSP(float, WS_MOD);
    const int* sel = WSP(int, WS_SEL); const bf16_t* Y = WSP(bf16_t, WS_Y); bf16_t* X = WSP(bf16_t, WS_X); const float* gatev = WSP(float, WS_GATEV);
    const bool bmaj = (F.G == 256);
    const int bq = gw >> 7, sub = gw & 127;
    const int ntr = bmaj ? (final_ ? 8 : 9) : (nrows - gw + 2 * NGW - 1) / (2 * NGW);
#define CMB_R0(k_) (bmaj ? ((k_) < 8 ? bq * TL + sub + 128 * (k_) : MLAT + gw) : gw + (k_) * 2 * NGW)
#define CMB_OFF(k_) (bmaj ? ((k_) < 8 ? TL / 2 : NGW) : NGW)
    u32x2 xw[2][4]; int myr[2] = {-1, -1};
#pragma unroll
    for (int p = 0; p < 2; ++p)
#pragma unroll
        for (int j = 0; j < 4; ++j) xw[p][j] = (u32x2){0u, 0u};
#define CMB_PRE(k_) do { _Pragma("unroll") for (int p = 0; p < 2; ++p) { const int r_ = CMB_R0(k_) + p * CMB_OFF(k_); if ((k_) < ntr && r_ < nrows) { const u32x2* xr = (const u32x2*)(X + (size_t)r_ * D) + F.lane; \
        _Pragma("unroll") for (int j = 0; j < 4; ++j) xw[p][j] = xr[64 * j]; myr[p] = sel[(size_t)r_ * NE + (F.lane & 15)]; } else myr[p] = -1; } } while (0)
    f32x4 g2v[4], am[4], bm[4]; int curb = -1;
    CMB_PRE(0);
    for (int kt = 0; kt < ntr; ++kt) {
        const int row = CMB_R0(kt), poff = CMB_OFF(kt);
        f32x4 v[2][4], s[2][4]; int myc[2]; unsigned long long mask[2];
#pragma unroll
        for (int p = 0; p < 2; ++p) { myc[p] = myr[p];
#pragma unroll
            for (int j = 0; j < 4; ++j) { v[p][j] = (f32x4){__uint_as_float(xw[p][j].x << 16), __uint_as_float(xw[p][j].x & 0xffff0000u), __uint_as_float(xw[p][j].y << 16), __uint_as_float(xw[p][j].y & 0xffff0000u)};
                s[p][j] = (f32x4){0.f, 0.f, 0.f, 0.f}; } }
        CMB_PRE(kt + 1);
#pragma unroll
        for (int p = 0; p < 2; ++p) mask[p] = __ballot(myc[p] >= 0) & 0xffffull;
        while (mask[0] | mask[1]) {
            int mr[2][4]; u32x2 w[2][4][4]; float gq[2][4];
#pragma unroll
            for (int p = 0; p < 2; ++p)
#pragma unroll
                for (int q = 0; q < 4; ++q) { if (mask[p]) { const int e = __builtin_ctzll(mask[p]); mask[p] &= mask[p] - 1; mr[p][q] = __builtin_amdgcn_readlane(myc[p], e); } else mr[p][q] = -1; }
#pragma unroll
            for (int p = 0; p < 2; ++p)
#pragma unroll
                for (int q = 0; q < 4; ++q) { if (mr[p][q] >= 0) { const u32x2* yr = (const u32x2*)(Y + (size_t)mr[p][q] * D) + F.lane; gq[p][q] = gatev[mr[p][q]];
#pragma unroll
                    for (int j = 0; j < 4; ++j) w[p][q][j] = yr[64 * j]; } else { gq[p][q] = 0.f;
#pragma unroll
                    for (int j = 0; j < 4; ++j) w[p][q][j] = (u32x2){0u, 0u}; } }
#pragma unroll
            for (int p = 0; p < 2; ++p)
#pragma unroll
                for (int q = 0; q < 4; ++q)
#pragma unroll
                    for (int j = 0; j < 4; ++j) { const float g_ = gq[p][q]; s[p][j][0] += g_ * __uint_as_float(w[p][q][j].x << 16); s[p][j][1] += g_ * __uint_as_float(w[p][q][j].x & 0xffff0000u);
                        s[p][j][2] += g_ * __uint_as_float(w[p][q][j].y << 16); s[p][j][3] += g_ * __uint_as_float(w[p][q][j].y & 0xffff0000u); }
        }
#pragma unroll
        for (int p = 0; p < 2; ++p) { const int r = row + p * poff;
            if (r < nrows) {
                const int bidx = row_bidx(r);
                if (bidx != curb) { curb = bidx;
                    const float* m0 = mod + (size_t)(layer * 17 + bidx) * 6144; const float* m1 = mod + (size_t)(17 + bidx) * 6144;
#pragma unroll
                    for (int j = 0; j < 4; ++j) { g2v[j] = ((const f32x4*)(m0 + 5 * D))[F.lane + 64 * j];
                        if (!final_) { const f32x4 g = ((const f32x4*)(A.in[I_NMIX] + D))[F.lane + 64 * j], sh = ((const f32x4*)m1)[F.lane + 64 * j], sc = ((const f32x4*)(m1 + D))[F.lane + 64 * j];
                            am[j] = g * (sc + 1.0f); bm[j] = sh; }
                        else { am[j] = ((const f32x4*)A.in[I_NFIN])[F.lane + 64 * j]; bm[j] = (f32x4){0.f, 0.f, 0.f, 0.f}; } } }
#pragma unroll
                for (int j = 0; j < 4; ++j) v[p][j] = v[p][j] + g2v[j] * s[p][j];
                if (!final_) {
                    row_store_bf16(v[p], X + (size_t)r * D, F.lane);
                    const float rs = row_rs(v[p]);
#pragma unroll
                    for (int j = 0; j < 4; ++j) v[p][j] = v[p][j] * rs * am[j] + bm[j];
                    row_store_bf16(v[p], WSP(bf16_t, WS_H) + (size_t)r * D, F.lane);
                } else {
                    const float rs = row_rs(v[p]); f32x4* o = (f32x4*)(A.out + (size_t)r * D) + F.lane;
#pragma unroll
                    for (int j = 0; j < 4; ++j) o[64 * j] = v[p][j] * rs * am[j];
                } } }
    }
#undef CMB_PRE
#undef CMB_R0
#undef CMB_OFF
}

__device__ __forceinline__ void p_scan(Frame& F) {
    const Args& A = *F.a;
    const int tid = F.tid, dir = tid >> 8, lt = tid & 255, wv = (tid >> 6) & 3, lane = F.lane, cl = lane & 15, q = lane >> 4;
    constexpr int RS = 68;
    LAS unsigned char* base = F.lds + dir * 51200;
    LAS unsigned char* At = base;
    LAS float* UX = (LAS float*)(base + 16384);
    LAS float* AY = (LAS float*)(base + 16384 + 17408);
    LAS float* CW = (LAS float*)(F.lds + 102400);
    const bf16_t* ZX = WSP(bf16_t, WS_ZX); const bf16_t* Gb = WSP(bf16_t, WS_G); bf16_t* YG = WSP(bf16_t, WS_YG);
    constexpr float L2E = 1.4426950408889634f;
    for (int u = F.bid; u < 256; u += F.G) {
        const int b = u >> 4, n = (u & 15) >> 1, half = u & 1; const int cb = n * 128 + half * 64;
        __syncthreads();
        for (int i = tid; i < 640; i += 512) CW[i] = i < 512 ? A.in[I_LCW][(i >> 7) * D + n * 128 + (i & 127)] : A.in[I_LCB][n * 128 + (i - 512)];
        bf16x8 bw[2][4];
        { const bf16_t* wg = WSP(bf16_t, WS_WG) + (size_t)((dir * 8 + n) * 2) * 128 * 128;
#pragma unroll
          for (int g = 0; g < 2; ++g)
#pragma unroll
            for (int ks = 0; ks < 4; ++ks) bw[g][ks] = *(const bf16x8*)(wg + (size_t)g * 128 * 128 + (half * 64 + 16 * wv + cl) * 128 + ks * 32 + q * 8); }
        const int chl = 16 * wv + cl;
        const float bias0 = A.in[I_LGB][(dir * 2 + 0) * D + cb + chl] * (-L2E), bias1 = A.in[I_LGB][(dir * 2 + 1) * D + cb + chl] * (-L2E);
        float sp8l; { const float lam = A.in[I_LLAM][dir * D + cb + chl]; sp8l = 8.0f * log1pf(__expf(-lam)) * L2E; }
        float hcar = 0.f;
        __syncthreads();
        const int o = lt & 15, tq = lt >> 4;
        float w[4][8], bsv[8];
#pragma unroll
        for (int k = 0; k < 4; ++k) { const f32x4 w0 = *(const LAS f32x4*)(CW + k * 128 + 8 * o), w1 = *(const LAS f32x4*)(CW + k * 128 + 8 * o + 4);
#pragma unroll
            for (int j = 0; j < 4; ++j) { w[k][j] = w0[j]; w[k][4 + j] = w1[j]; } }
        { const f32x4 b0 = *(const LAS f32x4*)(CW + 512 + 8 * o), b1 = *(const LAS f32x4*)(CW + 512 + 8 * o + 4);
#pragma unroll
          for (int j = 0; j < 4; ++j) { bsv[j] = b0[j]; bsv[4 + j] = b1[j]; } }
        const int sh16 = (q >= 1 ? lane - 16 : lane) << 2, sh32 = (q >= 2 ? lane - 32 : lane) << 2, shtot = (cl + 48) << 2;
        u32x4 z[7];
#define SCAN_GEOM(it_, c_, t0_, L_, rowbase_, first_) const bool isctx_##it_ = (it_) < 4; const int ci_##it_ = isctx_##it_ ? (it_) : (it_) - 4, nch_##it_ = isctx_##it_ ? 4 : 32; \
        const int c_ = dir == 0 ? ci_##it_ : nch_##it_ - 1 - ci_##it_; const int t0_ = c_ * 64, L_ = isctx_##it_ ? TCX : TL; const int rowbase_ = isctx_##it_ ? MLAT + b * TCX : b * TL; \
        const bool first_ = dir == 0 ? (c_ < nch_##it_ / 2) : (c_ >= nch_##it_ / 2);
#define SCAN_ZLOAD(t0_, L_, rowbase_) do { _Pragma("unroll") for (int r = 0; r < 7; ++r) { const int t = (t0_) + 4 * tq - 2 + r; \
        z[r] = (t >= 0 && t < (L_)) ? *(const u32x4*)(ZX + (size_t)((rowbase_) + t) * D + n * 128 + 8 * o) : (u32x4){0u, 0u, 0u, 0u}; } } while (0)
        { SCAN_GEOM(0, c0, t00, L0, rb0, f0) (void)f0; SCAN_ZLOAD(t00, L0, rb0); }
        for (int it = 0; it < 36; ++it) {
            SCAN_GEOM(it, c, t0, L, rowbase, first)
            {
#pragma unroll
              for (int tt = 0; tt < 4; ++tt) { float xc[8];
#pragma unroll
                  for (int j = 0; j < 8; ++j) xc[j] = bsv[j];
#pragma unroll
                  for (int k = 0; k < 4; ++k) { const u32x4 zz = z[tt + k]; const unsigned zw[4] = {zz.x, zz.y, zz.z, zz.w};
#pragma unroll
                      for (int j = 0; j < 4; ++j) { xc[2 * j] += w[k][2 * j] * __uint_as_float(zw[j] << 16); xc[2 * j + 1] += w[k][2 * j + 1] * __uint_as_float(zw[j] & 0xffff0000u); } }
                  const int tl = 4 * tq + tt, rr = dir == 0 ? tl : 63 - tl;
                  u32x4 pk; pk.x = cvt_pk_bf16(xc[0], xc[1]); pk.y = cvt_pk_bf16(xc[2], xc[3]); pk.z = cvt_pk_bf16(xc[4], xc[5]); pk.w = cvt_pk_bf16(xc[6], xc[7]);
                  *(LAS u32x4*)(At + rr * 256 + ((16 * o) ^ ((rr & 7) << 4))) = pk;
                  if ((o >> 3) == half) { LAS f32x4* ux = (LAS f32x4*)(UX + rr * RS + 8 * (o & 7)); ux[0] = (f32x4){xc[0], xc[1], xc[2], xc[3]}; ux[1] = (f32x4){xc[4], xc[5], xc[6], xc[7]}; } } }
            if (it + 1 < 36) { const int itn = it + 1; SCAN_GEOM(itn, cn, t0n, Ln, rbn, fn) (void)fn; (void)cn; SCAN_ZLOAD(t0n, Ln, rbn); }
            __syncthreads();
            u32x4 ps[2]; u32x4 pg[2];
#pragma unroll
            for (int qq = 0; qq < 2; ++qq) { const int item = lt + 256 * qq, tl = item >> 3, oc = item & 7; const size_t off = (size_t)(rowbase + t0 + tl) * D + cb + 8 * oc;
                if (!first) { ps[qq] = *(const u32x4*)(YG + off); pg[qq] = *(const u32x4*)(Gb + off); }
                else { ps[qq] = (u32x4){0u, 0u, 0u, 0u}; pg[qq] = ps[qq]; } }
            { f32x4 ga[2][4];
#pragma unroll
              for (int g = 0; g < 2; ++g)
#pragma unroll
                for (int mf = 0; mf < 4; ++mf) ga[g][mf] = (f32x4){0.f, 0.f, 0.f, 0.f};
#pragma unroll
              for (int mf = 0; mf < 4; ++mf)
#pragma unroll
                for (int ks = 0; ks < 4; ++ks) { const int row = 16 * mf + cl; const int colb = ks * 64 + q * 16;
                    const bf16x8 af = *(const LAS bf16x8*)(At + row * 256 + (colb ^ ((row & 7) << 4)));
                    ga[0][mf] = __builtin_amdgcn_mfma_f32_16x16x32_bf16(af, bw[0][ks], ga[0][mf], 0, 0, 0);
                    ga[1][mf] = __builtin_amdgcn_mfma_f32_16x16x32_bf16(af, bw[1][ks], ga[1][mf], 0, 0, 0); }
#pragma unroll
              for (int mf = 0; mf < 4; ++mf) {
#pragma unroll
                for (int rg = 0; rg < 4; ++rg) { const int row = 16 * mf + 4 * q + rg;
                    const float r = __builtin_amdgcn_rcpf(1.0f + __builtin_amdgcn_exp2f(ga[0][mf][rg] * (-L2E) + bias0)), ig = __builtin_amdgcn_rcpf(1.0f + __builtin_amdgcn_exp2f(ga[1][mf][rg] * (-L2E) + bias1));
                    const float av = __builtin_amdgcn_exp2f(-sp8l * r); const float mlt = __builtin_amdgcn_sqrtf(1.0f - av * av);
                    ga[0][mf][rg] = av; ga[1][mf][rg] = mlt * ig * UX[row * RS + chl]; }
#pragma unroll
                for (int rg = 1; rg < 4; ++rg) { ga[1][mf][rg] = ga[0][mf][rg] * ga[1][mf][rg - 1] + ga[1][mf][rg]; ga[0][mf][rg] = ga[0][mf][rg - 1] * ga[0][mf][rg]; } }
              float s = hcar;
#pragma unroll
              for (int mf = 0; mf < 4; ++mf) { float Ai = ga[0][mf][3], Hi = ga[1][mf][3];
#define BPERM(a_, v_) __int_as_float(__builtin_amdgcn_ds_bpermute((a_), __float_as_int(v_)))
                  { const float Ap = BPERM(sh16, Ai), Hp = BPERM(sh16, Hi); if (q >= 1) { Hi = Ai * Hp + Hi; Ai = Ai * Ap; } }
                  { const float Ap = BPERM(sh32, Ai), Hp = BPERM(sh32, Hi); if (q >= 2) { Hi = Ai * Hp + Hi; Ai = Ai * Ap; } }
                  const float ea = BPERM(sh16, Ai), eh = BPERM(sh16, Hi); const float Aex = q >= 1 ? ea : 1.0f, Hex = q >= 1 ? eh : 0.0f;
                  const float Ab = BPERM(shtot, Ai), Hb = BPERM(shtot, Hi);
#undef BPERM
                  const float hin = Aex * s + Hex;
#pragma unroll
                  for (int rg = 0; rg < 4; ++rg) AY[(16 * mf + 4 * q + rg) * RS + chl] = ga[0][mf][rg] * hin + ga[1][mf][rg];
                  s = Ab * s + Hb; }
              hcar = s; }
            __syncthreads();
#pragma unroll
            for (int qq = 0; qq < 2; ++qq) { const int item = lt + 256 * qq, tl = item >> 3, oc = item & 7, rr = dir == 0 ? tl : 63 - tl; const size_t off = (size_t)(rowbase + t0 + tl) * D + cb + 8 * oc;
                const f32x4 y0 = *(const LAS f32x4*)(AY + rr * RS + 8 * oc), y1 = *(const LAS f32x4*)(AY + rr * RS + 8 * oc + 4);
                if (first) { *(u32x4*)(YG + off) = pg8::pack8(y0, y1); }
                else { const u32x4 pw = ps[qq]; const u32x4 gg = pg[qq];
                    const f32x4 p0 = {__uint_as_float(pw.x << 16), __uint_as_float(pw.x & 0xffff0000u), __uint_as_float(pw.y << 16), __uint_as_float(pw.y & 0xffff0000u)};
                    const f32x4 p1 = {__uint_as_float(pw.z << 16), __uint_as_float(pw.z & 0xffff0000u), __uint_as_float(pw.w << 16), __uint_as_float(pw.w & 0xffff0000u)};
                    f32x4 o0, o1; o0[0] = (p0[0] + y0[0]) * __uint_as_float(gg.x << 16); o0[1] = (p0[1] + y0[1]) * __uint_as_float(gg.x & 0xffff0000u); o0[2] = (p0[2] + y0[2]) * __uint_as_float(gg.y << 16); o0[3] = (p0[3] + y0[3]) * __uint_as_float(gg.y & 0xffff0000u);
                    o1[0] = (p1[0] + y1[0]) * __uint_as_float(gg.z << 16); o1[1] = (p1[1] + y1[1]) * __uint_as_float(gg.z & 0xffff0000u); o1[2] = (p1[2] + y1[2]) * __uint_as_float(gg.w << 16); o1[3] = (p1[3] + y1[3]) * __uint_as_float(gg.w & 0xffff0000u);
                    *(u32x4*)(YG + off) = pg8::pack8(o0, o1); } }
        }
#undef SCAN_GEOM
#undef SCAN_ZLOAD
    }
    __syncthreads();
}

__device__ __forceinline__ void p_krope(Frame& F) {
    const bf16_t* Z = WSP(bf16_t, WS_Z); bf16_t* KRb = WSP(bf16_t, WS_YG + 16 * MiB); const float* rope = WSP(float, WS_ROPE);
    for (int row = F.bid * 512 + F.tid; row < MT; row += F.G * 512) {
        const bool isl = row < MLAT;
        const int b = isl ? row / TL : (row - MLAT) / TCX; const int t = isl ? row - b * TL : (row - MLAT) - b * TCX; const int key = isl ? t : TL + t;
        const u32x4* zp = (const u32x4*)(Z + (size_t)row * ZW + 640);
        float x[32];
#pragma unroll
        for (int q = 0; q < 4; ++q) { const u32x4 w = zp[q]; const unsigned ww[4] = {w.x, w.y, w.z, w.w};
#pragma unroll
            for (int i = 0; i < 4; ++i) { x[8 * q + 2 * i] = __uint_as_float(ww[i] << 16); x[8 * q + 2 * i + 1] = __uint_as_float(ww[i] & 0xffff0000u); } }
        if (isl) {
#pragma unroll
            for (int ax = 0; ax < 2; ++ax) { const int pos = ax == 0 ? (t >> 6) : (t & 63);
#pragma unroll
                for (int f = 0; f < 8; ++f) { const float cs = rope[(pos * 8 + f) * 2], sn = rope[(pos * 8 + f) * 2 + 1]; const float x1 = x[ax * 16 + f], x2 = x[ax * 16 + 8 + f];
                    x[ax * 16 + f] = x1 * cs - x2 * sn; x[ax * 16 + 8 + f] = x1 * sn + x2 * cs; } } }
        u32x4* kp = (u32x4*)(KRb + ((size_t)b * SKV + key) * 32);
#pragma unroll
        for (int q = 0; q < 4; ++q) { u32x4 w; w.x = cvt_pk_bf16(x[8 * q], x[8 * q + 1]); w.y = cvt_pk_bf16(x[8 * q + 2], x[8 * q + 3]); w.z = cvt_pk_bf16(x[8 * q + 4], x[8 * q + 5]); w.w = cvt_pk_bf16(x[8 * q + 6], x[8 * q + 7]);
            kp[q] = w; }
    }
}

namespace att {
constexpr int KVBLK = 64, QBLK = 32;
constexpr int SHM_K = KVBLK * 256, SHM_V = KVBLK * DV * 2;
constexpr float THRL = 8.0f;
#define KSWZ(row, colB) ((row) * 256 + ((colB) ^ (((row) & 7) << 4)))
#define SBAR() __builtin_amdgcn_sched_barrier(0)
__device__ __forceinline__ int crow(int r, int hi) { return (r & 3) + 8 * (r >> 2) + 4 * hi; }
__device__ __forceinline__ void partialSM(f32x16& p0, f32x16& p1, float& m_ref, unsigned& q6x, float& alpha, bool first, int hi) {
    float pmax = p0[0];
#pragma unroll
    for (int r = 1; r < 16; ++r) pmax = fmaxf(pmax, p0[r]);
#pragma unroll
    for (int r = 0; r < 16; ++r) pmax = fmaxf(pmax, p1[r]);
    { auto rr = __builtin_amdgcn_permlane32_swap(__float_as_uint(pmax), __float_as_uint(pmax), false, false); pmax = fmaxf(__uint_as_float(rr[0]), __uint_as_float(rr[1])); }
    if (__builtin_expect(!first && __all(pmax <= THRL), 1)) { alpha = 1.f; }
    else { const float dl = first ? pmax : fmaxf(pmax, 0.f);
        const float mnew = __uint_as_float(cvt_pk_bf16(m_ref + dl, 0.f) << 16);
        const float delta = mnew - m_ref;
#pragma unroll
        for (int r = 0; r < 16; ++r) { p0[r] -= delta; p1[r] -= delta; }
        alpha = first ? 1.f : __builtin_amdgcn_exp2f(-delta); m_ref = mnew;
        q6x = hi == 0 ? ((__float_as_uint(-mnew) >> 16) & 0xffffu) : 0u; }
#pragma unroll
    for (int r = 0; r < 16; ++r) p0[r] = __builtin_amdgcn_exp2f(p0[r]);
}
__device__ __forceinline__ void finishSM(f32x16& p0, f32x16& p1, bf16x8& pa0, bf16x8& pa1, bf16x8& pa2, bf16x8& pa3) {
#pragma unroll
    for (int r = 0; r < 16; ++r) p1[r] = __builtin_amdgcn_exp2f(p1[r]);
#define PK4(P, BASE, OUT) do { unsigned a0 = cvt_pk_bf16(P[BASE + 0], P[BASE + 1]), a1 = cvt_pk_bf16(P[BASE + 2], P[BASE + 3]);   \
    unsigned b0 = cvt_pk_bf16(P[BASE + 4], P[BASE + 5]), b1 = cvt_pk_bf16(P[BASE + 6], P[BASE + 7]);                              \
    auto r0 = __builtin_amdgcn_permlane32_swap(a0, b0, false, false); auto r1 = __builtin_amdgcn_permlane32_swap(a1, b1, false, false); \
    u32x4 w = {r0[0], r1[0], r0[1], r1[1]}; OUT = *reinterpret_cast<bf16x8*>(&w); } while (0)
    PK4(p0, 0, pa0); PK4(p0, 8, pa1); PK4(p1, 0, pa2); PK4(p1, 8, pa3);
#undef PK4
}
__device__ __forceinline__ void qkt(f32x16& p0, f32x16& p1, const char* Ks, const bf16x8* qr, unsigned q6x, int r32, int hi) {
    p0 = f32x16{}; p1 = f32x16{};
#pragma unroll
    for (int d0 = 0; d0 < 6; ++d0) { const int cb = (d0 * 16 + hi * 8) * 2;
        const bf16x8 b0 = *reinterpret_cast<const bf16x8*>(Ks + KSWZ(r32, cb));
        const bf16x8 b1 = *reinterpret_cast<const bf16x8*>(Ks + KSWZ(32 + r32, cb));
        p0 = __builtin_amdgcn_mfma_f32_32x32x16_bf16(b0, qr[d0], p0, 0, 0, 0);
        p1 = __builtin_amdgcn_mfma_f32_32x32x16_bf16(b1, qr[d0], p1, 0, 0, 0); }
    { const u32x4 kw = {hi == 0 ? 0x00003F80u : 0u, 0u, 0u, 0u}, qw = {q6x, 0u, 0u, 0u};
      const bf16x8 k6 = *reinterpret_cast<const bf16x8*>(&kw), q6 = *reinterpret_cast<const bf16x8*>(&qw);
      p0 = __builtin_amdgcn_mfma_f32_32x32x16_bf16(k6, q6, p0, 0, 0, 0);
      p1 = __builtin_amdgcn_mfma_f32_32x32x16_bf16(k6, q6, p1, 0, 0, 0); }
}
__device__ __forceinline__ int v_st(int k, int c) { const int kk = (k & ~0xC) | ((k & 4) << 1) | ((k & 8) >> 1); return ((kk >> 3) * 2 + (c >> 5)) * 512 + ((kk & 7) * 32 + (c & 31)) * 2; }
__device__ __forceinline__ int v_rd_base(int lane) { return ((lane & 3) << 3) | (((lane >> 2) & 3) << 6) | (((lane >> 4) & 1) << 5) | (((lane >> 5) & 1) << 8); }
constexpr int v_rd_off(int d0, int ks, int half) { return d0 * 512 + ks * 2048 + half * 1024; }
template <int OFF> __device__ __forceinline__ s16x4 tr_read(int vb) { s16x4 r; asm volatile("ds_read_b64_tr_b16 %0, %1 offset:%2" : "=&v"(r) : "v"(vb), "i"(OFF) : "memory"); return r; }
template <int D0> __device__ __forceinline__ void pv_one(f32x16& od, int vb, bf16x8 pa0, bf16x8 pa1, bf16x8 pa2, bf16x8 pa3) {
    const s16x4 l0 = tr_read<v_rd_off(D0, 0, 0)>(vb), h0 = tr_read<v_rd_off(D0, 0, 1)>(vb), l1 = tr_read<v_rd_off(D0, 1, 0)>(vb), h1 = tr_read<v_rd_off(D0, 1, 1)>(vb);
    const s16x4 l2 = tr_read<v_rd_off(D0, 2, 0)>(vb), h2 = tr_read<v_rd_off(D0, 2, 1)>(vb), l3 = tr_read<v_rd_off(D0, 3, 0)>(vb), h3 = tr_read<v_rd_off(D0, 3, 1)>(vb);
    asm volatile("s_waitcnt lgkmcnt(0)" ::: "memory"); SBAR();
#define PK(L, H) (bf16x8){L[0], L[1], L[2], L[3], H[0], H[1], H[2], H[3]}
    od = __builtin_amdgcn_mfma_f32_32x32x16_bf16(pa0, PK(l0, h0), od, 0, 0, 0);
    od = __builtin_amdgcn_mfma_f32_32x32x16_bf16(pa1, PK(l1, h1), od, 0, 0, 0);
    od = __builtin_amdgcn_mfma_f32_32x32x16_bf16(pa2, PK(l2, h2), od, 0, 0, 0);
    od = __builtin_amdgcn_mfma_f32_32x32x16_bf16(pa3, PK(l3, h3), od, 0, 0, 0);
#undef PK
}
__device__ __forceinline__ void pv_d0(f32x16* o, f32x16& osum, int vb, bf16x8 pa0, bf16x8 pa1, bf16x8 pa2, bf16x8 pa3) {
    pv_one<0>(o[0], vb, pa0, pa1, pa2, pa3); pv_one<1>(o[1], vb, pa0, pa1, pa2, pa3);
    const u32x4 ow = {0x3F803F80u, 0x3F803F80u, 0x3F803F80u, 0x3F803F80u}; const bf16x8 ones = *reinterpret_cast<const bf16x8*>(&ow);
    osum = __builtin_amdgcn_mfma_f32_32x32x16_bf16(pa0, ones, osum, 0, 0, 0);
    osum = __builtin_amdgcn_mfma_f32_32x32x16_bf16(pa1, ones, osum, 0, 0, 0);
    osum = __builtin_amdgcn_mfma_f32_32x32x16_bf16(pa2, ones, osum, 0, 0, 0);
    osum = __builtin_amdgcn_mfma_f32_32x32x16_bf16(pa3, ones, osum, 0, 0, 0);
}

__device__ __forceinline__ void pv_partial(f32x16* o, f32x16& osum, int vb, bf16x8 pa0, bf16x8 pa1, bf16x8 pa2, bf16x8 pa3,
                                           f32x16& p0, f32x16& p1, float& m_ref, unsigned& q6x, float& alpha, int hi) {
    pv_one<0>(o[0], vb, pa0, pa1, pa2, pa3);
    float pmax = p0[0];
#pragma unroll
    for (int r = 1; r < 16; ++r) pmax = fmaxf(pmax, p0[r]);
#pragma unroll
    for (int r = 0; r < 8; ++r) p0[r] = __builtin_amdgcn_exp2f(p0[r]);
    pv_one<1>(o[1], vb, pa0, pa1, pa2, pa3);
#pragma unroll
    for (int r = 8; r < 16; ++r) p0[r] = __builtin_amdgcn_exp2f(p0[r]);
#pragma unroll
    for (int r = 0; r < 16; ++r) pmax = fmaxf(pmax, p1[r]);
    { auto rr = __builtin_amdgcn_permlane32_swap(__float_as_uint(pmax), __float_as_uint(pmax), false, false); pmax = fmaxf(__uint_as_float(rr[0]), __uint_as_float(rr[1])); }
    const u32x4 ow = {0x3F803F80u, 0x3F803F80u, 0x3F803F80u, 0x3F803F80u}; const bf16x8 ones = *reinterpret_cast<const bf16x8*>(&ow);
    osum = __builtin_amdgcn_mfma_f32_32x32x16_bf16(pa0, ones, osum, 0, 0, 0);
    osum = __builtin_amdgcn_mfma_f32_32x32x16_bf16(pa1, ones, osum, 0, 0, 0);
    osum = __builtin_amdgcn_mfma_f32_32x32x16_bf16(pa2, ones, osum, 0, 0, 0);
    osum = __builtin_amdgcn_mfma_f32_32x32x16_bf16(pa3, ones, osum, 0, 0, 0);
    if (__builtin_expect(__all(pmax <= THRL), 1)) { alpha = 1.f; }
    else { const float dl = fmaxf(pmax, 0.f);
        const float mnew = __uint_as_float(cvt_pk_bf16(m_ref + dl, 0.f) << 16);
        const float delta = mnew - m_ref;
        alpha = __builtin_amdgcn_exp2f(-delta); m_ref = mnew;
#pragma unroll
        for (int r = 0; r < 16; ++r) { p0[r] *= alpha; p1[r] -= delta; }
        q6x = hi == 0 ? ((__float_as_uint(-mnew) >> 16) & 0xffffu) : 0u; }
}
__device__ __forceinline__ void attn_units(const bf16_t* __restrict__ Q, const bf16_t* __restrict__ Kc, const bf16_t* __restrict__ Vc, bf16_t* __restrict__ O, int u0, int ustep, int nunits, char* lds, LAS unsigned char* ldsl, const bf16_t* __restrict__ KR) {
    const int tid = threadIdx.x, wid = __builtin_amdgcn_readfirstlane(tid >> 6), lane = tid & 63, r32 = lane & 31, hi = lane >> 5;
    char* V_lds = lds; char* K_lds = lds + 2 * SHM_V;
    float* wsf = (float*)(lds + 2 * SHM_V + 2 * SHM_K) + wid * 64; float* al_l = wsf + 32;
    unsigned kofs[2], vofs;
    unsigned tstr[2]; const char* gkh[2]; const char* gkn[2];
#define KBASE(Kp, arr) do { const size_t b_ = (size_t)((((Kp) - Kc) / (SKV * DQK)) >> 4); _Pragma("unroll") for (int i_ = 0; i_ < 2; ++i_) arr[i_] = (isr[i_] ? (const char*)KR + b_ * SKV * 64 : (const char*)(Kp)) + kofs[i_]; } while (0)
    bool isr[2];
#pragma unroll
    for (int i = 0; i < 2; ++i) { const int r = 4 * (2 * wid + i) + (lane >> 4), q = lane & 15; int c = q ^ (r & 7); c = c < 12 ? c : c - 4; isr[i] = c >= 8; kofs[i] = isr[i] ? (unsigned)(r * 64 + (c - 8) * 16) : (unsigned)((r * DQK + c * 8) * 2); tstr[i] = isr[i] ? (unsigned)(KVBLK * 64) : (unsigned)(KVBLK * DQK * 2); }
    { const int o = wid * 1024 + lane * 16, sI = o >> 9, wd = (o & 511) >> 1; const int kk = (sI >> 1) * 8 + (wd >> 5); const int k = (kk & ~0xC) | ((kk & 4) << 1) | ((kk & 8) >> 1);
      const int c = (sI & 1) * 32 + (wd & 31); vofs = (unsigned)((k * DV + c) * 2); }
    const int vb0 = (int)(uintptr_t)V_lds + v_rd_base(lane);
    bf16x8 qr[6];
#define DMA_K(Karr, t, b) do { _Pragma("unroll") for (int i_ = 0; i_ < 2; ++i_) \
    __builtin_amdgcn_global_load_lds((const unsigned*)(Karr[i_] + (size_t)(t) * tstr[i_]), (LAS unsigned*)(ldsl + 2 * SHM_V + (b) * SHM_K + (2 * wid + i_) * 1024), 16, 0, 0); } while (0)
#define DMA_V(Vp, t, b) do { const char* g_ = (const char*)(Vp) + (size_t)(t) * (KVBLK * DV * 2); \
    __builtin_amdgcn_global_load_lds((const unsigned*)(g_ + vofs), (LAS unsigned*)(ldsl + (b) * SHM_V + wid * 1024), 16, 0, 0); } while (0)
#define SWAIT() asm volatile("s_waitcnt vmcnt(0)" ::: "memory")
#define RESC(a) do { if (__any((a) < 1.f)) { if (hi == 0) al_l[r32] = (a); asm volatile("s_waitcnt lgkmcnt(0)" ::: "memory"); \
    _Pragma("unroll") for (int r = 0; r < 16; ++r) { const float f_ = al_l[crow(r, hi)]; o[0][r] *= f_; o[1][r] *= f_; osum[r] *= f_; } } } while (0)
#define UNIT_PTRS(u_, Kp, Vp, Qp) do { const int bh_ = (u_) >> 3, qb_ = (u_) & 7; Kp = Kc + (size_t)bh_ * SKV * DQK; Vp = Vc + (size_t)bh_ * SKV * DV; \
    Qp = Q + ((size_t)bh_ * TL + qb_ * 256 + wid * QBLK + r32) * DQK + hi * 8; } while (0)
#define QLOAD(Qp) do { _Pragma("unroll") for (int d0 = 0; d0 < 6; ++d0) qr[d0] = *reinterpret_cast<const bf16x8*>((Qp) + d0 * 16); } while (0)
    constexpr int NT = SKV / KVBLK;
    int u = u0; if (u >= nunits) return;
    const bf16_t* Kh; const bf16_t* Vh; const bf16_t* Qw;
    UNIT_PTRS(u, Kh, Vh, Qw);
    KBASE(Kh, gkh);
    __syncthreads();
    DMA_K(gkh, 0, 0); DMA_V(Vh, 0, 0); DMA_K(gkh, 1, 1); QLOAD(Qw);
    bool firstu = true;
    for (;;) {
        float m_ref = 0.f; unsigned q6x = 0u; f32x16 o[2] = {}; f32x16 osum = {};
        f32x16 pA0, pA1, pB0, pB1; float alA, alB; bf16x8 pa0, pa1, pa2, pa3;
        bf16_t* Ow = O + ((size_t)((u >> 3) >> 4) * TL + (u & 7) * 256 + wid * QBLK) * D + ((u >> 3) & 15) * DV;
        if (firstu) SWAIT(); else asm volatile("s_waitcnt vmcnt(4)" ::: "memory");
        __syncthreads(); firstu = false;
        qkt(pA0, pA1, K_lds, qr, q6x, r32, hi); partialSM(pA0, pA1, m_ref, q6x, alA, true, hi);
        __syncthreads();
        for (int j = 0; j + 2 < NT; j += 2) {
            DMA_K(gkh, j + 2, 0); DMA_V(Vh, j + 1, 1);
            SBAR(); qkt(pB0, pB1, K_lds + SHM_K, qr, q6x, r32, hi);
            finishSM(pA0, pA1, pa0, pa1, pa2, pa3); SBAR();
            pv_partial(o, osum, vb0, pa0, pa1, pa2, pa3, pB0, pB1, m_ref, q6x, alB, hi);
            RESC(alB); SWAIT(); __syncthreads();
            DMA_K(gkh, j + 3, 1); DMA_V(Vh, j + 2, 0);
            SBAR(); qkt(pA0, pA1, K_lds, qr, q6x, r32, hi);
            finishSM(pB0, pB1, pa0, pa1, pa2, pa3); SBAR();
            pv_partial(o, osum, vb0 + SHM_V, pa0, pa1, pa2, pa3, pA0, pA1, m_ref, q6x, alA, hi);
            RESC(alA); SWAIT(); __syncthreads();
        }
        const int un = u + ustep; const bool has_next = un < nunits;
        const bf16_t* Kn = Kh; const bf16_t* Vn = Vh; const bf16_t* Qn = Qw;
        if (has_next) UNIT_PTRS(un, Kn, Vn, Qn);
        gkn[0] = gkh[0]; gkn[1] = gkh[1]; if (has_next) KBASE(Kn, gkn);
        if (has_next) DMA_K(gkn, 0, 0);
        DMA_V(Vh, NT - 1, 1);
        SBAR(); qkt(pB0, pB1, K_lds + SHM_K, qr, q6x, r32, hi);
        finishSM(pA0, pA1, pa0, pa1, pa2, pa3); SBAR();
        if (has_next) QLOAD(Qn);
        SBAR();
        pv_partial(o, osum, vb0, pa0, pa1, pa2, pa3, pB0, pB1, m_ref, q6x, alB, hi);
        RESC(alB); SWAIT(); __syncthreads();
        if (has_next) { DMA_K(gkn, 1, 1); DMA_V(Vn, 0, 0); }
        finishSM(pB0, pB1, pa0, pa1, pa2, pa3); SBAR();
        pv_d0(o, osum, vb0 + SHM_V, pa0, pa1, pa2, pa3);
        float rli[16];
#pragma unroll
        for (int r = 0; r < 16; ++r) rli[r] = __builtin_amdgcn_rcpf(osum[r]);
        { bf16_t* stg = (bf16_t*)(lds + 65536) + wid * 2048;
#pragma unroll
          for (int r = 0; r < 16; ++r) { const int orow = crow(r, hi);
#pragma unroll
              for (int d0 = 0; d0 < 2; ++d0) { const float val = o[d0][r] * rli[r]; stg[orow * 64 + d0 * 32 + r32] = (bf16_t)(cvt_pk_bf16(val, val) & 0xffffu); } }
          asm volatile("s_waitcnt lgkmcnt(0)" ::: "memory");
#pragma unroll
          for (int i = 0; i < 4; ++i) { const int row = i * 8 + (lane >> 3), ch = lane & 7; const u32x4 v = *(const u32x4*)(stg + row * 64 + ch * 8); *(u32x4*)(Ow + (size_t)row * D + ch * 8) = v; }
          asm volatile("s_waitcnt lgkmcnt(0)" ::: "memory"); }
        if (!has_next) break;
        u = un; Kh = Kn; Vh = Vn; Qw = Qn; gkh[0] = gkn[0]; gkh[1] = gkn[1];
    }
    SWAIT();
#undef DMA_K
#undef DMA_V
#undef SWAIT
#undef RESC
#undef UNIT_PTRS
#undef QLOAD
}
#undef KSWZ
#undef SBAR
}

__device__ __forceinline__ void p_attention(Frame& F) {
    const int vcu = (F.G % 8 == 0) ? (F.bid % 8) * (F.G / 8) + F.bid / 8 : F.bid;
    att::attn_units(WSP(bf16_t, WS_Q), WSP(bf16_t, WS_K), WSP(bf16_t, WS_V), WSP(bf16_t, WS_O), vcu, F.G, NB * NH * 8, (char*)F.lds, F.lds, WSP(bf16_t, WS_YG + 16 * MiB));
    __syncthreads();
}

__device__ __forceinline__ void stage_gather_idx(Frame& F, const pg8::MoeOrder& S) {
    LAS unsigned* gi = (LAS unsigned*)(F.lds + pg8::STAGE_BYTES);
    const int* rowidx = WSP(int, WS_ROWIDX); pg8::Unit u;
    for (int i = 0; S.next(i, u); ++i) for (int r = F.tid; r < 256; r += 512) gi[i * 256 + r] = (unsigned)rowidx[u.arow + r] * (unsigned)(D * 2);
    __syncthreads();
}

constexpr int N_PHASES = 19;
__global__ void __launch_bounds__(NWAVES * 64, 2) mega_fwd(Args args) {
    extern __shared__ __attribute__((aligned(16))) unsigned char lds_raw[];
    Frame F; F.lds = (LAS unsigned char*)lds_raw; F.tid = threadIdx.x; F.lane = F.tid & 63; F.wave = __builtin_amdgcn_readfirstlane(F.tid >> 6);
    F.G = gridDim.x; F.bid = blockIdx.x; F.a = &args; F.ws = args.ws;
    cg::grid_group grid = cg::this_grid();
    const int lo = args.ph_lo, hi = args.ph_hi;
    volatile LAS unsigned* misc = (volatile LAS unsigned*)(F.lds + LDS_BYTES - 256);
    if (F.tid < 2) misc[F.tid] = 0u;
    __syncthreads();
    (void)xcd_barrier_post((unsigned*)args.ws, misc);
    if (lo < 0) grid.sync();
#ifdef ONLY_PHASE
#define IN(k) ((k) == ONLY_PHASE && lo <= (k) && (k) < hi)
#else
#define IN(k) (lo <= (k) && (k) < hi)
#endif
#define GRIDBAR() do { XcdBarrier xb_; xb_.bar = (unsigned*)args.ws; xb_.x = xb_xcc_id(); xb_.st = (volatile LAS unsigned*)(F.lds + LDS_BYTES - 256); xcd_barrier(xb_); } while (0)
#define PH(k, ...) if (IN(k)) { __VA_ARGS__ if ((DUP_MASK >> (k)) & 1u) { GRIDBAR(); __VA_ARGS__ } } SEAM(k);
#define SEAM(k) do { if (IN(k) && IN((k) + 1)) { XcdBarrier xb_; xb_.bar = (unsigned*)args.ws; xb_.x = xb_xcc_id(); xb_.st = (volatile LAS unsigned*)(F.lds + LDS_BYTES - 256); xcd_barrier(xb_); } } while (0)
    const Args& A = args;
    PH(0,  p0_prologue(F); )
    PH(1,  p_norm_in(F); )
    PH(2,
        pg8::DenseOrder S; S.init(MT, 2048, D, F.G, F.bid); pg8::EpiLruIn E{WSP(bf16_t, WS_G), WSP(bf16_t, WS_ZX)};
        pg8::gemm_phase<pg8::EpiLruIn, pg8::DenseOrder, false>(F.lds, WSP(bf16_t, WS_H), D, WSP(bf16_t, WS_WLIN), D, S, E, nullptr); )
    PH(3,  p_scan(F); )
    PH(4,
        pg8::DenseOrder S; S.init(MT, D, D, F.G, F.bid); pg8::EpiResid<false> E{A.in[I_X], A.in[I_CTX], WSP(bf16_t, WS_X), WSP(float, WS_MOD)};
        pg8::gemm_phase<pg8::EpiResid<false>, pg8::DenseOrder, false>(F.lds, WSP(bf16_t, WS_YG), D, WSP(bf16_t, WS_WLOUT), D, S, E, nullptr); )
    PH(5,  p_moe_norm(F, 0, MT); )
    PH(6,  p_topk(F, true); )
    PH(7,
        pg8::MoeOrder S; S.init(288, 8, 2048, F.G, F.bid); stage_gather_idx(F, S); pg8::EpiUp E{WSP(bf16_t, WS_HID)};
        pg8::gemm_phase<pg8::EpiUp, pg8::MoeOrder, true>(F.lds, WSP(bf16_t, WS_H), D, WSP(bf16_t, WS_WUP), D, S, E, (const LAS unsigned*)(F.lds + pg8::STAGE_BYTES)); )
    PH(8,
        pg8::MoeOrder S; S.init(288, 4, 1024, F.G, F.bid); pg8::EpiDown E{WSP(bf16_t, WS_Y), WSP(float, WS_GATEV)};
        pg8::gemm_phase<pg8::EpiDown, pg8::MoeOrder, false>(F.lds, WSP(bf16_t, WS_HID), D, WSP(bf16_t, WS_WDN), D, S, E, nullptr); )
    PH(9,  p_combine(F, 0, false); )
    PH(10,
        pg8::DenseOrder S; S.init(MT, ZW, D, F.G, F.bid); pg8::EpiZ E{WSP(bf16_t, WS_Z), WSP(float, WS_SSQ), WSP(float, WS_SSKV), (LAS float*)(F.lds + pg8::STAGE_BYTES)};
        pg8::gemm_phase<pg8::EpiZ, pg8::DenseOrder, false>(F.lds, WSP(bf16_t, WS_H), D, WSP(bf16_t, WS_WMIN), D, S, E, nullptr); )
    PH(11,
        { LAS float* ropel = (LAS float*)(F.lds + pg8::STAGE_BYTES);
          for (int i = F.tid; i < 1024; i += 512) ropel[i] = WSP(float, WS_ROPE)[i];
          pg8::DenseOrder S; S.init(MLAT, NH * DQK, QLORA, F.G, F.bid);
          LAS float* rsl = ropel + 1024; { pg8::Unit uu; for (int i = 0; S.next(i, uu); ++i) if (F.tid < 256) rsl[i * 256 + F.tid] = rsqrtf(WSP(float, WS_SSQ)[uu.pm * 256 + F.tid] * (1.0f / QLORA) + EPS) * QSCALE; }
          __syncthreads();
          pg8::EpiQ E{WSP(bf16_t, WS_Q), rsl, ropel};
          pg8::gemm_phase<pg8::EpiQ, pg8::DenseOrder, false>(F.lds, WSP(bf16_t, WS_Z), ZW, WSP(bf16_t, WS_WUQ), QLORA, S, E, nullptr); }
        { pg8::DenseOrder S; S.init(MT, NH * 128, KVLORA, F.G, F.bid);
          LAS float* rsl = (LAS float*)(F.lds + pg8::STAGE_BYTES); { pg8::Unit uu; for (int i = 0; S.next(i, uu); ++i) if (F.tid < 256) rsl[i * 256 + F.tid] = rsqrtf(WSP(float, WS_SSKV)[uu.pm * 256 + F.tid] * (1.0f / KVLORA) + EPS); }
          __syncthreads();
          pg8::EpiKV E{WSP(bf16_t, WS_K), WSP(bf16_t, WS_V), rsl};
          pg8::gemm_phase<pg8::EpiKV, pg8::DenseOrder, false>(F.lds, WSP(bf16_t, WS_Z) + QLORA, ZW, WSP(bf16_t, WS_WUKV), KVLORA, S, E, nullptr); }
        p_krope(F); )
    PH(12,  p_attention(F); )
    PH(13,
        pg8::DenseOrder S; S.init(MLAT, D, D, F.G, F.bid); pg8::EpiResid<true> E{nullptr, nullptr, WSP(bf16_t, WS_X), WSP(float, WS_MOD) + 17 * 6144};
        pg8::gemm_phase<pg8::EpiResid<true>, pg8::DenseOrder, false>(F.lds, WSP(bf16_t, WS_O), D, WSP(bf16_t, WS_WO), D, S, E, nullptr); )
    PH(14,  p_moe_norm(F, 1, MLAT); )
    PH(15,  p_topk(F, false); )
    PH(16,
        pg8::MoeOrder S; S.init(256, 8, 2048, F.G, F.bid); stage_gather_idx(F, S); pg8::EpiUp E{WSP(bf16_t, WS_HID)};
        pg8::gemm_phase<pg8::EpiUp, pg8::MoeOrder, true>(F.lds, WSP(bf16_t, WS_H), D, WSP(bf16_t, WS_WUP) + (size_t)NE * 2048 * 1024, D, S, E, (const LAS unsigned*)(F.lds + pg8::STAGE_BYTES)); )
    PH(17,
        pg8::MoeOrder S; S.init(256, 4, 1024, F.G, F.bid); pg8::EpiDown E{WSP(bf16_t, WS_Y), WSP(float, WS_GATEV)};
        pg8::gemm_phase<pg8::EpiDown, pg8::MoeOrder, false>(F.lds, WSP(bf16_t, WS_HID), D, WSP(bf16_t, WS_WDN) + (size_t)NE * 1024 * 1024, D, S, E, nullptr); )
    PH(18,  p_combine(F, 1, true); )
#undef IN
#undef SEAM
#undef PH
#undef GRIDBAR
}

extern "C" void kernel_launch(void* const* d_in, const int* in_sizes, int n_in, void* d_out, int out_size, void* d_ws, size_t ws_size, hipStream_t stream) {
    static int grid = 0;
    if (grid == 0) {
        if (n_in != 25 || in_sizes[0] != MLAT * D || out_size != MLAT * D || ws_size < WS_END) { fprintf(stderr, "kernel_launch: unexpected shapes (n_in %d, in0 %d, out %d, ws %zu)\n", n_in, n_in > 0 ? in_sizes[0] : -1, out_size, ws_size); grid = -1; return; }
        int dev = 0, cus = 0, per_cu = 0;
        if (hipGetDevice(&dev) != hipSuccess || hipDeviceGetAttribute(&cus, hipDeviceAttributeMultiprocessorCount, dev) != hipSuccess) { grid = -1; return; }
        if (hipFuncSetAttribute((const void*)mega_fwd, hipFuncAttributeMaxDynamicSharedMemorySize, LDS_BYTES) != hipSuccess) { fprintf(stderr, "kernel_launch: hipFuncSetAttribute failed\n"); grid = -1; return; }
        if (hipOccupancyMaxActiveBlocksPerMultiprocessor(&per_cu, (const void*)mega_fwd, NWAVES * 64, LDS_BYTES) != hipSuccess || per_cu < 1) { fprintf(stderr, "kernel_launch: occupancy query says %d\n", per_cu); (void)hipGetLastError(); per_cu = 1; }
        grid = cus * 1;
    }
    if (grid < 0) return;
    if (hipMemsetAsync(d_ws, 0, 16384, stream) != hipSuccess) { fprintf(stderr, "kernel_launch: memset of the barrier words failed\n"); return; }
    Args a{};
    for (int i = 0; i < 25; ++i) a.in[i] = (const float*)d_in[i];
    a.out = (float*)d_out; a.ws = (unsigned char*)d_ws;
#if MK_N_LAUNCHES == 1
    a.ph_lo = 0; a.ph_hi = N_PHASES;
    void* kargs[] = {&a};
    hipError_t e = hipLaunchCooperativeKernel((const void*)mega_fwd, dim3(grid), dim3(NWAVES * 64), kargs, LDS_BYTES, stream);
    if (e != hipSuccess) fprintf(stderr, "kernel_launch: cooperative launch failed: %s (grid %d)\n", hipGetErrorString(e), grid);
#else
    for (int p = 0; p < N_PHASES; ++p) { a.ph_lo = p; a.ph_hi = p + 1; void* kargs[] = {&a};
        hipError_t e = hipLaunchCooperativeKernel((const void*)mega_fwd, dim3(grid), dim3(NWAVES * 64), kargs, LDS_BYTES, stream);
        if (e != hipSuccess) { fprintf(stderr, "kernel_launch: launch %d failed: %s\n", p, hipGetErrorString(e)); break; } }
#endif
}
```
